# Optimizing an MI355X kernel written in HIP

```python
import math
import jax, jax.numpy as jnp
from jax import lax
import numpy as np

D_MODEL = 4096
BATCH = 2
SEQ = 8192
DEPTH = 2

N_MIXERS = 2
N_META = 16
BLOCK_Q = 128
DA_HEADS = 16
DA_HEAD_DIM = D_MODEL // (2 * DA_HEADS)
ROPE_THETA = 10000.0
SSM_GROUP = 16
SSM_GROUPS = D_MODEL // SSM_GROUP
SSM_STATE = 64
DT_MIN = 0.001
DT_MAX = 0.1
D_FF = 4 * D_MODEL
EPS = 1e-6
N_ATTN_LAYERS = (DEPTH + N_MIXERS - 1) // N_MIXERS
N_SSM_LAYERS = DEPTH // N_MIXERS

kernel_name = "hybrid_diffattn_s5_sqrelu"


def lambda_init(layer_idx):
    return 0.8 - 0.6 * math.exp(-0.3 * layer_idx)


def rmsnorm(x, g):
    xf = x.astype(jnp.float32)
    y = xf * lax.rsqrt(jnp.mean(xf * xf, axis=-1, keepdims=True) + EPS)
    return (y * g.astype(jnp.float32)).astype(x.dtype)


def rope_tables(length):
    inv = ROPE_THETA ** (-jnp.arange(0, DA_HEAD_DIM, 2, dtype=jnp.float32) / DA_HEAD_DIM)
    ang = jnp.arange(length, dtype=jnp.float32)[:, None] * inv[None, :]
    return jnp.cos(ang), jnp.sin(ang)


def apply_rope(x, cos, sin):
    xf = x.astype(jnp.float32)
    x1, x2 = jnp.split(xf, 2, axis=-1)
    c = cos[None, :, None, :]
    s = sin[None, :, None, :]
    return jnp.concatenate([x1 * c - x2 * s, x2 * c + x1 * s], axis=-1).astype(x.dtype)


def diff_attention(u, w_qkv, q_g, k_g, lam_vecs, subln_g, w_o, cos, sin, lam_init):
    bsz, length, _ = u.shape
    H, dh = DA_HEADS, DA_HEAD_DIM
    nb = length // BLOCK_Q
    qkv = u @ w_qkv
    q, k, v = jnp.split(qkv, 3, axis=-1)
    q = q.reshape(bsz, length, 2 * H, dh)
    k = k.reshape(bsz, length, 2 * H, dh)
    v = v.reshape(bsz, length, H, 2 * dh)
    q = apply_rope(rmsnorm(q, q_g), cos, sin) * (dh ** -0.5)
    k = apply_rope(rmsnorm(k, k_g), cos, sin)
    q = q.reshape(bsz, nb, BLOCK_Q, H, 2, dh).transpose(1, 0, 2, 3, 4, 5)
    k = k.reshape(bsz, length, H, 2, dh)
    lv = lam_vecs.astype(jnp.float32)
    lam = jnp.exp(jnp.sum(lv[0] * lv[1])) - jnp.exp(jnp.sum(lv[2] * lv[3])) + lam_init
    kpos = jnp.arange(length)

    def block(args):
        qb, bi = args
        s = jnp.einsum('bqhcd,bkhcd->bhcqk', qb, k, preferred_element_type=jnp.float32)
        qpos = bi * BLOCK_Q + jnp.arange(BLOCK_Q)
        mask = kpos[None, :] <= qpos[:, None]
        p = jax.nn.softmax(jnp.where(mask, s, -jnp.inf), axis=-1)
        a = p[:, :, 0] - lam * p[:, :, 1]
        return jnp.einsum('bhqk,bkhe->bqhe', a.astype(v.dtype), v)

    o = lax.map(block, (q, jnp.arange(nb)))
    o = o.transpose(1, 0, 2, 3, 4).reshape(bsz, length, H, 2 * dh)
    o = rmsnorm(o, subln_g) * (1.0 - lam_init)
    return o.reshape(bsz, length, D_MODEL) @ w_o


def s5_mixer(u, a_re, a_im, log_dt, b_re, b_im, c_re, c_im, d_skip, w_glu, b_glu):
    bsz, length, _ = u.shape
    G, P = SSM_GROUPS, SSM_STATE
    uf = u.astype(jnp.float32).reshape(bsz, length, G, SSM_GROUP)
    dt = jnp.exp(log_dt.astype(jnp.float32))[:, None]
    ar = a_re.astype(jnp.float32)
    ai = a_im.astype(jnp.float32)
    mag = jnp.exp(dt * ar)
    ang = dt * ai
    abar_re = mag * jnp.cos(ang)
    abar_im = mag * jnp.sin(ang)
    nr = abar_re - 1.0
    ni = abar_im
    den = ar * ar + ai * ai
    f_re = (nr * ar + ni * ai) / den
    f_im = (ni * ar - nr * ai) / den
    br = b_re.astype(jnp.float32)
    bi = b_im.astype(jnp.float32)
    bb_re = f_re[..., None] * br - f_im[..., None] * bi
    bb_im = f_re[..., None] * bi + f_im[..., None] * br
    bu_re = jnp.einsum('blgh,gph->blgp', uf, bb_re)
    bu_im = jnp.einsum('blgh,gph->blgp', uf, bb_im)
    a_r = jnp.broadcast_to(abar_re, (1, length, G, P))
    a_i = jnp.broadcast_to(abar_im, (1, length, G, P))

    def combine(e1, e2):
        a1r, a1i, b1r, b1i = e1
        a2r, a2i, b2r, b2i = e2
        return (a1r * a2r - a1i * a2i,
                a1r * a2i + a1i * a2r,
                a2r * b1r - a2i * b1i + b2r,
                a2r * b1i + a2i * b1r + b2i)

    _, _, x_re, x_im = lax.associative_scan(combine, (a_r, a_i, bu_re, bu_im), axis=1)
    y = (jnp.einsum('blgp,ghp->blgh', x_re, c_re.astype(jnp.float32))
         - jnp.einsum('blgp,ghp->blgh', x_im, c_im.astype(jnp.float32)))
    y = y.reshape(bsz, length, D_MODEL) + d_skip.astype(jnp.float32) * uf.reshape(bsz, length, D_MODEL)
    z = jax.nn.gelu(y).astype(u.dtype)
    gl = z @ w_glu + b_glu
    val, gate = jnp.split(gl, 2, axis=-1)
    return val * jax.nn.sigmoid(gate)


def sqrelu_mlp(u, w_up, w_down):
    return jnp.square(jax.nn.relu(u @ w_up)) @ w_down


def setup_inputs(seed: int = 0) -> dict:
    key = jax.random.key(seed)
    ks = jax.random.split(key, 24)
    D, NA, NS = D_MODEL, N_ATTN_LAYERS, N_SSM_LAYERS
    G, P, GS, dh = SSM_GROUPS, SSM_STATE, SSM_GROUP, DA_HEAD_DIM
    f32 = jnp.float32
    nrm = lambda k, s: jax.random.normal(k, s, f32)
    return {
        "x": nrm(ks[0], (BATCH, SEQ, D)),
        "meta_tokens": nrm(ks[1], (N_META, D)),
        "norm_mix_g": 1.0 + 0.02 * nrm(ks[2], (DEPTH, D)),
        "norm_mlp_g": 1.0 + 0.02 * nrm(ks[3], (DEPTH, D)),
        "da_w_qkv": nrm(ks[4], (NA, D, 3 * D)) * D ** -0.5,
        "da_q_norm_g": 1.0 + 0.02 * nrm(ks[5], (NA, dh)),
        "da_k_norm_g": 1.0 + 0.02 * nrm(ks[6], (NA, dh)),
        "da_lambda": 0.1 * nrm(ks[7], (NA, 4, dh)),
        "da_subln_g": 1.0 + 0.02 * nrm(ks[8], (NA, 2 * dh)),
        "da_w_o": nrm(ks[9], (NA, D, D)) * D ** -0.5,
        "ssm_a_re": -0.5 + 0.01 * nrm(ks[10], (NS, G, P)),
        "ssm_a_im": math.pi * jnp.arange(P, dtype=f32)[None, None, :] + 0.01 * nrm(ks[11], (NS, G, P)),
        "ssm_log_dt": jax.random.uniform(ks[12], (NS, G), f32, math.log(DT_MIN), math.log(DT_MAX)),
        "ssm_b_re": nrm(ks[13], (NS, G, P, GS)) * (2 * GS) ** -0.5,
        "ssm_b_im": nrm(ks[14], (NS, G, P, GS)) * (2 * GS) ** -0.5,
        "ssm_c_re": nrm(ks[15], (NS, G, GS, P)) * P ** -0.5,
        "ssm_c_im": nrm(ks[16], (NS, G, GS, P)) * P ** -0.5,
        "ssm_d": nrm(ks[17], (NS, D)),
        "ssm_w_glu": nrm(ks[18], (NS, D, 2 * D)) * D ** -0.5,
        "ssm_b_glu": 0.01 * nrm(ks[19], (NS, 2 * D)),
        "mlp_w_up": nrm(ks[20], (DEPTH, D, D_FF)) * D ** -0.5,
        "mlp_w_down": nrm(ks[21], (DEPTH, D_FF, D)) * D_FF ** -0.5,
    }


def reference(x, meta_tokens, norm_mix_g, norm_mlp_g, da_w_qkv, da_q_norm_g, da_k_norm_g,
              da_lambda, da_subln_g, da_w_o, ssm_a_re, ssm_a_im, ssm_log_dt, ssm_b_re,
              ssm_b_im, ssm_c_re, ssm_c_im, ssm_d, ssm_w_glu, ssm_b_glu, mlp_w_up, mlp_w_down):
    bsz, seq, _ = x.shape
    length = N_META + seq
    padded = ((length + BLOCK_Q - 1) // BLOCK_Q) * BLOCK_Q
    meta = jnp.broadcast_to(meta_tokens.astype(x.dtype)[None], (bsz, N_META, D_MODEL))
    pad = jnp.zeros((bsz, padded - length, D_MODEL), x.dtype)
    h = jnp.concatenate([meta, x, pad], axis=1)
    cos, sin = rope_tables(padded)
    for i in range(DEPTH):
        j = i // N_MIXERS
        hn = rmsnorm(h, norm_mix_g[i])
        if i % N_MIXERS == 0:
            h = h + diff_attention(hn, da_w_qkv[j], da_q_norm_g[j], da_k_norm_g[j], da_lambda[j],
                                   da_subln_g[j], da_w_o[j], cos, sin, lambda_init(i))
        else:
            h = h + s5_mixer(hn, ssm_a_re[j], ssm_a_im[j], ssm_log_dt[j], ssm_b_re[j], ssm_b_im[j],
                             ssm_c_re[j], ssm_c_im[j], ssm_d[j], ssm_w_glu[j], ssm_b_glu[j])
        h = h + sqrelu_mlp(rmsnorm(h, norm_mlp_g[i]), mlp_w_up[i], mlp_w_down[i])
    return h[:, N_META:length]
```

```cpp
#include <hip/hip_runtime.h>
#include <cstdio>
#include <cstdint>
__device__ __forceinline__ int tid_fresh() { int t = threadIdx.x; asm volatile("" : "+v"(t)); return t; }
namespace pg8 {
#define PG8_LAS __attribute__((address_space(3)))
typedef unsigned short bf16_t;
typedef short bf16x8 __attribute__((ext_vector_type(8)));
typedef float f32x4 __attribute__((ext_vector_type(4)));
typedef unsigned u32x4 __attribute__((ext_vector_type(4)));
constexpr int BM = 256, BK = 64, HALF = 128, HTB = HALF * BK * 2  , STAGE_BYTES = 8 * HTB, NXCD = 8, WGM = 8;

__host__ __device__ __forceinline__ int lds_byte(int r, int c) { const int st = (r >> 4) * 2 + (c >> 5), rr = r & 15, cc = c & 31, ob = rr * 64 + cc * 2; return st * 1024 + (ob ^ (((ob >> 9) & 1) << 5)); }
__host__ __device__ __forceinline__ void stage_rc(int b, int& R, int& C) { const int st = b / 1024, sb = b % 1024, swz = sb ^ (((sb >> 9) & 1) << 5); R = (st >> 1) * 16 + swz / 64; C = (st & 1) * 32 + (swz % 64) / 2; }
__host__ __device__ __forceinline__ int perm32(int rho) { const int n = rho >> 4, i = rho & 15; return 8 * (i >> 2) + 4 * n + (i & 3); }

struct Unit { int pm, pn; };
struct Gemm { const bf16_t* A; const bf16_t* Bt; int M, N, K; };

struct StaticOrder {
    int nM, nN, nwg, G, c;
    __host__ __device__ void init(int M, int N, int G_, int c_) { nM = M / BM; nN = N / BM; nwg = nM * nN; G = G_; c = c_; }
    __host__ __device__ bool next(int i, Unit& u) const {
        const long L = (long)i * G + c; if (L >= nwg) return false;
        int wgid = (int)L; { const int q = nwg / NXCD, r = nwg % NXCD, xcd = wgid % NXCD, off = wgid / NXCD; wgid = (xcd < r ? xcd * (q + 1) : r * (q + 1) + (xcd - r) * q) + off; }
        const int nig = WGM * nN, gid = wgid / nig, fm = gid * WGM, gsz = (nM - fm) < WGM ? (nM - fm) : WGM;
        u.pm = fm + ((wgid % nig) % gsz); u.pn = (wgid % nig) / gsz; return true;
    }
    __device__ __forceinline__ void a_ready(const Unit&) const {}
    __device__ __forceinline__ void done(const Unit&) const {}
};
__device__ __forceinline__ unsigned cvt_pk_bf16(float lo, float hi) { unsigned r; asm volatile("v_cvt_pk_bf16_f32 %0, %1, %2" : "=v"(r) : "v"(lo), "v"(hi)); return r; }
constexpr int E_SKVP = 8256, E_NMETA = 16, E_MXP = 64  ;
struct EpiQKV {
    static constexpr bool PERM = true, AFTER_DRAIN = false;
    bf16_t* Q; size_t sec_stride;
    __device__ __forceinline__ void operator()(const f32x4 (&acc)[2][2][4][2], const Unit& u, int wr, int wc, int fr, int fq) const {
        const int sec = u.pn >> 4; bf16_t* base = Q + (size_t)sec * sec_stride;
        const int hid0 = (u.pn & 15) * 2, d0 = wc * 32 + 8 * fq;
        const bool meta = u.pm >= E_MXP; const int b = meta ? 0 : (u.pm >> 5), pos0 = meta ? 0 : E_NMETA + (u.pm & 31) * 256;
#pragma unroll
        for (int ai = 0; ai < 2; ++ai)
#pragma unroll
            for (int m = 0; m < 4; ++m) { const int r = ai * HALF + wr * 64 + m * 16 + fr;
                if (meta && r >= E_NMETA) continue;
#pragma unroll
                for (int bj = 0; bj < 2; ++bj) { const f32x4 v0 = acc[ai][bj][m][0], v1 = acc[ai][bj][m][1];
                    u32x4 w; w.x = cvt_pk_bf16(v0[0], v0[1]); w.y = cvt_pk_bf16(v0[2], v0[3]); w.z = cvt_pk_bf16(v1[0], v1[1]); w.w = cvt_pk_bf16(v1[2], v1[3]);
                    bf16_t* dst = base + ((size_t)(b * 32 + hid0 + bj) * E_SKVP + pos0 + r) * 128 + d0;
                    *(u32x4*)dst = w;
                    if (meta) *(u32x4*)(dst + (size_t)32 * E_SKVP * 128) = w; } }
    }
};
struct EpiRes {
    static constexpr bool PERM = false, AFTER_DRAIN = false;
    const float* base; float* out;
    __device__ __forceinline__ void operator()(const f32x4 (&acc)[2][2][4][2], const Unit& u, int wr, int wc, int fr, int fq) const {
        const int row0 = u.pm * BM + wr * 64 + fr, col0 = u.pn * BM + wc * 32 + 4 * fq;
#pragma unroll
        for (int ai = 0; ai < 2; ++ai)
#pragma unroll
            for (int m = 0; m < 4; ++m) { const size_t off = (size_t)(row0 + ai * HALF + m * 16) * 4096 + col0;
#pragma unroll
                for (int bj = 0; bj < 2; ++bj)
#pragma unroll
                    for (int n = 0; n < 2; ++n) { const f32x4 bs = *(const f32x4*)(base + off + bj * HALF + n * 16); *(f32x4*)(out + off + bj * HALF + n * 16) = bs + acc[ai][bj][m][n]; }
                asm volatile("" ::: "memory"); }
    }
};
struct EpiRelu2 {
    static constexpr bool PERM = true, AFTER_DRAIN = false;
    bf16_t* O; int ldc;
    __device__ __forceinline__ void operator()(const f32x4 (&acc)[2][2][4][2], const Unit& u, int wr, int wc, int fr, int fq) const {
        const int row0 = u.pm * BM + wr * 64 + fr, col0 = u.pn * BM + wc * 32 + 8 * fq;
#pragma unroll
        for (int ai = 0; ai < 2; ++ai)
#pragma unroll
            for (int m = 0; m < 4; ++m) { bf16_t* rowp = O + (size_t)(row0 + ai * HALF + m * 16) * ldc + col0;
#pragma unroll
                for (int bj = 0; bj < 2; ++bj) { f32x4 v0 = acc[ai][bj][m][0], v1 = acc[ai][bj][m][1];
#pragma unroll
                    for (int j = 0; j < 4; ++j) { const float a = fmaxf(v0[j], 0.f), b = fmaxf(v1[j], 0.f); v0[j] = a * a; v1[j] = b * b; }
                    u32x4 w; w.x = cvt_pk_bf16(v0[0], v0[1]); w.y = cvt_pk_bf16(v0[2], v0[3]); w.z = cvt_pk_bf16(v1[0], v1[1]); w.w = cvt_pk_bf16(v1[2], v1[3]);
                    *(u32x4*)(rowp + bj * HALF) = w; } }
    }
};
struct EpiGlu {
    static constexpr bool PERM = false, AFTER_DRAIN = false;
    float* h; const float* bias;
    __device__ __forceinline__ void operator()(const f32x4 (&acc)[2][2][4][2], const Unit& u, int wr, int wc, int fr, int fq) const {
        const int row0 = u.pm * BM + wr * 64 + fr, f0 = u.pn * HALF + wc * 32 + 4 * fq;
        f32x4 bv[2], bg[2];
#pragma unroll
        for (int n = 0; n < 2; ++n) { bv[n] = *(const f32x4*)(bias + f0 + n * 16); bg[n] = *(const f32x4*)(bias + 4096 + f0 + n * 16); }
#pragma unroll
        for (int ai = 0; ai < 2; ++ai)
#pragma unroll
            for (int m = 0; m < 4; ++m) { float* rowp = h + (size_t)(row0 + ai * HALF + m * 16) * 4096 + f0;
#pragma unroll
                for (int n = 0; n < 2; ++n) { const f32x4 val = acc[ai][0][m][n] + bv[n], gt = acc[ai][1][m][n] + bg[n]; f32x4 o = *(const f32x4*)(rowp + n * 16);
#pragma unroll
                    for (int j = 0; j < 4; ++j) o[j] += val[j] * __builtin_amdgcn_rcpf(1.0f + __builtin_amdgcn_exp2f(-1.4426950408889634f * gt[j]));
                    *(f32x4*)(rowp + n * 16) = o; }
                asm volatile("" ::: "memory"); }
    }
};
template <class Epi, class Sched, bool ALIGN_EPI = false, bool SP2 = false>
__device__ __forceinline__ void gemm_phase(PG8_LAS unsigned char* lds, const Gemm g, const Sched& S, const Epi& E) {
    const int tid = tid_fresh(), wid = __builtin_amdgcn_readfirstlane(tid >> 6), lane = tid & 63, wr = wid >> 2, wc = wid & 3, fr = lane & 15, fq = lane >> 4;
    const int K = g.K, nt = K / BK;
    unsigned voffA[2], voffB[2];
#pragma unroll
    for (int i = 0; i < 2; ++i) { int R, C; stage_rc(tid * 16 + i * 8192, R, C); const int Rb = Epi::PERM ? ((R & ~31) + perm32(R & 31)) : R;
        voffA[i] = (unsigned)(R * K + C) * 2u; voffB[i] = (unsigned)(Rb * K + C) * 2u; }
    const size_t kstep = (size_t)(BK * 2);
    const size_t hstep = (size_t)HALF * K * 2;
    const size_t tstep = 2 * hstep;
    const unsigned ldsw = (unsigned)wid * 1024u;
    const int aoff = lds_byte(wr * 64 + fr, fq * 8), boff = lds_byte(wc * 32 + fr, fq * 8);
#define PG8_SA(b, h) (((b) * 2 + (h)) * HTB)
#define PG8_SB(b, h) ((4 + (b) * 2 + (h)) * HTB)
#define PG8_STAGE(bufoff, gbase, voff) do { _Pragma("unroll") for (int _i = 0; _i < 2; ++_i) \
        __builtin_amdgcn_global_load_lds((const unsigned*)((const char*)(gbase) + (voff)[_i]), (PG8_LAS unsigned*)(lds + (bufoff) + ldsw + _i * 8192), 16, 0, 0); } while (0)
#define PG8_LDA(dst, b, h) do { _Pragma("unroll") for (int m = 0; m < 4; ++m) _Pragma("unroll") for (int k = 0; k < 2; ++k) dst[m][k] = *(const PG8_LAS bf16x8*)(lds + PG8_SA(b, h) + aoff + m * 2048 + k * 1024); } while (0)
#define PG8_LDB(dst, b, h) do { _Pragma("unroll") for (int n = 0; n < 2; ++n) _Pragma("unroll") for (int k = 0; k < 2; ++k) dst[n][k] = *(const PG8_LAS bf16x8*)(lds + PG8_SB(b, h) + boff + n * 2048 + k * 1024); } while (0)
#define PG8_MMA(ai, bj, At, Bt) do { __builtin_amdgcn_s_setprio(1); _Pragma("unroll") for (int m = 0; m < 4; ++m) _Pragma("unroll") for (int n = 0; n < 2; ++n) _Pragma("unroll") for (int k = 0; k < 2; ++k) \
        acc[ai][bj][m][n] = __builtin_amdgcn_mfma_f32_16x16x32_bf16(Bt[n][k], At[m][k], acc[ai][bj][m][n], 0, 0, 0); __builtin_amdgcn_s_setprio(0); } while (0)
#define PG8_WAIT_V(n) asm volatile("s_waitcnt vmcnt(" #n ")" ::: "memory")
#define PG8_WAIT_L(n) asm volatile("s_waitcnt lgkmcnt(" #n ")" ::: "memory")
#define PG8_BAR __builtin_amdgcn_s_barrier()
#define PG8_SCHED __builtin_amdgcn_sched_barrier(0)
    Unit cur, nxt; int ui = 0;
    if (!S.next(0, cur)) return;
    f32x4 acc[2][2][4][2];
#pragma unroll
    for (int a = 0; a < 2; ++a)
#pragma unroll
        for (int b = 0; b < 2; ++b)
#pragma unroll
            for (int m = 0; m < 4; ++m)
#pragma unroll
                for (int n = 0; n < 2; ++n) acc[a][b][m][n] = (f32x4){0.f, 0.f, 0.f, 0.f};
    bf16x8 At[4][2], B0[2][2], B1[2][2];
    const char* cA = (const char*)g.A + (size_t)cur.pm * tstep; const char* cB = (const char*)g.Bt + (size_t)cur.pn * tstep;
    S.a_ready(cur);
    if constexpr (SP2) {
        PG8_STAGE(PG8_SB(0, 0), cB, voffB); PG8_STAGE(PG8_SB(0, 1), cB + hstep, voffB); PG8_STAGE(PG8_SA(0, 0), cA, voffA); PG8_STAGE(PG8_SA(0, 1), cA + hstep, voffA);
        if (wr == 1) PG8_BAR;
        PG8_WAIT_V(2); PG8_BAR;
        PG8_STAGE(PG8_SB(1, 0), cB + kstep, voffB); PG8_STAGE(PG8_SA(1, 0), cA + kstep, voffA); PG8_STAGE(PG8_SB(1, 1), cB + hstep + kstep, voffB);
        PG8_WAIT_V(6); PG8_BAR;
    } else {
        PG8_STAGE(PG8_SB(0, 0), cB, voffB); PG8_STAGE(PG8_SA(0, 0), cA, voffA); PG8_STAGE(PG8_SB(0, 1), cB + hstep, voffB); PG8_STAGE(PG8_SA(0, 1), cA + hstep, voffA);
        if (wr == 1) PG8_BAR;
        PG8_WAIT_V(4); PG8_BAR;
        PG8_STAGE(PG8_SB(1, 0), cB + kstep, voffB); PG8_STAGE(PG8_SA(1, 0), cA + kstep, voffA); PG8_STAGE(PG8_SB(1, 1), cB + hstep + kstep, voffB);
        PG8_WAIT_V(6); PG8_BAR;
    }
    for (;;) {
        const bool has_next = S.next(ui + 1, nxt);
        const char* nA = has_next ? (const char*)g.A + (size_t)nxt.pm * tstep : cA; const char* nB = has_next ? (const char*)g.Bt + (size_t)nxt.pn * tstep : cB;
        for (int t = 0; t < nt; t += 2) {
            const bool last = (t == nt - 2);
            const char* a1 = cA + (size_t)(t + 1) * kstep;
            const char* a2 = last ? nA : cA + (size_t)(t + 2) * kstep; const char* b2 = last ? nB : cB + (size_t)(t + 2) * kstep;
            const char* a3 = a2 + kstep; const char* b3 = b2 + kstep;
            if (last && has_next) S.a_ready(nxt);
            if constexpr (SP2) {
            PG8_LDB(B0, 0, 0); PG8_LDB(B1, 0, 1); PG8_SCHED; PG8_LDA(At, 0, 0); PG8_STAGE(PG8_SA(1, 1), a1 + hstep, voffA);
            PG8_WAIT_V(8); PG8_WAIT_L(0); PG8_BAR; PG8_MMA(0, 0, At, B0); PG8_MMA(0, 1, At, B1); PG8_BAR; PG8_SCHED;
            PG8_LDA(At, 0, 1); PG8_STAGE(PG8_SB(0, 0), b2, voffB); PG8_STAGE(PG8_SB(0, 1), b2 + hstep, voffB); PG8_STAGE(PG8_SA(0, 0), a2, voffA);
            PG8_WAIT_V(8); PG8_WAIT_L(0); PG8_BAR; PG8_MMA(1, 0, At, B0); PG8_MMA(1, 1, At, B1); PG8_BAR; PG8_SCHED;
            PG8_LDB(B0, 1, 0); PG8_LDB(B1, 1, 1); PG8_SCHED; PG8_LDA(At, 1, 0); PG8_STAGE(PG8_SA(0, 1), a2 + hstep, voffA);
            PG8_WAIT_V(8); PG8_WAIT_L(0); PG8_BAR; PG8_MMA(0, 0, At, B0); PG8_MMA(0, 1, At, B1); PG8_BAR; PG8_SCHED;
            PG8_LDA(At, 1, 1); PG8_STAGE(PG8_SB(1, 0), b3, voffB); PG8_STAGE(PG8_SB(1, 1), b3 + hstep, voffB); PG8_STAGE(PG8_SA(1, 0), a3, voffA);
            PG8_WAIT_V(8); PG8_WAIT_L(0); PG8_BAR; PG8_MMA(1, 0, At, B0); PG8_MMA(1, 1, At, B1); PG8_BAR; PG8_SCHED;
            } else {
            PG8_LDB(B0, 0, 0); PG8_SCHED; PG8_LDA(At, 0, 0); PG8_STAGE(PG8_SA(1, 1), a1 + hstep, voffA);
            PG8_WAIT_L(8); PG8_BAR; PG8_WAIT_L(0); PG8_MMA(0, 0, At, B0); PG8_BAR; PG8_SCHED;
            PG8_LDB(B1, 0, 1); PG8_STAGE(PG8_SB(0, 0), b2, voffB);
            PG8_BAR; PG8_WAIT_L(0); PG8_MMA(0, 1, At, B1); PG8_BAR;
            PG8_LDA(At, 0, 1); PG8_STAGE(PG8_SA(0, 0), a2, voffA);
            PG8_BAR; PG8_WAIT_L(0); PG8_MMA(1, 0, At, B0); PG8_BAR; PG8_SCHED;
            PG8_STAGE(PG8_SB(0, 1), b2 + hstep, voffB);
            PG8_WAIT_V(6); PG8_BAR; PG8_MMA(1, 1, At, B1); PG8_BAR;
            PG8_LDB(B0, 1, 0); PG8_SCHED; PG8_LDA(At, 1, 0); PG8_STAGE(PG8_SA(0, 1), a2 + hstep, voffA);
            PG8_WAIT_L(8); PG8_BAR; PG8_WAIT_L(0); PG8_MMA(0, 0, At, B0); PG8_BAR; PG8_SCHED;
            PG8_LDB(B1, 1, 1); PG8_STAGE(PG8_SB(1, 0), b3, voffB);
            PG8_BAR; PG8_WAIT_L(0); PG8_MMA(0, 1, At, B1); PG8_BAR;
            PG8_LDA(At, 1, 1); PG8_STAGE(PG8_SA(1, 0), a3, voffA);
            PG8_BAR; PG8_WAIT_L(0); PG8_MMA(1, 0, At, B0); PG8_BAR; PG8_SCHED;
            PG8_STAGE(PG8_SB(1, 1), b3 + hstep, voffB);
            PG8_WAIT_V(6); PG8_BAR; PG8_MMA(1, 1, At, B1); PG8_BAR;
            }
        }
        if constexpr (ALIGN_EPI) { if (wr == 0) PG8_BAR; }
        if constexpr (!Epi::AFTER_DRAIN) { E(acc, cur, wr, wc, fr, fq); S.done(cur); }
        if (!has_next) break;
#pragma unroll
        for (int a = 0; a < 2; ++a)
#pragma unroll
            for (int b = 0; b < 2; ++b)
#pragma unroll
                for (int m = 0; m < 4; ++m)
#pragma unroll
                    for (int n = 0; n < 2; ++n) acc[a][b][m][n] = (f32x4){0.f, 0.f, 0.f, 0.f};
        cur = nxt; cA = nA; cB = nB; ++ui;
        if constexpr (ALIGN_EPI) { if (wr == 1) PG8_BAR; }
    }
    PG8_WAIT_V(0);
    if constexpr (!ALIGN_EPI) { if (wr == 0) PG8_BAR; }
    PG8_BAR;
    if constexpr (Epi::AFTER_DRAIN) { E.fused(acc, cur, wr, wc, fr, fq, lds, wid, lane); S.done(cur); }
#undef PG8_SA
#undef PG8_SB
#undef PG8_STAGE
#undef PG8_LDA
#undef PG8_LDB
#undef PG8_MMA
#undef PG8_WAIT_V
#undef PG8_WAIT_L
#undef PG8_BAR
#undef PG8_SCHED
}
}
namespace ab {
constexpr int D = 128;
constexpr float THR = 8.f;
constexpr bool WSKIP = false;
constexpr float SCALE = 0.08838834764831845f;
constexpr int NW = 8, QBLK = 32, KVBLK = 64, QB = NW * QBLK;
constexpr int SHM_V = KVBLK * D * 2, SHM_K = KVBLK * D * 2;
constexpr int LDS_BYTES = 2 * SHM_V + 2 * SHM_K + NW * 64 * 4;
typedef unsigned short bf16;
typedef short bf16x8 __attribute__((ext_vector_type(8)));
typedef short s16x4 __attribute__((ext_vector_type(4)));
typedef float f32x16 __attribute__((ext_vector_type(16)));
typedef float f32x4 __attribute__((ext_vector_type(4)));
typedef unsigned u32x4 __attribute__((ext_vector_type(4)));
template <class A, class Bt> struct same_t { static constexpr bool v = false; };
template <class A> struct same_t<A, A> { static constexpr bool v = true; };

#define KSWZ(row, colB) ((row) * 256 + ((colB) ^ (((row) & 7) << 4)))
#define SBAR() __builtin_amdgcn_sched_barrier(0)
__device__ __forceinline__ int v_st(int k, int c) { const int kk = (k & ~0xC) | ((k & 4) << 1) | ((k & 8) >> 1); return ((kk >> 3) * 4 + (c >> 5)) * 512 + ((kk & 7) * 32 + (c & 31)) * 2; }
__device__ __forceinline__ int v_rd_base(int lane) { return ((lane & 3) << 3) | (((lane >> 2) & 3) << 6) | (((lane >> 4) & 1) << 5) | (((lane >> 5) & 1) << 8); }
constexpr int v_rd_off(int d0, int ks, int half) { return d0 * 512 + ks * 4096 + half * 2048; }
__device__ __forceinline__ int crow(int r, int hi) { return (r & 3) + 8 * (r >> 2) + 4 * hi; }
__device__ __forceinline__ unsigned cvtpk(float lo, float hi) {
    unsigned r; asm volatile("v_cvt_pk_bf16_f32 %0, %1, %2" : "=v"(r) : "v"(lo), "v"(hi)); return r;
}
__device__ __forceinline__ bf16x8 pack8(f32x4 a, f32x4 b) {
    u32x4 w = {cvtpk(a[0], a[1]), cvtpk(a[2], a[3]), cvtpk(b[0], b[1]), cvtpk(b[2], b[3])};
    return *reinterpret_cast<bf16x8*>(&w);
}
template <class T> __device__ __forceinline__ bf16x8 load8(const T* p) {
    if constexpr (same_t<T, float>::v) { return pack8(*(const f32x4*)p, *(const f32x4*)(p + 4)); }
    else { return *reinterpret_cast<const bf16x8*>(p); }
}
__device__ __forceinline__ void mask_tile(f32x16& p0, f32x16& p1, int dq, unsigned W) {
    const float NEG = -__builtin_inff();
#pragma unroll
    for (int r = 0; r < 16; ++r) {
        const int c = (r & 3) + 8 * (r >> 2);
        if ((unsigned)(dq - c) >= W) p0[r] = NEG;
        if ((unsigned)(dq - c - 32) >= W) p1[r] = NEG;
    }
}
__device__ __forceinline__ void partialSM(f32x16& p0, f32x16& p1, float& m_reg, float& mn, float& alpha) {
    float pmax = p0[0]; for (int r = 1; r < 16; ++r) pmax = fmaxf(pmax, p0[r]); for (int r = 0; r < 16; ++r) pmax = fmaxf(pmax, p1[r]);
    { auto rr = __builtin_amdgcn_permlane32_swap(__float_as_uint(pmax), __float_as_uint(pmax), false, false);
      pmax = fmaxf(__uint_as_float(rr[0]), __uint_as_float(rr[1])); }
    constexpr float C2 = 1.4426950408889634f * SCALE;
    if (__builtin_expect(__all((pmax - m_reg) * SCALE <= THR), 1)) { mn = m_reg; alpha = 1.f; }
    else { mn = fmaxf(m_reg, pmax); alpha = __builtin_amdgcn_exp2f((m_reg - mn) * C2); m_reg = mn; }
    const float mnL = -mn * C2;
    for (int r = 0; r < 16; ++r) p0[r] = fmaf(p0[r], C2, mnL); for (int r = 0; r < 16; ++r) p1[r] = fmaf(p1[r], C2, mnL);
    for (int r = 0; r < 16; ++r) p0[r] = __builtin_amdgcn_exp2f(p0[r]);
}
__device__ __forceinline__ void finishSM(f32x16& p0, f32x16& p1, float alpha, float& l_reg, bf16x8& pa0, bf16x8& pa1, bf16x8& pa2, bf16x8& pa3) {
    for (int r = 0; r < 16; ++r) p1[r] = __builtin_amdgcn_exp2f(p1[r]);
    float ps = 0; for (int r = 0; r < 16; ++r) ps += p0[r]; for (int r = 0; r < 16; ++r) ps += p1[r];
    { auto rr = __builtin_amdgcn_permlane32_swap(__float_as_uint(ps), __float_as_uint(ps), false, false);
      ps = __uint_as_float(rr[0]) + __uint_as_float(rr[1]); }
    l_reg = l_reg * alpha + ps;
#define PK4(P, B_, OUT) do { unsigned a0 = cvtpk(P[B_+0], P[B_+1]), a1 = cvtpk(P[B_+2], P[B_+3]);                          \
        unsigned b0 = cvtpk(P[B_+4], P[B_+5]), b1 = cvtpk(P[B_+6], P[B_+7]);                                             \
        auto r0 = __builtin_amdgcn_permlane32_swap(a0, b0, false, false); auto r1 = __builtin_amdgcn_permlane32_swap(a1, b1, false, false); \
        u32x4 w = {r0[0], r1[0], r0[1], r1[1]}; OUT = *reinterpret_cast<bf16x8*>(&w); } while (0)
    PK4(p0, 0, pa0); PK4(p0, 8, pa1); PK4(p1, 0, pa2); PK4(p1, 8, pa3);
#undef PK4
}
template <int KB, bool SK>
__device__ __forceinline__ void qkt(f32x16& p0, f32x16& p1, const char* K_lds, int r32, int hi, const bf16x8* qr, bool act) {
    if (SK && !act) { const float NEG = -__builtin_inff();
#pragma unroll
        for (int r = 0; r < 16; ++r) { p0[r] = NEG; p1[r] = NEG; } return; }
    p0 = f32x16{}; p1 = f32x16{};
    const char* kb[4];
#pragma unroll
    for (int dd = 0; dd < 4; ++dd) kb[dd] = K_lds + KB * SHM_K + KSWZ(r32, (dd * 16 + hi * 8) * 2);
#pragma unroll
    for (int d0 = 0; d0 < 8; ++d0) { const char* a = kb[d0 & 3] + (d0 >> 2) * 128;
        bf16x8 b0 = *reinterpret_cast<const bf16x8*>(a);
        bf16x8 b1 = *reinterpret_cast<const bf16x8*>(a + 32 * 256);
        p0 = __builtin_amdgcn_mfma_f32_32x32x16_bf16(b0, qr[d0], p0, 0, 0, 0);
        p1 = __builtin_amdgcn_mfma_f32_32x32x16_bf16(b1, qr[d0], p1, 0, 0, 0); }
}
template <int VB, bool SK>
__device__ __forceinline__ void pv_tile(f32x16* o, int vb0, bf16x8 pa0, bf16x8 pa1, bf16x8 pa2, bf16x8 pa3, bool act) {
    if (SK && !act) return;
#define TRRD(dst, off) asm volatile("ds_read_b64_tr_b16 %0, %1 offset:%2" : "=&v"(dst) : "v"(vb0), "i"(off) : "memory")
#define PV_D0(d0) do { s16x4 l0, l1, l2, l3, h0, h1, h2, h3; constexpr int b_ = VB * SHM_V + v_rd_off(d0, 0, 0);     \
        TRRD(l0, b_); TRRD(h0, b_ + 2048); TRRD(l1, b_ + 4096); TRRD(h1, b_ + 6144); TRRD(l2, b_ + 8192); TRRD(h2, b_ + 10240); TRRD(l3, b_ + 12288); TRRD(h3, b_ + 14336); \
        asm volatile("s_waitcnt lgkmcnt(0)" ::: "memory"); SBAR();                 \
        o[d0] = __builtin_amdgcn_mfma_f32_32x32x16_bf16(pa0, (bf16x8){l0[0], l0[1], l0[2], l0[3], h0[0], h0[1], h0[2], h0[3]}, o[d0], 0, 0, 0);   \
        o[d0] = __builtin_amdgcn_mfma_f32_32x32x16_bf16(pa1, (bf16x8){l1[0], l1[1], l1[2], l1[3], h1[0], h1[1], h1[2], h1[3]}, o[d0], 0, 0, 0);   \
        o[d0] = __builtin_amdgcn_mfma_f32_32x32x16_bf16(pa2, (bf16x8){l2[0], l2[1], l2[2], l2[3], h2[0], h2[1], h2[2], h2[3]}, o[d0], 0, 0, 0);   \
        o[d0] = __builtin_amdgcn_mfma_f32_32x32x16_bf16(pa3, (bf16x8){l3[0], l3[1], l3[2], l3[3], h3[0], h3[1], h3[2], h3[3]}, o[d0], 0, 0, 0); } while (0)
    PV_D0(0); PV_D0(1); PV_D0(2); PV_D0(3);
#undef PV_D0
#undef TRRD
}

template <class TIn, class TOut> struct BlockRef { const TIn* Q; const TIn* K; const TIn* V; TOut* O; int P0; };
template <class TIn> struct Seam {
    bf16x8 qr[8];
    bf16x8 st_v0, st_v1, st_k0, st_k1; f32x4 sf0, sf1, sf2, sf3;
    f32x4 tq[16];
};
__device__ __forceinline__ int swa_jlo(int P0, int W) { const int lowk = P0 - W + 1; return lowk > 0 ? lowk / KVBLK : 0; }
#define ROW(p, k0, rr) ((p) + (size_t)((k0) + (rr)) * D + sc)
#define VMW() asm volatile("s_waitcnt vmcnt(0)" ::: "memory")
#define VMWN(n) asm volatile("s_waitcnt vmcnt(%0)" :: "i"(n) : "memory")
#define SLOAD_H(Kp, Vp, k0) do { S.st_v0 = load8<TIn>(ROW(Vp, k0, sr)); S.st_v1 = load8<TIn>(ROW(Vp, k0, 32 + sr));              \
                         S.st_k0 = load8<TIn>(ROW(Kp, k0, sr)); S.st_k1 = load8<TIn>(ROW(Kp, k0, 32 + sr)); } while (0)
#define SWRITE_HK(bf) do { *(bf16x8*)(K_lds + (bf) * SHM_K + kws) = S.st_k0; *(bf16x8*)(K_lds + (bf) * SHM_K + kws + 32 * 256) = S.st_k1; } while (0)
#define SWRITE_HV(bf) do { *(bf16x8*)(V_lds + (bf) * SHM_V + vst0) = S.st_v0; *(bf16x8*)(V_lds + (bf) * SHM_V + vst1) = S.st_v1; } while (0)
#define SWRITE_H(bf) do { SWRITE_HV(bf); SWRITE_HK(bf); } while (0)
#define SLOAD_F(p, k0) do { S.sf0 = *(const f32x4*)ROW(p, k0, sr); S.sf1 = *(const f32x4*)(ROW(p, k0, sr) + 4);                \
                            S.sf2 = *(const f32x4*)ROW(p, k0, 32 + sr); S.sf3 = *(const f32x4*)(ROW(p, k0, 32 + sr) + 4); } while (0)
#define SWRITE_KF(bf) do { *(bf16x8*)(K_lds + (bf) * SHM_K + kws) = pack8(S.sf0, S.sf1); *(bf16x8*)(K_lds + (bf) * SHM_K + kws + 32 * 256) = pack8(S.sf2, S.sf3); } while (0)
#define SWRITE_VF(bf) do { *(bf16x8*)(V_lds + (bf) * SHM_V + vst0) = pack8(S.sf0, S.sf1); *(bf16x8*)(V_lds + (bf) * SHM_V + vst1) = pack8(S.sf2, S.sf3); } while (0)
template <class TIn, class TOut>
__device__ __forceinline__ void causal_swa_prime(const BlockRef<TIn, TOut>& cur, int W, char* lds, Seam<TIn>& S) {
    constexpr bool F32 = same_t<TIn, float>::v;
    const int tid = tid_fresh(), wid = __builtin_amdgcn_readfirstlane(tid >> 6), lane = tid & 63, r32 = lane & 31, hi = lane >> 5;
    const int sr = tid >> 4, sc = (tid & 15) * 8, kws = KSWZ(sr, sc * 2); char* K_lds = lds + 2 * SHM_V;
    const int kb0 = swa_jlo(cur.P0, W) * KVBLK;
    for (int d0 = 0; d0 < 8; ++d0) S.qr[d0] = load8<TIn>(cur.Q + (size_t)(wid * QBLK + r32) * D + d0 * 16 + hi * 8);
    if constexpr (F32) { SLOAD_F((const float*)cur.K, kb0); VMW(); SWRITE_KF(0); SBAR(); SLOAD_F((const float*)cur.V, kb0); }
    else { SLOAD_H(cur.K, cur.V, kb0); VMW(); SWRITE_HK(0); }
    __syncthreads();
}
template <class TIn, class TOut>
__device__ __forceinline__ void causal_swa_block(const BlockRef<TIn, TOut>& cur, const BlockRef<TIn, TOut>& nxt, int skv, int W, char* lds, Seam<TIn>& S) {
    constexpr bool F32 = same_t<TIn, float>::v;
    const int tid = tid_fresh(), wid = __builtin_amdgcn_readfirstlane(tid >> 6), lane = tid & 63, r32 = lane & 31, hi = lane >> 5;
    const int j_lo = swa_jlo(cur.P0, W);
    int j_hi = (cur.P0 + QB - 1) / KVBLK + 1; if (j_hi > skv / KVBLK) j_hi = skv / KVBLK;
    const int NT = j_hi - j_lo;
    const int kbn = swa_jlo(nxt.P0, W) * KVBLK;
    const int qlo = cur.P0 + wid * QBLK, qm = qlo + r32 - 4 * hi;
    char* V_lds = lds; char* K_lds = lds + 2 * SHM_V;
    float* ws = (float*)(lds + 2 * SHM_V + 2 * SHM_K) + wid * 64; float* li_l = ws, * al_l = ws + 32;
    float m_reg = -1e30f, l_reg = 0; f32x16 o[4] = {};
    const int sr = tid >> 4, sc = (tid & 15) * 8, vst0 = v_st(sr, sc), vst1 = v_st(32 + sr, sc), kws = KSWZ(sr, sc * 2);
    const int vb0 = (int)(uintptr_t)V_lds + v_rd_base(lane);
    const TIn* Kh = cur.K; const TIn* Vh = cur.V;
#define RESC(a) do { if (__any((a) < 1.f)) { if (hi == 0) al_l[r32] = (a); asm volatile("s_waitcnt lgkmcnt(0)" ::: "memory");              \
                     for (int d_ = 0; d_ < 4; ++d_) for (int r = 0; r < 16; ++r) o[d_][r] *= al_l[crow(r, hi)]; } } while (0)
#define KBASE(t) ((j_lo + (t)) * KVBLK)
#define ACT(t) (KBASE(t) <= qlo + QBLK - 1 && KBASE(t) + KVBLK - 1 >= qlo - W + 1)
#define MASKT(P0_, P1_, t) do { const int kb_ = KBASE(t); if ((!SK || ACT(t)) && (kb_ + KVBLK - 1 > qlo || kb_ <= qlo + QBLK - 1 - W)) mask_tile(P0_, P1_, qm - kb_, (unsigned)W); } while (0)
    constexpr int NQL = F32 ? 16 : 8;
    constexpr bool SK = WSKIP && !F32;
#define SEAM_K0() do { VMWN(NQL); if constexpr (F32) { SWRITE_KF(0); SBAR(); SLOAD_F((const float*)nxt.V, kbn); } else { SWRITE_HK(0); } SBAR(); } while (0)
    f32x16 pA0, pA1, pB0, pB1; float mnA, mnB, alA, alB; bf16x8 pa0, pa1, pa2, pa3;
    if constexpr (F32) { VMW(); SWRITE_VF(0); SBAR(); } else { SWRITE_HV(0); SBAR(); }
    if (NT > 1) { if constexpr (F32) SLOAD_F((const float*)Kh, KBASE(1)); else SLOAD_H(Kh, Vh, KBASE(1)); }
    SBAR(); qkt<0, SK>(pA0, pA1, K_lds, r32, hi, S.qr, ACT(0));
    if constexpr (F32) { if (NT > 1) { VMW(); SWRITE_KF(1); SBAR(); SLOAD_F((const float*)Vh, KBASE(1)); } }
    MASKT(pA0, pA1, 0); partialSM(pA0, pA1, m_reg, mnA, alA);
    if (NT > 1) { VMW(); if constexpr (F32) { SWRITE_VF(1); SBAR(); if (NT > 2) SLOAD_F((const float*)Kh, KBASE(2)); } else SWRITE_H(1); }
    __syncthreads();
#define HALF_STEP(PX0, PX1, mnX, alX, PY0, PY1, alY, t, KB, VB, SB) do {                                                      \
        SBAR(); qkt<KB, SK>(PX0, PX1, K_lds, r32, hi, S.qr, ACT(t));                                             \
        finishSM(PY0, PY1, alY, l_reg, pa0, pa1, pa2, pa3); SBAR();                                                           \
        if ((t) + 1 < NT) { if constexpr (F32) { VMW(); SWRITE_KF(SB); SBAR(); SLOAD_F((const float*)Vh, KBASE((t) + 1)); }  \
                            else { SLOAD_H(Kh, Vh, KBASE((t) + 1)); } SBAR(); }                                               \
        pv_tile<VB, SK>(o, vb0, pa0, pa1, pa2, pa3, ACT((t) - 1)); MASKT(PX0, PX1, (t)); partialSM(PX0, PX1, m_reg, mnX, alX);                                        \
        __syncthreads();                                                                                                      \
        if ((t) + 1 < NT) { VMW(); if constexpr (F32) { SWRITE_VF(SB); SBAR(); if ((t) + 2 < NT) SLOAD_F((const float*)Kh, KBASE((t) + 2)); } \
                            else { SWRITE_H(SB); } }                                                                          \
        RESC(alX); __syncthreads(); } while (0)
    for (int t = 1; t + 1 < NT; t += 2) {
        HALF_STEP(pB0, pB1, mnB, alB, pA0, pA1, alA, t, 1, 0, 0);
        HALF_STEP(pA0, pA1, mnA, alA, pB0, pB1, alB, t + 1, 0, 1, 1);
    }
    const bool even = (NT & 1) == 0;
    if (even) { SBAR(); qkt<1, SK>(pB0, pB1, K_lds, r32, hi, S.qr, ACT(NT - 1)); SBAR(); }
#define QROW(e) (nxt.Q + (size_t)(wid * QBLK + r32) * D + ((e) >> 1) * 16 + hi * 8 + ((e) & 1) * 4)
    if constexpr (F32) { SLOAD_F((const float*)nxt.K, kbn); SBAR();
#pragma unroll
        for (int e = 0; e < 8; ++e) S.tq[e] = *(const f32x4*)QROW(e); }
    else { SLOAD_H(nxt.K, nxt.V, kbn); SBAR();
#pragma unroll
        for (int d0 = 0; d0 < 8; ++d0) S.qr[d0] = load8<TIn>(nxt.Q + (size_t)(wid * QBLK + r32) * D + d0 * 16 + hi * 8); }
    SBAR();
    finishSM(pA0, pA1, alA, l_reg, pa0, pa1, pa2, pa3); SBAR();
    if constexpr (F32) {
#pragma unroll
        for (int e = 8; e < 16; ++e) S.tq[e] = *(const f32x4*)QROW(e); SBAR(); }
#undef QROW
    pv_tile<0, SK>(o, vb0, pa0, pa1, pa2, pa3, ACT(even ? NT - 2 : NT - 1));
    if (even) { MASKT(pB0, pB1, NT - 1); partialSM(pB0, pB1, m_reg, mnB, alB); __syncthreads(); RESC(alB);
        finishSM(pB0, pB1, alB, l_reg, pa0, pa1, pa2, pa3); SBAR(); pv_tile<1, SK>(o, vb0, pa0, pa1, pa2, pa3, ACT(NT - 1)); }
    SBAR(); SEAM_K0();
    if (hi == 0) li_l[r32] = l_reg; asm volatile("s_waitcnt lgkmcnt(0)" ::: "memory");
    float rli[16];
#pragma unroll
    for (int r = 0; r < 16; ++r) rli[r] = __builtin_amdgcn_rcpf(li_l[crow(r, hi)]);
    TOut* Ow = cur.O + (size_t)(wid * QBLK) * D;
#pragma unroll
    for (int r = 0; r < 16; ++r) { const int orow = crow(r, hi);
#pragma unroll
        for (int d0 = 0; d0 < 4; ++d0) { const float v = o[d0][r] * rli[r];
            if constexpr (same_t<TOut, float>::v) { Ow[(size_t)orow * D + d0 * 32 + r32] = v; }
            else { const float vn = __shfl_xor(v, 1);
                   if ((r32 & 1) == 0) *(unsigned*)(Ow + (size_t)orow * D + d0 * 32 + r32) = cvtpk(v, vn); } } }
    if constexpr (F32) {
#pragma unroll
        for (int d0 = 0; d0 < 8; ++d0) S.qr[d0] = pack8(S.tq[2 * d0], S.tq[2 * d0 + 1]); }
    __syncthreads();
#undef RESC
#undef KBASE
#undef ACT
#undef MASKT
#undef SEAM_K0
#undef HALF_STEP
}
#undef ROW
#undef VMW
#undef VMWN
#undef SLOAD_H
#undef SWRITE_HK
#undef SWRITE_HV
#undef SWRITE_H
#undef SLOAD_F
#undef SWRITE_KF
#undef SWRITE_VF
}
#define GAS __attribute__((address_space(1)))
#define LAS __attribute__((address_space(3)))
typedef unsigned short bf16;
typedef unsigned u32x4 __attribute__((ext_vector_type(4)));
typedef unsigned u32x2 __attribute__((ext_vector_type(2)));
typedef float f32x4 __attribute__((ext_vector_type(4)));
typedef float f32x2 __attribute__((ext_vector_type(2)));
typedef short bf16x8 __attribute__((ext_vector_type(8)));

constexpr int DM = 4096, NB = 2, SEQ = 8192, NMETA = 16, FF = 16384, NH = 16, DH = 128, NSH = 32;
constexpr int MX = NB * SEQ;
constexpr int MP = MX + 256;
constexpr int SKVP = 8256, LPOS = 8208;
constexpr int SG = 256, SP = 64, SGS = 16;
constexpr float EPS = 1e-6f;
static_assert(SKVP == pg8::E_SKVP && NMETA == pg8::E_NMETA && MX / 256 == pg8::E_MXP, "epilogue constants");

constexpr size_t MiB = 1u << 20;
constexpr size_t WS_CTL = 0, CTL_ZERO_BYTES = 1 * MiB;
constexpr size_t WS_WQKV = 1 * MiB;
constexpr size_t WS_WO   = WS_WQKV + 96 * MiB;
constexpr size_t WS_WGLU = WS_WO + 32 * MiB;
constexpr size_t WS_WUP  = WS_WGLU + 64 * MiB;
constexpr size_t WS_WDN  = WS_WUP + 256 * MiB;
constexpr size_t WS_H    = WS_WDN + 256 * MiB;
constexpr size_t WS_HN   = WS_H + 260 * MiB;
constexpr size_t WS_ATTO = WS_HN + 130 * MiB;
constexpr size_t WS_R    = WS_ATTO + 130 * MiB;
constexpr size_t QKV_T_BYTES = (size_t)NB * NSH * SKVP * DH * 2;
constexpr size_t WS_Q = WS_R, WS_K = WS_Q + QKV_T_BYTES, WS_V = WS_K + QKV_T_BYTES, WS_O = WS_V + QKV_T_BYTES;
constexpr size_t O_BYTES = (size_t)128 * SEQ * DH * 2;
constexpr size_t WS_MID = WS_R;
constexpr size_t WS_END = WS_O + O_BYTES;
static_assert((size_t)MP * DM * 4 == 260 * MiB && (size_t)MP * DM * 2 == 130 * MiB && QKV_T_BYTES == 129 * MiB && (size_t)MP * FF * 2 <= WS_END - WS_R, "ws map");
constexpr int CW_BAR = 4096;

constexpr int RING_BYTES = 131072;
constexpr int S5_BFRAG = 0, S5_CFRAG = 65536, S5_KTAB = 131072, S5_CPOW = 139264, S5_WPOW = 147456, S5_A256 = 149504, S5_A1024 = 150016, S5_F = 150528  , S5_EMETA = S5_F + 8192  ;
constexpr int MISC_OFF = 159232, LDS_BYTES = 159744;
static_assert(S5_EMETA + 512 == MISC_OFF && ab::LDS_BYTES <= RING_BYTES && 17 * 64 * 8 <= 8704, "LDS map");

#define LDS_WAIT() asm volatile("s_waitcnt lgkmcnt(0)" ::: "memory")
__device__ __forceinline__ unsigned pk2(float lo, float hi) { unsigned r; asm volatile("v_cvt_pk_bf16_f32 %0, %1, %2" : "=v"(r) : "v"(lo), "v"(hi)); return r; }
__device__ __forceinline__ float bflo(unsigned w) { return __builtin_bit_cast(float, w << 16); }
__device__ __forceinline__ float bfhi(unsigned w) { return __builtin_bit_cast(float, w & 0xffff0000u); }
__device__ __forceinline__ float wave_sum(float v) {
#pragma unroll
    for (int o = 1; o < 64; o <<= 1) v += __shfl_xor(v, o);
    return v;
}

#define XB_TMO      128
#define XB_XCNT(j)  (256  + 64 * (j))
#define XB_XSUB(j)  (1280 + 64 * (j))
#define XB_XGEN(j)  (2304 + 64 * (j))
#define XB_TOP      3328
#define XB_TOPGEN   3392
#define XCD_BAR_WORDS 3456
#define XB_SPIN_CAP (1u << 18)

__device__ __forceinline__ unsigned xb_ld(unsigned* p)              { return __hip_atomic_load(p, __ATOMIC_RELAXED, __HIP_MEMORY_SCOPE_AGENT); }
__device__ __forceinline__ unsigned xb_add(unsigned* p, unsigned v) { return __hip_atomic_fetch_add(p, v, __ATOMIC_RELAXED, __HIP_MEMORY_SCOPE_AGENT); }
__device__ __forceinline__ unsigned xb_xcc_id() { return (unsigned)__builtin_amdgcn_s_getreg((3 << 11) | 20) & 0xFu; }
#define XB_SPIN(cond, bar) do { unsigned _sp = 0; while (cond) { __builtin_amdgcn_s_sleep(1); \
    if ((++_sp & 255u) == 0u) { if (xb_ld(&(bar)[XB_TMO])) break; if (_sp > XB_SPIN_CAP) { atomicAdd(&(bar)[XB_TMO], 1u); break; } } } } while (0)

struct XcdBarrier {
    unsigned* bar; unsigned x;
    volatile LAS unsigned* st;
};

__device__ __forceinline__ XcdBarrier xcd_barrier_post(unsigned* bar, volatile LAS unsigned* st) {
    XcdBarrier b; b.bar = bar; b.x = xb_xcc_id(); b.st = st;
    if (threadIdx.x == 0) (void)xb_add(&bar[XB_XCNT(b.x)], 1u);
    return b;
}
__device__ __forceinline__ void xcd_barrier_complete(unsigned* bar, unsigned x, unsigned& nloc, unsigned& nx) {
    const unsigned G = gridDim.x * gridDim.y * gridDim.z;
    unsigned sum, cnt, mine, sp = 0u;
    for (;;) {
        sum = 0u; cnt = 0u; mine = 0u;
#pragma unroll
        for (unsigned j = 0; j < 16; ++j) { const unsigned c = xb_ld(&bar[XB_XCNT(j)]); sum += c; cnt += (c > 0u) ? 1u : 0u; mine = (j == x) ? c : mine; }
        if (sum == G) break;
        __builtin_amdgcn_s_sleep(1);
        if ((++sp & 255u) == 0u) { if (xb_ld(&bar[XB_TMO])) break; if (sp > XB_SPIN_CAP) { atomicAdd(&bar[XB_TMO], 1u); break; } }
    }
    nloc = mine > 0u ? mine : 1u; nx = cnt > 0u ? cnt : 1u;
}

__device__ __forceinline__ void xcd_barrier(const XcdBarrier& b) {
    asm volatile("s_waitcnt vmcnt(0)" ::: "memory");
    __syncthreads();
    if (threadIdx.x == 0) {
        unsigned* bar = b.bar;
        __builtin_amdgcn_s_waitcnt(0);
        unsigned nloc = b.st[0], nx = b.st[1];
        if (nloc == 0u) { xcd_barrier_complete(bar, b.x, nloc, nx); b.st[0] = nloc; b.st[1] = nx; }
        const unsigned old = xb_add(&bar[XB_XSUB(b.x)], 1u);
        const unsigned gen = old / nloc;
        if (old + 1u == (gen + 1u) * nloc) {
            __builtin_amdgcn_fence(__ATOMIC_RELEASE, "agent");
            asm volatile("s_waitcnt vmcnt(0)" ::: "memory");
            const unsigned og = xb_add(&bar[XB_TOP], 1u);
            const unsigned tg = og / nx;
            if (og + 1u == (tg + 1u) * nx) xb_add(&bar[XB_TOPGEN], 1u);
            else XB_SPIN(xb_ld(&bar[XB_TOPGEN]) == tg, bar);
            __builtin_amdgcn_fence(__ATOMIC_ACQUIRE, "agent");
            xb_add(&bar[XB_XGEN(b.x)], 1u);
            asm volatile("s_waitcnt vmcnt(0)" ::: "memory");
        } else {
            XB_SPIN(xb_ld(&bar[XB_XGEN(b.x)]) == gen, bar);
            __builtin_amdgcn_fence(__ATOMIC_ACQUIRE, "agent");
            asm volatile("s_waitcnt vmcnt(0)" ::: "memory");
        }
    }
    __syncthreads();
}

__device__ __forceinline__ void transpose_item(const float* __restrict__ W, int K, int N, bf16* __restrict__ WT, int k0, int n0, int drow0, LAS float* scr, int lane) {
    const int kk0 = lane >> 4, nq = lane & 15;
#pragma unroll
    for (int half = 0; half < 2; ++half) {
        f32x4 v[8];
#pragma unroll
        for (int i = 0; i < 8; ++i) v[i] = *(const f32x4*)(W + (size_t)(k0 + (half * 8 + i) * 4 + kk0) * N + n0 + 4 * nq);
#pragma unroll
        for (int i = 0; i < 8; ++i) { LAS float* s = scr + ((half * 8 + i) * 4 + kk0) * 65 + 4 * nq; s[0] = v[i].x; s[1] = v[i].y; s[2] = v[i].z; s[3] = v[i].w; }
    }
    LDS_WAIT(); asm volatile("" ::: "memory");
    const int c = lane & 7;
#pragma unroll
    for (int j = 0; j < 8; ++j) { const int n = (lane >> 3) + 8 * j; const LAS float* s = scr + (8 * c) * 65 + n;
        u32x4 o; o.x = pk2(s[0 * 65], s[1 * 65]); o.y = pk2(s[2 * 65], s[3 * 65]); o.z = pk2(s[4 * 65], s[5 * 65]); o.w = pk2(s[6 * 65], s[7 * 65]);
        *(u32x4*)(WT + (size_t)(drow0 + n) * K + k0 + 8 * c) = o; }
    LDS_WAIT(); asm volatile("" ::: "memory");
}
template <bool COPY> __device__ __forceinline__ void rms_row(const float* __restrict__ src, const float* __restrict__ g, bf16* __restrict__ dst, float* __restrict__ cp, int lane) {
    const f32x4* s4 = (const f32x4*)src + lane; f32x4 v[16]; float ss = 0.f;
#pragma unroll
    for (int j = 0; j < 16; ++j) { v[j] = s4[64 * j]; ss += (v[j].x * v[j].x + v[j].y * v[j].y) + (v[j].z * v[j].z + v[j].w * v[j].w); }
    if (COPY) {
#pragma unroll
        for (int j = 0; j < 16; ++j) ((f32x4*)cp + lane)[64 * j] = v[j]; }
    ss = wave_sum(ss); const float rstd = 1.0f / sqrtf(ss * (1.0f / DM) + EPS);
    const f32x4* g4 = (const f32x4*)g + lane; u32x2* d2 = (u32x2*)dst + lane;
#pragma unroll
    for (int j = 0; j < 16; ++j) { const f32x4 gv = g4[64 * j]; u32x2 o; o.x = pk2(v[j].x * rstd * gv.x, v[j].y * rstd * gv.y); o.y = pk2(v[j].z * rstd * gv.z, v[j].w * rstd * gv.w); d2[64 * j] = o; }
}
__device__ __forceinline__ void zero_row(bf16* dst, float* cp, int lane) {
    u32x2* d2 = (u32x2*)dst + lane;
#pragma unroll
    for (int j = 0; j < 16; ++j) { d2[64 * j] = (u32x2){0u, 0u}; if (cp) ((f32x4*)cp + lane)[64 * j] = (f32x4){0.f, 0.f, 0.f, 0.f}; }
}

struct Ptrs {
    const float *x, *meta, *g_mix, *g_mlp, *wqkv, *qg, *kg, *lamv, *sg, *wo, *a_re, *a_im, *log_dt, *b_re, *b_im, *c_re, *c_im, *dsk, *wglu, *bglu, *wup, *wdn;
    float* out; unsigned char* ws;
};

__device__ __forceinline__ void p0_prologue(const Ptrs& P, LAS unsigned char* lds, int gw, int NGW, int wave, int lane) {
    LAS float* scr = (LAS float*)(lds + wave * 16640);
    bf16* Wqkv_t = (bf16*)(P.ws + WS_WQKV); bf16* Wo_t = (bf16*)(P.ws + WS_WO); bf16* Wglu_t = (bf16*)(P.ws + WS_WGLU); bf16* Wup_t = (bf16*)(P.ws + WS_WUP); bf16* Wdn_t = (bf16*)(P.ws + WS_WDN);
    constexpr int I_QKV = 64 * 192, I_O = 64 * 64, I_GLU = 64 * 128, I_UP = 64 * 256, I_DN = 256 * 64;
    constexpr int NITEMS = I_QKV + I_O + I_GLU + 2 * I_UP + 2 * I_DN;
    for (int it = gw; it < NITEMS; it += NGW) {
        int r = it;
        if (r < I_QKV) { const int kb = r / 192, nb = r % 192; transpose_item(P.wqkv, DM, 3 * DM, Wqkv_t, 64 * kb, 64 * nb, 64 * nb, scr, lane); continue; } r -= I_QKV;
        if (r < I_O) { const int kb = r / 64, nb = r % 64; transpose_item(P.wo, DM, DM, Wo_t, 64 * kb, 64 * nb, 64 * nb, scr, lane); continue; } r -= I_O;
        if (r < I_GLU) { const int kb = r / 128, nb = r % 128, n0 = 64 * nb, hf = n0 / DM, f0 = n0 % DM; transpose_item(P.wglu, DM, 2 * DM, Wglu_t, 64 * kb, n0, 256 * (f0 / 128) + 128 * hf + (f0 % 128), scr, lane); continue; } r -= I_GLU;
        if (r < 2 * I_UP) { const int l = r / I_UP; r -= l * I_UP; const int kb = r / 256, nb = r % 256; transpose_item(P.wup + (size_t)l * DM * FF, DM, FF, Wup_t + (size_t)l * DM * FF, 64 * kb, 64 * nb, 64 * nb, scr, lane); continue; } r -= 2 * I_UP;
        { const int l = r / I_DN; r -= l * I_DN; const int kb = r / 64, nb = r % 64; transpose_item(P.wdn + (size_t)l * DM * FF, FF, DM, Wdn_t + (size_t)l * DM * FF, 64 * kb, 64 * nb, 64 * nb, scr, lane); }
    }
    float* H = (float*)(P.ws + WS_H); bf16* HN = (bf16*)(P.ws + WS_HN);
    for (int m = gw; m < MP; m += NGW) {
        if (m < MX) rms_row<true>(P.x + (size_t)m * DM, P.g_mix, HN + (size_t)m * DM, H + (size_t)m * DM, lane);
        else if (m < MX + NMETA) rms_row<true>(P.meta + (size_t)(m - MX) * DM, P.g_mix, HN + (size_t)m * DM, H + (size_t)m * DM, lane);
        else zero_row(HN + (size_t)m * DM, H + (size_t)m * DM, lane);
    }
    for (int it = gw; it < 3 * 64 * (SKVP - LPOS); it += NGW) { const int t = it / (64 * (SKVP - LPOS)), r2 = it % (64 * (SKVP - LPOS)), bh = r2 / (SKVP - LPOS), pp = LPOS + r2 % (SKVP - LPOS);
        bf16* base = (bf16*)(P.ws + WS_Q + (size_t)t * QKV_T_BYTES) + ((size_t)bh * SKVP + pp) * DH; ((unsigned*)base)[lane] = 0u; }
}

__device__ __forceinline__ void norm_phase(const float* H, const float* g, bf16* HN, int nrows, int gw, int NGW, int lane) {
    for (int m = gw; m < nrows; m += NGW) rms_row<false>(H + (size_t)m * DM, g, HN + (size_t)m * DM, nullptr, lane);
}

__device__ __forceinline__ void qk_rope_phase(bf16* Q, bf16* K, const float* qg, const float* kg, int gw, int NGW, int lane) {
    const int j16 = lane & 15, rr = lane >> 4;
    float inv[4];
#pragma unroll
    for (int t = 0; t < 4; ++t) inv[t] = exp2f(-(float)(2 * (4 * j16 + t)) * (13.287712379549449f / 128.0f));
    for (int item = gw; item < NB * LPOS; item += NGW) {
        const int b = item / LPOS, p = item % LPOS;
        float cs[4], sn[4];
#pragma unroll
        for (int t = 0; t < 4; ++t) { const float ang = (float)p * inv[t]; cs[t] = cosf(ang); sn[t] = sinf(ang); }
#pragma unroll 1
        for (int ten = 0; ten < 2; ++ten) {
            bf16* T = ten ? K : Q; const float* g = ten ? kg : qg;
            const f32x4 g1 = *(const f32x4*)(g + 4 * j16), g2 = *(const f32x4*)(g + 64 + 4 * j16);
#pragma unroll 2
            for (int ps = 0; ps < 8; ++ps) {
                const int sh = ps * 4 + rr;
                bf16* row = T + ((size_t)(b * NSH + sh) * SKVP + p) * DH;
                const u32x2 a = *(const u32x2*)(row + 4 * j16), c = *(const u32x2*)(row + 64 + 4 * j16);
                float x1[4] = {bflo(a.x), bfhi(a.x), bflo(a.y), bfhi(a.y)}, x2[4] = {bflo(c.x), bfhi(c.x), bflo(c.y), bfhi(c.y)};
                float ss = 0.f;
#pragma unroll
                for (int t = 0; t < 4; ++t) ss += x1[t] * x1[t] + x2[t] * x2[t];
                ss += __shfl_xor(ss, 1); ss += __shfl_xor(ss, 2); ss += __shfl_xor(ss, 4); ss += __shfl_xor(ss, 8);
                const float rstd = 1.0f / sqrtf(ss * (1.0f / DH) + EPS);
                float o1[4], o2[4];
#pragma unroll
                for (int t = 0; t < 4; ++t) { const float y1 = x1[t] * rstd * g1[t], y2 = x2[t] * rstd * g2[t]; o1[t] = y1 * cs[t] - y2 * sn[t]; o2[t] = y2 * cs[t] + y1 * sn[t]; }
                *(u32x2*)(row + 4 * j16) = (u32x2){pk2(o1[0], o1[1]), pk2(o1[2], o1[3])};
                *(u32x2*)(row + 64 + 4 * j16) = (u32x2){pk2(o2[0], o2[1]), pk2(o2[2], o2[3])};
            }
        }
    }
}

typedef ab::BlockRef<ab::bf16, ab::bf16> ARef;
__device__ __forceinline__ ARef attn_ref(int L, int pass, const bf16* Q, const bf16* K, const bf16* V, bf16* O) {
    const int inst = L >> 4, x = L & 15, qb = pass ? 31 - x : x;
    const int b = inst >> 6, h = (inst >> 2) & 15, c = (inst >> 1) & 1, vh = inst & 1;
    ARef r;
    r.Q = Q + ((size_t)(b * NSH + 2 * h + c) * SKVP + NMETA + 256 * qb) * DH;
    r.K = K + (size_t)(b * NSH + 2 * h + c) * SKVP * DH;
    r.V = V + (size_t)(b * NSH + 2 * h + vh) * SKVP * DH;
    r.O = O + ((size_t)inst * SEQ + 256 * qb) * DH;
    r.P0 = NMETA + 256 * qb;
    return r;
}
__device__ __forceinline__ void attn_phase(char* lds, const bf16* Q, const bf16* K, const bf16* V, bf16* O, int vcu, int G) {
    constexpr int TOTAL = 128 * 16, W = 1 << 30;
    int L = vcu; if (L >= TOTAL) return;
    int pass = 0;
    ARef cur = attn_ref(L, 0, Q, K, V, O);
    ab::Seam<ab::bf16> S;
    ab::causal_swa_prime<ab::bf16, ab::bf16>(cur, W, lds, S);
    for (;;) {
        const bool more_pass = pass == 0, more_item = L + G < TOTAL, last = !more_pass && !more_item;
        int passn = pass + 1, Ln = L;
        if (!more_pass) { passn = 0; Ln = more_item ? L + G : L; }
        const ARef nxt = last ? cur : attn_ref(Ln, passn, Q, K, V, O);
        ab::causal_swa_block<ab::bf16, ab::bf16>(cur, nxt, SKVP, W, lds, S);
        if (last) break;
        cur = nxt; pass = passn; L = Ln;
    }
}

__device__ __forceinline__ void combine_phase(const Ptrs& P, int gw, int NGW, int lane) {
    const bf16* Ob = (const bf16*)(P.ws + WS_O); bf16* ATTO = (bf16*)(P.ws + WS_ATTO);
    const bf16* Qb = (const bf16*)(P.ws + WS_Q); const bf16* Kb = (const bf16*)(P.ws + WS_K); const bf16* Vb = (const bf16*)(P.ws + WS_V);
    float lam; { const float s1 = wave_sum(P.lamv[lane] * P.lamv[128 + lane] + P.lamv[64 + lane] * P.lamv[192 + lane]);
                 const float s2 = wave_sum(P.lamv[256 + lane] * P.lamv[384 + lane] + P.lamv[320 + lane] * P.lamv[448 + lane]); lam = expf(s1) - expf(s2) + 0.2f; }
    const f32x4 sgv = *(const f32x4*)(P.sg + 4 * lane);
    const int vh = lane >> 5, d = (lane & 31) * 4;
    for (int r = gw; r < MX; r += NGW) {
        const int b = r >> 13, i = r & (SEQ - 1);
#pragma unroll 4
        for (int h = 0; h < NH; ++h) {
            const int inst0 = ((b * NH + h) * 2 + 0) * 2 + vh;
            const u32x2 a = *(const u32x2*)(Ob + ((size_t)inst0 * SEQ + i) * DH + d), c = *(const u32x2*)(Ob + ((size_t)(inst0 + 2) * SEQ + i) * DH + d);
            float v[4] = {bflo(a.x) - lam * bflo(c.x), bfhi(a.x) - lam * bfhi(c.x), bflo(a.y) - lam * bflo(c.y), bfhi(a.y) - lam * bfhi(c.y)};
            const float ss = wave_sum((v[0] * v[0] + v[1] * v[1]) + (v[2] * v[2] + v[3] * v[3]));
            const float rs = 0.8f / sqrtf(ss * (1.0f / 256.0f) + EPS);
            *(u32x2*)(ATTO + (size_t)r * DM + h * 256 + 4 * lane) = (u32x2){pk2(v[0] * rs * sgv.x, v[1] * rs * sgv.y), pk2(v[2] * rs * sgv.z, v[3] * rs * sgv.w)};
        }
    }
    for (int t = gw; t < NMETA * NH; t += NGW) {
        const int qi = t >> 4, h = t & 15, j = lane & 15, part = lane >> 4;
        float am = 0.f;
#pragma unroll
        for (int c = 0; c < 2; ++c) {
            const bf16* qrow = Qb + ((size_t)(2 * h + c) * SKVP + qi) * DH + part * 32; const bf16* krow = Kb + ((size_t)(2 * h + c) * SKVP + j) * DH + part * 32;
            float s = 0.f;
#pragma unroll
            for (int e = 0; e < 4; ++e) { const u32x4 qv = *(const u32x4*)(qrow + 8 * e), kv = *(const u32x4*)(krow + 8 * e);
                s += bflo(qv.x) * bflo(kv.x) + bfhi(qv.x) * bfhi(kv.x) + bflo(qv.y) * bflo(kv.y) + bfhi(qv.y) * bfhi(kv.y) + bflo(qv.z) * bflo(kv.z) + bfhi(qv.z) * bfhi(kv.z) + bflo(qv.w) * bflo(kv.w) + bfhi(qv.w) * bfhi(kv.w); }
            s += __shfl_xor(s, 16); s += __shfl_xor(s, 32);
            s = (j <= qi) ? s * 0.08838834764831845f : -__builtin_inff();
            float mx = s; mx = fmaxf(mx, __shfl_xor(mx, 1)); mx = fmaxf(mx, __shfl_xor(mx, 2)); mx = fmaxf(mx, __shfl_xor(mx, 4)); mx = fmaxf(mx, __shfl_xor(mx, 8));
            const float e_ = expf(s - mx); float sm = e_; sm += __shfl_xor(sm, 1); sm += __shfl_xor(sm, 2); sm += __shfl_xor(sm, 4); sm += __shfl_xor(sm, 8);
            const float p_ = e_ / sm; am = c == 0 ? p_ : am - lam * p_;
        }
        float o[4] = {0.f, 0.f, 0.f, 0.f};
        for (int jj = 0; jj <= qi; ++jj) { const float aj = __shfl(am, jj); const u32x2 vv = *(const u32x2*)(Vb + ((size_t)(2 * h + vh) * SKVP + jj) * DH + d);
            o[0] += aj * bflo(vv.x); o[1] += aj * bfhi(vv.x); o[2] += aj * bflo(vv.y); o[3] += aj * bfhi(vv.y); }
        const float ss = wave_sum((o[0] * o[0] + o[1] * o[1]) + (o[2] * o[2] + o[3] * o[3]));
        const float rs = 0.8f / sqrtf(ss * (1.0f / 256.0f) + EPS);
        *(u32x2*)(ATTO + (size_t)(MX + qi) * DM + h * 256 + 4 * lane) = (u32x2){pk2(o[0] * rs * sgv.x, o[1] * rs * sgv.y), pk2(o[2] * rs * sgv.z, o[3] * rs * sgv.w)};
    }
    for (int m = MX + NMETA + gw; m < MP; m += NGW) zero_row(ATTO + (size_t)m * DM, nullptr, lane);
}

__device__ __forceinline__ f32x2 cpowf2(float dar, float dai, int tau) { const float m = expf((float)tau * dar), a = (float)tau * dai; return (f32x2){m * cosf(a), m * sinf(a)}; }
template <int CTRL, bool BC> __device__ __forceinline__ float dppf(float x) { return __builtin_bit_cast(float, __builtin_amdgcn_update_dpp(0, __builtin_bit_cast(int, x), CTRL, 0xF, 0xF, BC)); }
__device__ __forceinline__ f32x4 cmul_add2(f32x4 w, f32x4 v, f32x4 acc) {
    acc.x += w.x * v.x - w.y * v.y; acc.y += w.x * v.y + w.y * v.x; acc.z += w.z * v.z - w.w * v.w; acc.w += w.z * v.w + w.w * v.z; return acc; }
template <int CTRL, bool BC> __device__ __forceinline__ f32x4 dpp4(f32x4 v) { return (f32x4){dppf<CTRL, BC>(v.x), dppf<CTRL, BC>(v.y), dppf<CTRL, BC>(v.z), dppf<CTRL, BC>(v.w)}; }

__device__ __forceinline__ void s5_load_u(bf16x8 (&uf)[8], const bf16* rowbase  , int fq) {
#pragma unroll
    for (int kt = 0; kt < 8; ++kt) uf[kt] = *(const bf16x8*)(rowbase + (size_t)(2 * kt + (fq >> 1)) * DM + 8 * (fq & 1));
}
__device__ __forceinline__ void s5_bmat(f32x4 (&Lc)[8], const bf16x8 (&uf)[8], LAS unsigned char* bfr  ) {
#pragma unroll
    for (int mt = 0; mt < 8; ++mt) Lc[mt] = (f32x4){0.f, 0.f, 0.f, 0.f};
#pragma unroll
    for (int ks = 0; ks < 8; ++ks) { asm volatile("" ::: "memory");
#pragma unroll
        for (int mt = 0; mt < 8; ++mt) Lc[mt] = __builtin_amdgcn_mfma_f32_16x16x32_bf16(*(const LAS bf16x8*)(bfr + (mt * 8 + ks) * 1024), uf[ks], Lc[mt], 0, 0, 0); }
}
__device__ __forceinline__ void s5_scan(f32x4 (&Lc)[8], const LAS f32x4* wp  ) {
    asm volatile("" ::: "memory");
#pragma unroll
    for (int mt = 0; mt < 8; ++mt) { Lc[mt] = cmul_add2(wp[0 * 32 + mt * 4], dpp4<0x111, true>(Lc[mt]), Lc[mt]); }
    asm volatile("" ::: "memory");
#pragma unroll
    for (int mt = 0; mt < 8; ++mt) { Lc[mt] = cmul_add2(wp[1 * 32 + mt * 4], dpp4<0x112, true>(Lc[mt]), Lc[mt]); }
    asm volatile("" ::: "memory");
#pragma unroll
    for (int mt = 0; mt < 8; ++mt) { Lc[mt] = cmul_add2(wp[2 * 32 + mt * 4], dpp4<0x114, true>(Lc[mt]), Lc[mt]); }
    asm volatile("" ::: "memory");
#pragma unroll
    for (int mt = 0; mt < 8; ++mt) { Lc[mt] = cmul_add2(wp[3 * 32 + mt * 4], dpp4<0x118, true>(Lc[mt]), Lc[mt]); }
}

__device__ __forceinline__ void dbg4(float* dbg, int comp0, int fr, f32x4 v, bool dd) { if (dd) { float* p = dbg; asm volatile("" : "+v"(p)); p += comp0 * 16 + fr; p[0] = v.x; p[16] = v.y; p[32] = v.z; p[48] = v.w; } }
template <int DUMP> __device__ __forceinline__ void s5_tile(unsigned char* ws, const bf16* HN, bf16* Z, int b, int tl, int g, int fr, int fq, f32x4 (&carry)[8],
        LAS unsigned char* bfr, LAS unsigned char* cfr, LAS unsigned char* ktb, const LAS f32x4* wp, const LAS f32x4* cpw, const LAS f32x4* a256) {
                bf16x8 uf[8]; f32x4 Lc[8];
                const size_t row0 = (size_t)b * SEQ + (size_t)(16 * tl + fr) * 16;
                s5_load_u(uf, HN + row0 * DM + g * SGS, fq); s5_bmat(Lc, uf, bfr);
#if defined(CHK) && CHK
                float* dbg = (float*)(ws + WS_END + 8 * MiB); constexpr int dm = DUMP; const bool dd = (g == 37 && b == 0 && tl == 5);
                if constexpr ((dm & 1) != 0) {
_Pragma("unroll") for (int mt = 0; mt < 8; ++mt) dbg4(dbg, 0 * 128 + 16 * mt + 4 * fq, fr, Lc[mt], dd); }
#endif
                s5_scan(Lc, wp);
#if defined(CHK) && CHK
                if constexpr ((dm & 2) != 0) {
_Pragma("unroll") for (int mt = 0; mt < 8; ++mt) { dbg4(dbg, 1 * 128 + 16 * mt + 4 * fq, fr, Lc[mt], dd); dbg4(dbg, 3 * 128 + 16 * mt + 4 * fq, fr, carry[mt], dd); } }
#endif
                bf16x8 sf[4]; asm volatile("" ::: "memory");
#pragma unroll
                for (int ks = 0; ks < 4; ++ks) { f32x4 s0 = cmul_add2(cpw[(2 * ks) * 4], carry[2 * ks], dpp4<0x111, true>(Lc[2 * ks])), s1 = cmul_add2(cpw[(2 * ks + 1) * 4], carry[2 * ks + 1], dpp4<0x111, true>(Lc[2 * ks + 1]));
                    const u32x4 w = (u32x4){pk2(s0.x, s0.y), pk2(s0.z, s0.w), pk2(s1.x, s1.y), pk2(s1.z, s1.w)}; sf[ks] = __builtin_bit_cast(bf16x8, w);
#if defined(CHK) && CHK
                    if constexpr ((dm & 4) != 0) {
#if CHK_ALT == 1
                        const f32x4 d0 = dpp4<0x111, true>(Lc[2 * ks]), d1 = dpp4<0x111, true>(Lc[2 * ks + 1]);
#elif CHK_ALT == 2
                        const f32x4 d0 = s0 - dpp4<0x111, true>(Lc[2 * ks]), d1 = s1 - dpp4<0x111, true>(Lc[2 * ks + 1]);
#elif CHK_ALT == 3
                        const f32x4 d0 = carry[2 * ks], d1 = carry[2 * ks + 1];
#else
                        const f32x4 d0 = s0, d1 = s1;
#endif
                        dbg4(dbg, 2 * 128 + 16 * (2 * ks) + 4 * fq, fr, d0, dd); dbg4(dbg, 2 * 128 + 16 * (2 * ks + 1) + 4 * fq, fr, d1, dd); }
#endif
                }
                asm volatile("" ::: "memory");
#pragma unroll
                for (int mt = 0; mt < 8; ++mt) carry[mt] = cmul_add2(a256[mt * 4], carry[mt], dpp4<0x15F, false>(Lc[mt]));
                bf16* zrow = Z + row0 * DM + g * SGS + 4 * fq;
#pragma unroll
                for (int hf = 0; hf < 2; ++hf) {
                    f32x4 Y[8];
#pragma unroll
                    for (int m8 = 0; m8 < 8; ++m8) Y[m8] = (f32x4){0.f, 0.f, 0.f, 0.f};
#pragma unroll
                    for (int ks = 0; ks < 4; ++ks) { asm volatile("" ::: "memory");
#pragma unroll
                        for (int m8 = 0; m8 < 8; ++m8) Y[m8] = __builtin_amdgcn_mfma_f32_16x16x32_bf16(*(const LAS bf16x8*)(cfr + ((8 * hf + m8) * 4 + ks) * 1024), sf[ks], Y[m8], 0, 0, 0); }
#if defined(CHK) && CHK
                    if constexpr ((dm & 8) != 0) {
_Pragma("unroll") for (int m8 = 0; m8 < 8; ++m8) dbg4(dbg, 4 * 128 + 16 * (8 * hf + m8) + 4 * fq, fr, Y[m8], dd); }
#endif
#pragma unroll
                    for (int kt = 0; kt < 4 * hf + 4; ++kt) { asm volatile("" ::: "memory");
#pragma unroll
                        for (int m8 = 0; m8 < 8; ++m8) { const int mt = 8 * hf + m8; if (mt < 2 * kt) continue;
                            bf16x8 a = *(const LAS bf16x8*)(ktb + (mt - 2 * kt) * 512);
                            if (mt == 2 * kt && fq >= 2) a = (bf16x8){0, 0, 0, 0, 0, 0, 0, 0};
                            Y[m8] = __builtin_amdgcn_mfma_f32_16x16x32_bf16(a, uf[kt], Y[m8], 0, 0, 0); } }
#if defined(CHK) && CHK
                    if constexpr ((dm & 16) != 0) {
_Pragma("unroll") for (int m8 = 0; m8 < 8; ++m8) dbg4(dbg, 6 * 128 + 16 * (8 * hf + m8) + 4 * fq, fr, Y[m8], dd); }
#endif
#pragma unroll
                    for (int m8 = 0; m8 < 8; ++m8) { float o[4];
#pragma unroll
                        for (int i = 0; i < 4; ++i) { const float y = Y[m8][i]; o[i] = y * __builtin_amdgcn_rcpf(1.0f + __builtin_amdgcn_exp2f(-2.3022082f * (y + 0.044715f * y * y * y))); }
                        *(u32x2*)(zrow + (size_t)(8 * hf + m8) * DM) = (u32x2){pk2(o[0], o[1]), pk2(o[2], o[3])}; }
                }
}
template <int DMASK> __device__ __forceinline__ void s5_phase(const Ptrs& P, LAS unsigned char* lds, int vcu, int G, int tid) {
    const int wave = __builtin_amdgcn_readfirstlane(tid >> 6), lane = tid & 63, fr = lane & 15, fq = lane >> 4;
    const bf16* HN = (const bf16*)(P.ws + WS_HN); bf16* Z = (bf16*)(P.ws + WS_ATTO);
    for (int g = vcu; g < SG; g += G) {
        __syncthreads();
        const float dt = expf(P.log_dt[g]);
        LAS f32x2* Apow = (LAS f32x2*)(lds + S5_F);
        LAS f32x2* Bbar = (LAS f32x2*)(lds + S5_CFRAG);
        for (int e = tid; e < 17 * 64; e += 512) { const int tau = e >> 6, p = e & 63; Apow[e] = cpowf2(dt * P.a_re[g * SP + p], dt * P.a_im[g * SP + p], tau); }
        for (int e = tid; e < SP * SGS; e += 512) { const int p = e >> 4;
            const float ar = P.a_re[g * SP + p], ai = P.a_im[g * SP + p]; const f32x2 ab_ = cpowf2(dt * ar, dt * ai, 1);
            const float nr = ab_.x - 1.0f, ni = ab_.y, den = ar * ar + ai * ai, fre = (nr * ar + ni * ai) / den, fim = (ni * ar - nr * ai) / den;
            const float br = P.b_re[(size_t)g * SP * SGS + e], bi = P.b_im[(size_t)g * SP * SGS + e];
            Bbar[e] = (f32x2){fre * br - fim * bi, fre * bi + fim * br}; }
        __syncthreads();
        for (int f = tid; f < 4096; f += 512) {
            const int l2 = f & 63, ks = (f >> 6) & 7, mt = f >> 9, comp = 16 * mt + (l2 & 15), p = comp >> 1, ri = comp & 1; float v[8];
#pragma unroll
            for (int j = 0; j < 8; ++j) { const int k = 32 * ks + 8 * (l2 >> 4) + j, s = k >> 4, hh = k & 15; const f32x2 pw = Apow[(15 - s) * 64 + p], bb = Bbar[p * 16 + hh];
                v[j] = ri ? (pw.x * bb.y + pw.y * bb.x) : (pw.x * bb.x - pw.y * bb.y); }
            *(LAS u32x4*)(lds + S5_BFRAG + f * 16) = (u32x4){pk2(v[0], v[1]), pk2(v[2], v[3]), pk2(v[4], v[5]), pk2(v[6], v[7])}; }
        for (int e = tid; e < 4096; e += 512) {
            const int hp = e & 15, h = (e >> 4) & 15, tau = e >> 8; float acc = 0.f;
            const float* cr = P.c_re + ((size_t)g * SGS + h) * SP; const float* ci = P.c_im + ((size_t)g * SGS + h) * SP;
            for (int p = 0; p < SP; ++p) { const f32x2 pw = Apow[tau * 64 + p], bb = Bbar[p * 16 + hp]; const float wr_ = pw.x * bb.x - pw.y * bb.y, wi_ = pw.x * bb.y + pw.y * bb.x; acc += cr[p] * wr_ - ci[p] * wi_; }
            if (tau == 0 && h == hp) acc += P.dsk[g * SGS + h];
            ((LAS bf16*)(lds + S5_KTAB))[e] = (bf16)(pk2(acc, 0.f) & 0xffffu); }
        for (int e = tid; e < 16 * 64 + 4 * 64 + 64 + 64; e += 512) {
            int tau, off; const int p = e & 63;
            if (e < 1024) { tau = 16 * (e >> 6); off = S5_CPOW + e * 8; } else if (e < 1280) { tau = 16 << ((e - 1024) >> 6); off = S5_WPOW + (e - 1024) * 8; }
            else if (e < 1344) { tau = 256; off = S5_A256 + p * 8; } else { tau = 1024; off = S5_A1024 + p * 8; }
            *(LAS f32x2*)(lds + off) = cpowf2(dt * P.a_re[g * SP + p], dt * P.a_im[g * SP + p], tau); }
        __syncthreads();
        for (int f = tid; f < 4096; f += 512) {
            const int l2 = f & 63, ks = (f >> 6) & 3, mt = f >> 8, h = l2 & 15; float v[8];
            const float* cr = P.c_re + ((size_t)g * SGS + h) * SP; const float* ci = P.c_im + ((size_t)g * SGS + h) * SP;
#pragma unroll
            for (int j = 0; j < 8; ++j) { const int comp = 16 * (2 * ks + (j >> 2)) + 4 * (l2 >> 4) + (j & 3), p = comp >> 1, ri = comp & 1; const f32x2 pw = Apow[(mt + 1) * 64 + p];
                v[j] = ri ? (-cr[p] * pw.y - ci[p] * pw.x) : (cr[p] * pw.x - ci[p] * pw.y); }
            *(LAS u32x4*)(lds + S5_CFRAG + f * 16) = (u32x4){pk2(v[0], v[1]), pk2(v[2], v[3]), pk2(v[4], v[5]), pk2(v[6], v[7])}; }
        __syncthreads();
        LAS unsigned char* bfr = lds + S5_BFRAG + lane * 16; LAS unsigned char* cfr = lds + S5_CFRAG + lane * 16;
        LAS unsigned char* ktb = lds + S5_KTAB + ((fr * 16 + 8 * (fq & 1)) * 2) - (fq >> 1) * 512;
        const LAS f32x4* wp = (const LAS f32x4*)(lds + S5_WPOW) + fq;
        const LAS f32x4* cpw = (const LAS f32x4*)(lds + S5_CPOW) + fr * 32 + fq;
        const LAS f32x4* a256 = (const LAS f32x4*)(lds + S5_A256) + fq; const LAS f32x4* a1024 = (const LAS f32x4*)(lds + S5_A1024) + fq;
        LAS f32x4* Fw = (LAS f32x4*)(lds + S5_F); LAS f32x4* Em = (LAS f32x4*)(lds + S5_EMETA);
        bf16x8 uf[8]; f32x4 Lc[8];
        if (wave == 0) {
            s5_load_u(uf, HN + (size_t)MX * DM + g * SGS, fq); s5_bmat(Lc, uf, bfr);
            if (fr == 0) {
#pragma unroll
                for (int mt = 0; mt < 8; ++mt) Em[mt * 4 + fq] = Lc[mt]; }
        }
#pragma unroll 1
        for (int b = 0; b < NB; ++b) {
            f32x4 seg[8];
#pragma unroll
            for (int mt = 0; mt < 8; ++mt) seg[mt] = (f32x4){0.f, 0.f, 0.f, 0.f};
#pragma unroll 1
            for (int tl = 4 * wave; tl < 4 * wave + 4; ++tl) {
                s5_load_u(uf, HN + ((size_t)b * SEQ + (size_t)(16 * tl + fr) * 16) * DM + g * SGS, fq); s5_bmat(Lc, uf, bfr); s5_scan(Lc, wp);
                asm volatile("" ::: "memory");
#pragma unroll
                for (int mt = 0; mt < 8; ++mt) seg[mt] = cmul_add2(a256[mt * 4], seg[mt], dpp4<0x15F, false>(Lc[mt]));
            }
            if (fr == 0) {
#pragma unroll
                for (int mt = 0; mt < 8; ++mt) Fw[(b * 8 + wave) * 32 + mt * 4 + fq] = seg[mt]; }
            __syncthreads();
            f32x4 carry[8];
#pragma unroll
            for (int mt = 0; mt < 8; ++mt) carry[mt] = Em[mt * 4 + fq];
            for (int w2 = 0; w2 < wave; ++w2) {
#pragma unroll
                for (int mt = 0; mt < 8; ++mt) carry[mt] = cmul_add2(a1024[mt * 4], carry[mt], Fw[(b * 8 + w2) * 32 + mt * 4 + fq]); }
#pragma unroll 1
            for (int tl = 4 * wave; tl < 4 * wave + 4; ++tl) {
                                s5_tile<DMASK>(P.ws, HN, Z, b, tl, g, fr, fq, carry, bfr, cfr, ktb, wp, cpw, a256);
            }
        }
    }
}

#ifndef PH_ALL
#define PH_ALL 1
#endif
#ifndef PH_P0
#define PH_P0 PH_ALL
#endif
#ifndef PH_QKV
#define PH_QKV PH_ALL
#endif
#ifndef PH_ROPE
#define PH_ROPE PH_ALL
#endif
#ifndef PH_ATTN
#define PH_ATTN PH_ALL
#endif
#ifndef PH_COMB
#define PH_COMB PH_ALL
#endif
#ifndef PH_WO
#define PH_WO PH_ALL
#endif
#ifndef PH_NORM
#define PH_NORM PH_ALL
#endif
#ifndef PH_UP
#define PH_UP PH_ALL
#endif
#ifndef PH_DN
#define PH_DN PH_ALL
#endif
#ifndef PH_S5
#define PH_S5 PH_ALL
#endif
#ifndef PH_GLU
#define PH_GLU PH_ALL
#endif
struct Args { const float* in[22]; float* out; unsigned char* ws; int ph_lo, ph_hi; };
__device__ __forceinline__ Ptrs load_ptrs() {
    const __attribute__((address_space(4))) Args* ap = (const __attribute__((address_space(4))) Args*)__builtin_amdgcn_kernarg_segment_ptr();
    asm volatile("" : "+s"(ap));
    Ptrs P;
    P.x = ap->in[0]; P.meta = ap->in[1]; P.g_mix = ap->in[2]; P.g_mlp = ap->in[3]; P.wqkv = ap->in[4]; P.qg = ap->in[5]; P.kg = ap->in[6]; P.lamv = ap->in[7]; P.sg = ap->in[8]; P.wo = ap->in[9];
    P.a_re = ap->in[10]; P.a_im = ap->in[11]; P.log_dt = ap->in[12]; P.b_re = ap->in[13]; P.b_im = ap->in[14]; P.c_re = ap->in[15]; P.c_im = ap->in[16]; P.dsk = ap->in[17]; P.wglu = ap->in[18]; P.bglu = ap->in[19];
    P.wup = ap->in[20]; P.wdn = ap->in[21]; P.out = ap->out; P.ws = ap->ws;
    return P;
}
#define PHASE_VARS() const Ptrs P = load_ptrs(); int tid = tid_fresh(); const int lane = tid & 63, wave = __builtin_amdgcn_readfirstlane(tid >> 6); \
    const int G = gridDim.x, bx = blockIdx.x, vcu = (G % 8 == 0) ? (bx % 8) * (G / 8) + bx / 8 : bx; const int gw = vcu * 8 + wave, NGW = G * 8; (void)lane; (void)gw; (void)NGW; (void)vcu; \
    float* H = (float*)(P.ws + WS_H); bf16* HN = (bf16*)(P.ws + WS_HN); bf16* ATTO = (bf16*)(P.ws + WS_ATTO); bf16* MID = (bf16*)(P.ws + WS_MID); \
    bf16* Qb = (bf16*)(P.ws + WS_Q); bf16* Kb = (bf16*)(P.ws + WS_K); bf16* Vb = (bf16*)(P.ws + WS_V); bf16* Ob = (bf16*)(P.ws + WS_O); \
    const bf16* Wqkv_t = (const bf16*)(P.ws + WS_WQKV); const bf16* Wo_t = (const bf16*)(P.ws + WS_WO); const bf16* Wglu_t = (const bf16*)(P.ws + WS_WGLU); \
    const bf16* Wup_t = (const bf16*)(P.ws + WS_WUP); const bf16* Wdn_t = (const bf16*)(P.ws + WS_WDN); \
    (void)H; (void)HN; (void)ATTO; (void)MID; (void)Qb; (void)Kb; (void)Vb; (void)Ob; (void)Wqkv_t; (void)Wo_t; (void)Wglu_t; (void)Wup_t; (void)Wdn_t;

__global__ void __launch_bounds__(512, 2) fwd_kernel(Args args) {
    extern __shared__ __attribute__((aligned(16))) unsigned char lds_raw[];
    LAS unsigned char* lds = (LAS unsigned char*)lds_raw;
    (void)args;
    int ph_lo_, ph_hi_; { const __attribute__((address_space(4))) Args* ap = (const __attribute__((address_space(4))) Args*)__builtin_amdgcn_kernarg_segment_ptr(); ph_lo_ = ap->ph_lo; ph_hi_ = ap->ph_hi; }
#define RUN(k) (ph_lo_ <= (k) && (k) < ph_hi_)
    XcdBarrier bar;
    { PHASE_VARS();
      volatile LAS unsigned* MISC = (volatile LAS unsigned*)(lds + MISC_OFF);
      if (tid < 32) MISC[tid] = 0u;
      __syncthreads();
      bar = xcd_barrier_post((unsigned*)(P.ws + WS_CTL) + CW_BAR, MISC + 8); }

#if PH_P0
    if (RUN(0)) {
    { PHASE_VARS(); p0_prologue(P, lds, gw, NGW, wave, lane); }
    }
#endif
    if (RUN(0) && RUN(1)) xcd_barrier(bar);
#if PH_QKV
    if (RUN(1)) {
    { PHASE_VARS(); pg8::Gemm g{HN, Wqkv_t, MP, 3 * DM, DM}; pg8::StaticOrder S; S.init(MP, 3 * DM, G, bx); pg8::EpiQKV E{Qb, QKV_T_BYTES / 2};
      pg8::gemm_phase<pg8::EpiQKV, pg8::StaticOrder, true, true>(lds, g, S, E); }
    }
#endif
    if (RUN(1) && RUN(2)) xcd_barrier(bar);
#if PH_ROPE
    if (RUN(2)) {
    { PHASE_VARS(); qk_rope_phase(Qb, Kb, P.qg, P.kg, gw, NGW, lane); }
    }
#endif
    if (RUN(2) && RUN(3)) xcd_barrier(bar);
#if PH_ATTN
    if (RUN(3)) {
    { PHASE_VARS(); attn_phase((char*)lds_raw, Qb, Kb, Vb, Ob, vcu, G); }
    }
#endif
    if (RUN(3) && RUN(4)) xcd_barrier(bar);
#if PH_COMB
    if (RUN(4)) {
    { PHASE_VARS(); combine_phase(P, gw, NGW, lane); }
    }
#endif
    if (RUN(4) && RUN(5)) xcd_barrier(bar);
#if PH_WO
    if (RUN(5)) {
    { PHASE_VARS(); pg8::Gemm g{ATTO, Wo_t, MP, DM, DM}; pg8::StaticOrder S; S.init(MP, DM, G, bx); pg8::EpiRes E{H, H};
      pg8::gemm_phase<pg8::EpiRes, pg8::StaticOrder, true, true>(lds, g, S, E); }
    }
#endif
    if (RUN(5) && RUN(6)) xcd_barrier(bar);
#if PH_NORM
    if (RUN(6)) {
    { PHASE_VARS(); norm_phase(H, P.g_mlp, HN, MP, gw, NGW, lane); }
    }
#endif
    if (RUN(6) && RUN(7)) xcd_barrier(bar);
#if PH_UP
    if (RUN(7)) {
    { PHASE_VARS(); pg8::Gemm g{HN, Wup_t, MP, FF, DM}; pg8::StaticOrder S; S.init(MP, FF, G, bx); pg8::EpiRelu2 E{MID, FF};
      pg8::gemm_phase<pg8::EpiRelu2, pg8::StaticOrder, true, true>(lds, g, S, E); }
    }
#endif
    if (RUN(7) && RUN(8)) xcd_barrier(bar);
#if PH_DN
    if (RUN(8)) {
    { PHASE_VARS(); pg8::Gemm g{MID, Wdn_t, MP, DM, FF}; pg8::StaticOrder S; S.init(MP, DM, G, bx); pg8::EpiRes E{H, H};
      pg8::gemm_phase<pg8::EpiRes, pg8::StaticOrder, true, true>(lds, g, S, E); }
    }
#endif
    if (RUN(8) && RUN(9)) xcd_barrier(bar);
#if PH_NORM
    if (RUN(9)) {
    { PHASE_VARS(); norm_phase(H, P.g_mix + DM, HN, MX + NMETA, gw, NGW, lane); }
    }
#endif
    if (RUN(9) && RUN(10)) xcd_barrier(bar);
#if PH_S5
    if (RUN(10)) {
    { PHASE_VARS(); s5_phase<0>(P, lds, vcu, G, tid); }
    }
#endif
    if (RUN(10) && RUN(11)) xcd_barrier(bar);
#if PH_GLU
    if (RUN(11)) {
    { PHASE_VARS(); pg8::Gemm g{ATTO, Wglu_t, MX, 2 * DM, DM}; pg8::StaticOrder S; S.init(MX, 2 * DM, G, bx); pg8::EpiGlu E{H, P.bglu};
      pg8::gemm_phase<pg8::EpiGlu, pg8::StaticOrder, true, true>(lds, g, S, E); }
    }
#endif
    if (RUN(11) && RUN(12)) xcd_barrier(bar);
#if PH_NORM
    if (RUN(12)) {
    { PHASE_VARS(); norm_phase(H, P.g_mlp + DM, HN, MX, gw, NGW, lane); }
    }
#endif
    if (RUN(12) && RUN(13)) xcd_barrier(bar);
#if PH_UP
    if (RUN(13)) {
    { PHASE_VARS(); pg8::Gemm g{HN, Wup_t + (size_t)DM * FF, MX, FF, DM}; pg8::StaticOrder S; S.init(MX, FF, G, bx); pg8::EpiRelu2 E{MID, FF};
      pg8::gemm_phase<pg8::EpiRelu2, pg8::StaticOrder, true, true>(lds, g, S, E); }
    }
#endif
    if (RUN(13) && RUN(14)) xcd_barrier(bar);
#if PH_DN
    if (RUN(14)) {
    { PHASE_VARS(); pg8::Gemm g{MID, Wdn_t + (size_t)DM * FF, MX, DM, FF}; pg8::StaticOrder S; S.init(MX, DM, G, bx); pg8::EpiRes E{H, P.out};
      pg8::gemm_phase<pg8::EpiRes, pg8::StaticOrder, true, true>(lds, g, S, E); }
    }
#endif
}

#undef RUN
#if defined(CHK) && CHK && defined(CHK_DUMP)
__global__ void __launch_bounds__(512, 2) s5_dbg_kernel(Args args) {
    extern __shared__ __attribute__((aligned(16))) unsigned char lds_raw[];
    LAS unsigned char* lds = (LAS unsigned char*)lds_raw; (void)args;
    PHASE_VARS(); s5_phase<CHK_DUMP>(P, lds, vcu, G, tid);
}
#endif
extern "C" void kernel_launch(void* const* d_in, const int* in_sizes, int n_in, void* d_out, int out_size, void* d_ws, size_t ws_size, hipStream_t stream) {
    static int grid = 0;
    if (grid == 0) {
        if (n_in != 22 || in_sizes[0] != MX * DM || out_size != MX * DM || ws_size < WS_END + 16 * MiB) {
            fprintf(stderr, "kernel_launch: built for 22 inputs, x/out of %d floats, >= %zu bytes of workspace; got n_in %d, in0 %d, out %d, ws %zu; nothing launched\n", MX * DM, (size_t)WS_END, n_in, n_in > 0 ? in_sizes[0] : -1, out_size, ws_size); grid = -1; return; }
        int dev = 0, cus = 0, per_cu = 0;
        if (hipGetDevice(&dev) != hipSuccess || hipDeviceGetAttribute(&cus, hipDeviceAttributeMultiprocessorCount, dev) != hipSuccess) { fprintf(stderr, "kernel_launch: device query failed\n"); grid = -1; return; }
        if (hipFuncSetAttribute((const void*)fwd_kernel, hipFuncAttributeMaxDynamicSharedMemorySize, LDS_BYTES) != hipSuccess) { fprintf(stderr, "kernel_launch: hipFuncSetAttribute(%d B LDS) failed\n", LDS_BYTES); grid = -1; return; }
        if (hipOccupancyMaxActiveBlocksPerMultiprocessor(&per_cu, (const void*)fwd_kernel, 512, LDS_BYTES) != hipSuccess || per_cu < 1)
            fprintf(stderr, "kernel_launch: note: occupancy query reports %d workgroups per CU; launching one per CU anyway (%d B LDS)\n", per_cu, LDS_BYTES);
        (void)hipGetLastError();
        grid = cus;
    }
    if (grid < 0) return;
    if (hipMemsetAsync((char*)d_ws + WS_CTL, 0, CTL_ZERO_BYTES, stream) != hipSuccess) { fprintf(stderr, "kernel_launch: memset failed\n"); return; }
    Args a{};
    for (int i = 0; i < 22; ++i) a.in[i] = (const float*)d_in[i];
    a.out = (float*)d_out; a.ws = (unsigned char*)d_ws;
#if defined(CHK) && CHK
    (void)hipMemsetAsync((char*)d_ws + WS_RES, 0, 1024, stream);
    for (int k = 0; k < 15; ++k) {
        if (k == 8 || k == 11) hipLaunchKernelGGL(chk_snap, dim3(64), dim3(256), 0, stream, (const float*)((char*)d_ws + WS_H), (float*)((char*)d_ws + WS_SNAP));
        a.ph_lo = k; a.ph_hi = k + 1;
        hipLaunchKernelGGL(fwd_kernel, dim3(grid), dim3(512), LDS_BYTES, stream, a);
        if (k == 3) hipLaunchKernelGGL(chk_attn, dim3(48), dim3(128), 0, stream, a);
        else if (k == 10) { hipLaunchKernelGGL(chk_s5, dim3(12), dim3(64), 0, stream, a);
#if defined(CHK_DUMP)
            (void)hipFuncSetAttribute((const void*)s5_dbg_kernel, hipFuncAttributeMaxDynamicSharedMemorySize, LDS_BYTES);
            hipLaunchKernelGGL(s5_dbg_kernel, dim3(grid), dim3(512), LDS_BYTES, stream, a);
            hipLaunchKernelGGL(chk_s5_int, dim3(1), dim3(64), 0, stream, a);
#endif
        }
        else hipLaunchKernelGGL(chk_kernel, dim3(64), dim3(64), 0, stream, a, k);
    }
    hipLaunchKernelGGL(chk_report, dim3(1), dim3(1), 0, stream, a);
#else
    a.ph_lo = 0; a.ph_hi = 15;
    hipLaunchKernelGGL(fwd_kernel, dim3(grid), dim3(512), LDS_BYTES, stream, a);
#endif
    const hipError_t le = hipPeekAtLastError();
    if (le != hipSuccess) fprintf(stderr, "kernel_launch: launch failed: %s\n", hipGetErrorName(le));
}
```

```cpp
#include <hip/hip_runtime.h>
#include <cstdio>
#include <cstdint>
__device__ __forceinline__ int tid_fresh() { int t = threadIdx.x; asm volatile("" : "+v"(t)); return t; }
namespace pg8 {
#define PG8_LAS __attribute__((address_space(3)))
typedef unsigned short bf16_t;
typedef short bf16x8 __attribute__((ext_vector_type(8)));
typedef float f32x4 __attribute__((ext_vector_type(4)));
typedef unsigned u32x4 __attribute__((ext_vector_type(4)));
constexpr int BM = 256, BK = 64, HALF = 128, HTB = HALF * BK * 2  , STAGE_BYTES = 8 * HTB, NXCD = 8, WGM = 8;

__host__ __device__ __forceinline__ int lds_byte(int r, int c) { const int st = (r >> 4) * 2 + (c >> 5), rr = r & 15, cc = c & 31, ob = rr * 64 + cc * 2; return st * 1024 + (ob ^ (((ob >> 9) & 1) << 5)); }
__host__ __device__ __forceinline__ void stage_rc(int b, int& R, int& C) { const int st = b / 1024, sb = b % 1024, swz = sb ^ (((sb >> 9) & 1) << 5); R = (st >> 1) * 16 + swz / 64; C = (st & 1) * 32 + (swz % 64) / 2; }
__host__ __device__ __forceinline__ int perm32(int rho) { const int n = rho >> 4, i = rho & 15; return 8 * (i >> 2) + 4 * n + (i & 3); }

struct Unit { int pm, pn; };
struct Gemm { const bf16_t* A; const bf16_t* Bt; int M, N, K; };

struct StaticOrder {
    int nM, nN, nwg, G, c;
    __host__ __device__ void init(int M, int N, int G_, int c_) { nM = M / BM; nN = N / BM; nwg = nM * nN; G = G_; c = c_; }
    __host__ __device__ bool next(int i, Unit& u) const {
        const long L = (long)i * G + c; if (L >= nwg) return false;
        int wgid = (int)L; { const int q = nwg / NXCD, r = nwg % NXCD, xcd = wgid % NXCD, off = wgid / NXCD; wgid = (xcd < r ? xcd * (q + 1) : r * (q + 1) + (xcd - r) * q) + off; }
        const int nig = WGM * nN, gid = wgid / nig, fm = gid * WGM, gsz = (nM - fm) < WGM ? (nM - fm) : WGM;
        u.pm = fm + ((wgid % nig) % gsz); u.pn = (wgid % nig) / gsz; return true;
    }
    __device__ __forceinline__ void a_ready(const Unit&) const {}
    __device__ __forceinline__ void done(const Unit&) const {}
};
typedef unsigned u32x2v __attribute__((ext_vector_type(2)));
__device__ __forceinline__ unsigned cvt_pk_bf16(float lo, float hi) { unsigned r; asm volatile("v_cvt_pk_bf16_f32 %0, %1, %2" : "=v"(r) : "v"(lo), "v"(hi)); return r; }
constexpr int E_SKVP = 8256, E_NMETA = 16, E_MXP = 64  ;
struct EpiQKV {
    static constexpr bool PERM = true, AFTER_DRAIN = false;
    bf16_t* Q; size_t sec_stride;
    __device__ __forceinline__ void operator()(const f32x4 (&acc)[2][2][4][2], const Unit& u, int wr, int wc, int fr, int fq) const {
        const int sec = u.pn >> 4; bf16_t* base = Q + (size_t)sec * sec_stride;
        const int hid0 = (u.pn & 15) * 2, d0 = wc * 32 + 8 * fq;
        const bool meta = u.pm >= E_MXP; const int b = meta ? 0 : (u.pm >> 5), pos0 = meta ? 0 : E_NMETA + (u.pm & 31) * 256;
#pragma unroll
        for (int ai = 0; ai < 2; ++ai)
#pragma unroll
            for (int m = 0; m < 4; ++m) { const int r = ai * HALF + wr * 64 + m * 16 + fr;
                if (meta && r >= E_NMETA) continue;
#pragma unroll
                for (int bj = 0; bj < 2; ++bj) { const f32x4 v0 = acc[ai][bj][m][0], v1 = acc[ai][bj][m][1];
                    u32x4 w; w.x = cvt_pk_bf16(v0[0], v0[1]); w.y = cvt_pk_bf16(v0[2], v0[3]); w.z = cvt_pk_bf16(v1[0], v1[1]); w.w = cvt_pk_bf16(v1[2], v1[3]);
                    bf16_t* dst = base + ((size_t)(b * 32 + hid0 + bj) * E_SKVP + pos0 + r) * 128 + d0;
                    *(u32x4*)dst = w;
                    if (meta) *(u32x4*)(dst + (size_t)32 * E_SKVP * 128) = w; } }
    }
};
__device__ __forceinline__ f32x4 bf4_to_f32(u32x2v w) { return (f32x4){__builtin_bit_cast(float, w.x << 16), __builtin_bit_cast(float, w.x & 0xffff0000u), __builtin_bit_cast(float, w.y << 16), __builtin_bit_cast(float, w.y & 0xffff0000u)}; }
template <bool BASE_F32, bool OUT_F32, bool STATS = false> struct EpiRes {
    static constexpr bool PERM = false, AFTER_DRAIN = false;
    const void* base; void* out; float* part;
    __device__ __forceinline__ void operator()(const f32x4 (&acc)[2][2][4][2], const Unit& u, int wr, int wc, int fr, int fq) const {
        const int row0 = u.pm * BM + wr * 64 + fr, col0 = u.pn * BM + wc * 32 + 4 * fq;
#pragma unroll
        for (int ai = 0; ai < 2; ++ai)
#pragma unroll
            for (int m = 0; m < 4; ++m) { const size_t off = (size_t)(row0 + ai * HALF + m * 16) * 4096 + col0; float ssq = 0.f;
#pragma unroll
                for (int bj = 0; bj < 2; ++bj)
#pragma unroll
                    for (int n = 0; n < 2; ++n) { const size_t o2 = off + bj * HALF + n * 16;
                        f32x4 bs; if (BASE_F32) bs = *(const f32x4*)((const float*)base + o2); else bs = bf4_to_f32(*(const u32x2v*)((const bf16_t*)base + o2));
                        const f32x4 r = bs + acc[ai][bj][m][n];
                        if (STATS) ssq += (r[0] * r[0] + r[1] * r[1]) + (r[2] * r[2] + r[3] * r[3]);
                        if (OUT_F32) *(f32x4*)((float*)out + o2) = r; else *(u32x2v*)((bf16_t*)out + o2) = (u32x2v){cvt_pk_bf16(r[0], r[1]), cvt_pk_bf16(r[2], r[3])}; }
                if (STATS) { ssq += __shfl_xor(ssq, 16); ssq += __shfl_xor(ssq, 32); if (fq == 0) part[(size_t)(row0 + ai * HALF + m * 16) * 128 + 4 * u.pn + wc] = ssq; }
                if (m & 1) asm volatile("" ::: "memory"); }
    }
};
struct EpiRelu2 {
    static constexpr bool PERM = true, AFTER_DRAIN = false;
    bf16_t* O; int ldc; const float* rstd;
    __device__ __forceinline__ void operator()(const f32x4 (&acc)[2][2][4][2], const Unit& u, int wr, int wc, int fr, int fq) const {
        const int row0 = u.pm * BM + wr * 64 + fr, col0 = u.pn * BM + wc * 32 + 8 * fq;
#pragma unroll
        for (int ai = 0; ai < 2; ++ai)
#pragma unroll
            for (int m = 0; m < 4; ++m) { bf16_t* rowp = O + (size_t)(row0 + ai * HALF + m * 16) * ldc + col0; float rs2 = 1.0f; if (rstd) { const float rs = rstd[row0 + ai * HALF + m * 16]; rs2 = rs * rs; }
#pragma unroll
                for (int bj = 0; bj < 2; ++bj) { f32x4 v0 = acc[ai][bj][m][0], v1 = acc[ai][bj][m][1];
#pragma unroll
                    for (int j = 0; j < 4; ++j) { const float a = fmaxf(v0[j], 0.f), b = fmaxf(v1[j], 0.f); v0[j] = a * a * rs2; v1[j] = b * b * rs2; }
                    u32x4 w; w.x = cvt_pk_bf16(v0[0], v0[1]); w.y = cvt_pk_bf16(v0[2], v0[3]); w.z = cvt_pk_bf16(v1[0], v1[1]); w.w = cvt_pk_bf16(v1[2], v1[3]);
                    *(u32x4*)(rowp + bj * HALF) = w; } }
    }
};
struct EpiGlu {
    static constexpr bool PERM = false, AFTER_DRAIN = false;
    bf16_t* h; const float* bias; float* part;
    __device__ __forceinline__ void operator()(const f32x4 (&acc)[2][2][4][2], const Unit& u, int wr, int wc, int fr, int fq) const {
        const int row0 = u.pm * BM + wr * 64 + fr, f0 = u.pn * HALF + wc * 32 + 4 * fq;
        f32x4 bv[2], bg[2];
#pragma unroll
        for (int n = 0; n < 2; ++n) { bv[n] = *(const f32x4*)(bias + f0 + n * 16); bg[n] = *(const f32x4*)(bias + 4096 + f0 + n * 16); }
#pragma unroll
        for (int ai = 0; ai < 2; ++ai)
#pragma unroll
            for (int m = 0; m < 4; ++m) { bf16_t* rowp = h + (size_t)(row0 + ai * HALF + m * 16) * 4096 + f0;
                float ssq = 0.f;
#pragma unroll
                for (int n = 0; n < 2; ++n) { const f32x4 val = acc[ai][0][m][n] + bv[n], gt = acc[ai][1][m][n] + bg[n]; f32x4 o = bf4_to_f32(*(const u32x2v*)(rowp + n * 16));
#pragma unroll
                    for (int j = 0; j < 4; ++j) o[j] += val[j] * __builtin_amdgcn_rcpf(1.0f + __builtin_amdgcn_exp2f(-1.4426950408889634f * gt[j]));
                    ssq += (o[0] * o[0] + o[1] * o[1]) + (o[2] * o[2] + o[3] * o[3]);
                    *(u32x2v*)(rowp + n * 16) = (u32x2v){cvt_pk_bf16(o[0], o[1]), cvt_pk_bf16(o[2], o[3])}; }
                ssq += __shfl_xor(ssq, 16); ssq += __shfl_xor(ssq, 32); if (fq == 0) part[(size_t)(row0 + ai * HALF + m * 16) * 128 + 4 * u.pn + wc] = ssq;
                if (m & 1) asm volatile("" ::: "memory"); }
    }
};
template <class Epi, class Sched, bool ALIGN_EPI = false, bool SP2 = false>
__device__ __forceinline__ void gemm_phase(PG8_LAS unsigned char* lds, const Gemm g, const Sched& S, const Epi& E) {
    const int tid = tid_fresh(), wid = __builtin_amdgcn_readfirstlane(tid >> 6), lane = tid & 63, wr = wid >> 2, wc = wid & 3, fr = lane & 15, fq = lane >> 4;
    const int K = g.K, nt = K / BK;
    unsigned voffA[2], voffB[2];
#pragma unroll
    for (int i = 0; i < 2; ++i) { int R, C; stage_rc(tid * 16 + i * 8192, R, C); const int Rb = Epi::PERM ? ((R & ~31) + perm32(R & 31)) : R;
        voffA[i] = (unsigned)(R * K + C) * 2u; voffB[i] = (unsigned)(Rb * K + C) * 2u; }
    const size_t kstep = (size_t)(BK * 2);
    const size_t hstep = (size_t)HALF * K * 2;
    const size_t tstep = 2 * hstep;
    const unsigned ldsw = (unsigned)wid * 1024u;
    const int aoff = lds_byte(wr * 64 + fr, fq * 8), boff = lds_byte(wc * 32 + fr, fq * 8);
#define PG8_SA(b, h) (((b) * 2 + (h)) * HTB)
#define PG8_SB(b, h) ((4 + (b) * 2 + (h)) * HTB)
#define PG8_STAGE(bufoff, gbase, voff) do { _Pragma("unroll") for (int _i = 0; _i < 2; ++_i) \
        __builtin_amdgcn_global_load_lds((const unsigned*)((const char*)(gbase) + (voff)[_i]), (PG8_LAS unsigned*)(lds + (bufoff) + ldsw + _i * 8192), 16, 0, 0); } while (0)
#define PG8_LDA(dst, b, h) do { _Pragma("unroll") for (int m = 0; m < 4; ++m) _Pragma("unroll") for (int k = 0; k < 2; ++k) dst[m][k] = *(const PG8_LAS bf16x8*)(lds + PG8_SA(b, h) + aoff + m * 2048 + k * 1024); } while (0)
#define PG8_LDB(dst, b, h) do { _Pragma("unroll") for (int n = 0; n < 2; ++n) _Pragma("unroll") for (int k = 0; k < 2; ++k) dst[n][k] = *(const PG8_LAS bf16x8*)(lds + PG8_SB(b, h) + boff + n * 2048 + k * 1024); } while (0)
#define PG8_MMA(ai, bj, At, Bt) do { __builtin_amdgcn_s_setprio(1); _Pragma("unroll") for (int m = 0; m < 4; ++m) _Pragma("unroll") for (int n = 0; n < 2; ++n) _Pragma("unroll") for (int k = 0; k < 2; ++k) \
        acc[ai][bj][m][n] = __builtin_amdgcn_mfma_f32_16x16x32_bf16(Bt[n][k], At[m][k], acc[ai][bj][m][n], 0, 0, 0); __builtin_amdgcn_s_setprio(0); } while (0)
#define PG8_WAIT_V(n) asm volatile("s_waitcnt vmcnt(" #n ")" ::: "memory")
#define PG8_WAIT_L(n) asm volatile("s_waitcnt lgkmcnt(" #n ")" ::: "memory")
#define PG8_BAR __builtin_amdgcn_s_barrier()
#define PG8_SCHED __builtin_amdgcn_sched_barrier(0)
    Unit cur, nxt; int ui = 0;
    if (!S.next(0, cur)) return;
    f32x4 acc[2][2][4][2];
#pragma unroll
    for (int a = 0; a < 2; ++a)
#pragma unroll
        for (int b = 0; b < 2; ++b)
#pragma unroll
            for (int m = 0; m < 4; ++m)
#pragma unroll
                for (int n = 0; n < 2; ++n) acc[a][b][m][n] = (f32x4){0.f, 0.f, 0.f, 0.f};
    bf16x8 At[4][2], B0[2][2], B1[2][2];
    const char* cA = (const char*)g.A + (size_t)cur.pm * tstep; const char* cB = (const char*)g.Bt + (size_t)cur.pn * tstep;
    S.a_ready(cur);
    if constexpr (SP2) {
        PG8_STAGE(PG8_SB(0, 0), cB, voffB); PG8_STAGE(PG8_SB(0, 1), cB + hstep, voffB); PG8_STAGE(PG8_SA(0, 0), cA, voffA); PG8_STAGE(PG8_SA(0, 1), cA + hstep, voffA);
        if (wr == 1) PG8_BAR;
        PG8_WAIT_V(2); PG8_BAR;
        PG8_STAGE(PG8_SB(1, 0), cB + kstep, voffB); PG8_STAGE(PG8_SA(1, 0), cA + kstep, voffA); PG8_STAGE(PG8_SB(1, 1), cB + hstep + kstep, voffB);
        PG8_WAIT_V(6); PG8_BAR;
    } else {
        PG8_STAGE(PG8_SB(0, 0), cB, voffB); PG8_STAGE(PG8_SA(0, 0), cA, voffA); PG8_STAGE(PG8_SB(0, 1), cB + hstep, voffB); PG8_STAGE(PG8_SA(0, 1), cA + hstep, voffA);
        if (wr == 1) PG8_BAR;
        PG8_WAIT_V(4); PG8_BAR;
        PG8_STAGE(PG8_SB(1, 0), cB + kstep, voffB); PG8_STAGE(PG8_SA(1, 0), cA + kstep, voffA); PG8_STAGE(PG8_SB(1, 1), cB + hstep + kstep, voffB);
        PG8_WAIT_V(6); PG8_BAR;
    }
    for (;;) {
        const bool has_next = S.next(ui + 1, nxt);
        const char* nA = has_next ? (const char*)g.A + (size_t)nxt.pm * tstep : cA; const char* nB = has_next ? (const char*)g.Bt + (size_t)nxt.pn * tstep : cB;
        for (int t = 0; t < nt; t += 2) {
            const bool last = (t == nt - 2);
            const char* a1 = cA + (size_t)(t + 1) * kstep;
            const char* a2 = last ? nA : cA + (size_t)(t + 2) * kstep; const char* b2 = last ? nB : cB + (size_t)(t + 2) * kstep;
            const char* a3 = a2 + kstep; const char* b3 = b2 + kstep;
            if (last && has_next) S.a_ready(nxt);
            if constexpr (SP2) {
            PG8_LDB(B0, 0, 0); PG8_LDB(B1, 0, 1); PG8_SCHED; PG8_LDA(At, 0, 0); PG8_STAGE(PG8_SA(1, 1), a1 + hstep, voffA);
            PG8_WAIT_V(8); PG8_WAIT_L(0); PG8_BAR; PG8_MMA(0, 0, At, B0); PG8_MMA(0, 1, At, B1); PG8_BAR; PG8_SCHED;
            PG8_LDA(At, 0, 1); PG8_STAGE(PG8_SB(0, 0), b2, voffB); PG8_STAGE(PG8_SB(0, 1), b2 + hstep, voffB); PG8_STAGE(PG8_SA(0, 0), a2, voffA);
            PG8_WAIT_V(8); PG8_WAIT_L(0); PG8_BAR; PG8_MMA(1, 0, At, B0); PG8_MMA(1, 1, At, B1); PG8_BAR; PG8_SCHED;
            PG8_LDB(B0, 1, 0); PG8_LDB(B1, 1, 1); PG8_SCHED; PG8_LDA(At, 1, 0); PG8_STAGE(PG8_SA(0, 1), a2 + hstep, voffA);
            PG8_WAIT_V(8); PG8_WAIT_L(0); PG8_BAR; PG8_MMA(0, 0, At, B0); PG8_MMA(0, 1, At, B1); PG8_BAR; PG8_SCHED;
            PG8_LDA(At, 1, 1); PG8_STAGE(PG8_SB(1, 0), b3, voffB); PG8_STAGE(PG8_SB(1, 1), b3 + hstep, voffB); PG8_STAGE(PG8_SA(1, 0), a3, voffA);
            PG8_WAIT_V(8); PG8_WAIT_L(0); PG8_BAR; PG8_MMA(1, 0, At, B0); PG8_MMA(1, 1, At, B1); PG8_BAR; PG8_SCHED;
            } else {
            PG8_LDB(B0, 0, 0); PG8_SCHED; PG8_LDA(At, 0, 0); PG8_STAGE(PG8_SA(1, 1), a1 + hstep, voffA);
            PG8_WAIT_L(8); PG8_BAR; PG8_WAIT_L(0); PG8_MMA(0, 0, At, B0); PG8_BAR; PG8_SCHED;
            PG8_LDB(B1, 0, 1); PG8_STAGE(PG8_SB(0, 0), b2, voffB);
            PG8_BAR; PG8_WAIT_L(0); PG8_MMA(0, 1, At, B1); PG8_BAR;
            PG8_LDA(At, 0, 1); PG8_STAGE(PG8_SA(0, 0), a2, voffA);
            PG8_BAR; PG8_WAIT_L(0); PG8_MMA(1, 0, At, B0); PG8_BAR; PG8_SCHED;
            PG8_STAGE(PG8_SB(0, 1), b2 + hstep, voffB);
            PG8_WAIT_V(6); PG8_BAR; PG8_MMA(1, 1, At, B1); PG8_BAR;
            PG8_LDB(B0, 1, 0); PG8_SCHED; PG8_LDA(At, 1, 0); PG8_STAGE(PG8_SA(0, 1), a2 + hstep, voffA);
            PG8_WAIT_L(8); PG8_BAR; PG8_WAIT_L(0); PG8_MMA(0, 0, At, B0); PG8_BAR; PG8_SCHED;
            PG8_LDB(B1, 1, 1); PG8_STAGE(PG8_SB(1, 0), b3, voffB);
            PG8_BAR; PG8_WAIT_L(0); PG8_MMA(0, 1, At, B1); PG8_BAR;
            PG8_LDA(At, 1, 1); PG8_STAGE(PG8_SA(1, 0), a3, voffA);
            PG8_BAR; PG8_WAIT_L(0); PG8_MMA(1, 0, At, B0); PG8_BAR; PG8_SCHED;
            PG8_STAGE(PG8_SB(1, 1), b3 + hstep, voffB);
            PG8_WAIT_V(6); PG8_BAR; PG8_MMA(1, 1, At, B1); PG8_BAR;
            }
        }
        if constexpr (ALIGN_EPI) { if (wr == 0) PG8_BAR; }
        if constexpr (!Epi::AFTER_DRAIN) { E(acc, cur, wr, wc, fr, fq); S.done(cur); }
        if (!has_next) break;
#pragma unroll
        for (int a = 0; a < 2; ++a)
#pragma unroll
            for (int b = 0; b < 2; ++b)
#pragma unroll
                for (int m = 0; m < 4; ++m)
#pragma unroll
                    for (int n = 0; n < 2; ++n) acc[a][b][m][n] = (f32x4){0.f, 0.f, 0.f, 0.f};
        cur = nxt; cA = nA; cB = nB; ++ui;
        if constexpr (ALIGN_EPI) { if (wr == 1) PG8_BAR; }
    }
    PG8_WAIT_V(0);
    if constexpr (!ALIGN_EPI) { if (wr == 0) PG8_BAR; }
    PG8_BAR;
    if constexpr (Epi::AFTER_DRAIN) { E.fused(acc, cur, wr, wc, fr, fq, lds, wid, lane); S.done(cur); }
#undef PG8_SA
#undef PG8_SB
#undef PG8_STAGE
#undef PG8_LDA
#undef PG8_LDB
#undef PG8_MMA
#undef PG8_WAIT_V
#undef PG8_WAIT_L
#undef PG8_BAR
#undef PG8_SCHED
}
}
namespace ab {
constexpr int D = 128;
constexpr float THR = 8.f;
constexpr bool WSKIP = false;
constexpr float SCALE = 0.08838834764831845f;
constexpr int NW = 8, QBLK = 32, KVBLK = 64, QB = NW * QBLK;
constexpr int SHM_V = KVBLK * D * 2, SHM_K = KVBLK * D * 2;
constexpr int LDS_BYTES = 2 * SHM_V + 2 * SHM_K + NW * 64 * 4;
typedef unsigned short bf16;
typedef short bf16x8 __attribute__((ext_vector_type(8)));
typedef short s16x4 __attribute__((ext_vector_type(4)));
typedef float f32x16 __attribute__((ext_vector_type(16)));
typedef float f32x4 __attribute__((ext_vector_type(4)));
typedef unsigned u32x4 __attribute__((ext_vector_type(4)));
template <class A, class Bt> struct same_t { static constexpr bool v = false; };
template <class A> struct same_t<A, A> { static constexpr bool v = true; };

#define KSWZ(row, colB) ((row) * 256 + ((colB) ^ (((row) & 7) << 4)))
#define SBAR() __builtin_amdgcn_sched_barrier(0)
__device__ __forceinline__ int v_st(int k, int c) { const int kk = (k & ~0xC) | ((k & 4) << 1) | ((k & 8) >> 1); return ((kk >> 3) * 4 + (c >> 5)) * 512 + ((kk & 7) * 32 + (c & 31)) * 2; }
__device__ __forceinline__ int v_rd_base(int lane) { return ((lane & 3) << 3) | (((lane >> 2) & 3) << 6) | (((lane >> 4) & 1) << 5) | (((lane >> 5) & 1) << 8); }
constexpr int v_rd_off(int d0, int ks, int half) { return d0 * 512 + ks * 4096 + half * 2048; }
__device__ __forceinline__ int crow(int r, int hi) { return (r & 3) + 8 * (r >> 2) + 4 * hi; }
__device__ __forceinline__ unsigned cvtpk(float lo, float hi) {
    unsigned r; asm volatile("v_cvt_pk_bf16_f32 %0, %1, %2" : "=v"(r) : "v"(lo), "v"(hi)); return r;
}
__device__ __forceinline__ bf16x8 pack8(f32x4 a, f32x4 b) {
    u32x4 w = {cvtpk(a[0], a[1]), cvtpk(a[2], a[3]), cvtpk(b[0], b[1]), cvtpk(b[2], b[3])};
    return *reinterpret_cast<bf16x8*>(&w);
}
template <class T> __device__ __forceinline__ bf16x8 load8(const T* p) {
    if constexpr (same_t<T, float>::v) { return pack8(*(const f32x4*)p, *(const f32x4*)(p + 4)); }
    else { return *reinterpret_cast<const bf16x8*>(p); }
}
__device__ __forceinline__ void mask_tile(f32x16& p0, f32x16& p1, int dq, unsigned W) {
    const float NEG = -__builtin_inff();
#pragma unroll
    for (int r = 0; r < 16; ++r) {
        const int c = (r & 3) + 8 * (r >> 2);
        if ((unsigned)(dq - c) >= W) p0[r] = NEG;
        if ((unsigned)(dq - c - 32) >= W) p1[r] = NEG;
    }
}
__device__ __forceinline__ void partialSM(f32x16& p0, f32x16& p1, float& m_reg, float& mn, float& alpha) {
    float pmax = p0[0]; for (int r = 1; r < 16; ++r) pmax = fmaxf(pmax, p0[r]); for (int r = 0; r < 16; ++r) pmax = fmaxf(pmax, p1[r]);
    { auto rr = __builtin_amdgcn_permlane32_swap(__float_as_uint(pmax), __float_as_uint(pmax), false, false);
      pmax = fmaxf(__uint_as_float(rr[0]), __uint_as_float(rr[1])); }
    constexpr float C2 = 1.4426950408889634f * SCALE;
    if (__builtin_expect(__all((pmax - m_reg) * SCALE <= THR), 1)) { mn = m_reg; alpha = 1.f; }
    else { mn = fmaxf(m_reg, pmax); alpha = __builtin_amdgcn_exp2f((m_reg - mn) * C2); m_reg = mn; }
    const float mnL = -mn * C2;
    for (int r = 0; r < 16; ++r) p0[r] = fmaf(p0[r], C2, mnL); for (int r = 0; r < 16; ++r) p1[r] = fmaf(p1[r], C2, mnL);
    for (int r = 0; r < 16; ++r) p0[r] = __builtin_amdgcn_exp2f(p0[r]);
}
__device__ __forceinline__ void finishSM(f32x16& p0, f32x16& p1, float alpha, float& l_reg, bf16x8& pa0, bf16x8& pa1, bf16x8& pa2, bf16x8& pa3) {
    for (int r = 0; r < 16; ++r) p1[r] = __builtin_amdgcn_exp2f(p1[r]);
    float ps = 0; for (int r = 0; r < 16; ++r) ps += p0[r]; for (int r = 0; r < 16; ++r) ps += p1[r];
    { auto rr = __builtin_amdgcn_permlane32_swap(__float_as_uint(ps), __float_as_uint(ps), false, false);
      ps = __uint_as_float(rr[0]) + __uint_as_float(rr[1]); }
    l_reg = l_reg * alpha + ps;
#define PK4(P, B_, OUT) do { unsigned a0 = cvtpk(P[B_+0], P[B_+1]), a1 = cvtpk(P[B_+2], P[B_+3]);                          \
        unsigned b0 = cvtpk(P[B_+4], P[B_+5]), b1 = cvtpk(P[B_+6], P[B_+7]);                                             \
        auto r0 = __builtin_amdgcn_permlane32_swap(a0, b0, false, false); auto r1 = __builtin_amdgcn_permlane32_swap(a1, b1, false, false); \
        u32x4 w = {r0[0], r1[0], r0[1], r1[1]}; OUT = *reinterpret_cast<bf16x8*>(&w); } while (0)
    PK4(p0, 0, pa0); PK4(p0, 8, pa1); PK4(p1, 0, pa2); PK4(p1, 8, pa3);
#undef PK4
}
template <int KB, bool SK>
__device__ __forceinline__ void qkt(f32x16& p0, f32x16& p1, const char* K_lds, int r32, int hi, const bf16x8* qr, bool act) {
    if (SK && !act) { const float NEG = -__builtin_inff();
#pragma unroll
        for (int r = 0; r < 16; ++r) { p0[r] = NEG; p1[r] = NEG; } return; }
    p0 = f32x16{}; p1 = f32x16{};
    const char* kb[4];
#pragma unroll
    for (int dd = 0; dd < 4; ++dd) kb[dd] = K_lds + KB * SHM_K + KSWZ(r32, (dd * 16 + hi * 8) * 2);
#pragma unroll
    for (int d0 = 0; d0 < 8; ++d0) { const char* a = kb[d0 & 3] + (d0 >> 2) * 128;
        bf16x8 b0 = *reinterpret_cast<const bf16x8*>(a);
        bf16x8 b1 = *reinterpret_cast<const bf16x8*>(a + 32 * 256);
        p0 = __builtin_amdgcn_mfma_f32_32x32x16_bf16(b0, qr[d0], p0, 0, 0, 0);
        p1 = __builtin_amdgcn_mfma_f32_32x32x16_bf16(b1, qr[d0], p1, 0, 0, 0); }
}
template <int VB, bool SK>
__device__ __forceinline__ void pv_tile(f32x16* o, int vb0, bf16x8 pa0, bf16x8 pa1, bf16x8 pa2, bf16x8 pa3, bool act) {
    if (SK && !act) return;
#define TRRD(dst, off) asm volatile("ds_read_b64_tr_b16 %0, %1 offset:%2" : "=&v"(dst) : "v"(vb0), "i"(off) : "memory")
#define PV_D0(d0) do { s16x4 l0, l1, l2, l3, h0, h1, h2, h3; constexpr int b_ = VB * SHM_V + v_rd_off(d0, 0, 0);     \
        TRRD(l0, b_); TRRD(h0, b_ + 2048); TRRD(l1, b_ + 4096); TRRD(h1, b_ + 6144); TRRD(l2, b_ + 8192); TRRD(h2, b_ + 10240); TRRD(l3, b_ + 12288); TRRD(h3, b_ + 14336); \
        asm volatile("s_waitcnt lgkmcnt(0)" ::: "memory"); SBAR();                 \
        o[d0] = __builtin_amdgcn_mfma_f32_32x32x16_bf16(pa0, (bf16x8){l0[0], l0[1], l0[2], l0[3], h0[0], h0[1], h0[2], h0[3]}, o[d0], 0, 0, 0);   \
        o[d0] = __builtin_amdgcn_mfma_f32_32x32x16_bf16(pa1, (bf16x8){l1[0], l1[1], l1[2], l1[3], h1[0], h1[1], h1[2], h1[3]}, o[d0], 0, 0, 0);   \
        o[d0] = __builtin_amdgcn_mfma_f32_32x32x16_bf16(pa2, (bf16x8){l2[0], l2[1], l2[2], l2[3], h2[0], h2[1], h2[2], h2[3]}, o[d0], 0, 0, 0);   \
        o[d0] = __builtin_amdgcn_mfma_f32_32x32x16_bf16(pa3, (bf16x8){l3[0], l3[1], l3[2], l3[3], h3[0], h3[1], h3[2], h3[3]}, o[d0], 0, 0, 0); } while (0)
    PV_D0(0); PV_D0(1); PV_D0(2); PV_D0(3);
#undef PV_D0
#undef TRRD
}

template <class TIn, class TOut> struct BlockRef { const TIn* Q; const TIn* K; const TIn* V; TOut* O; int P0; };
template <class TIn> struct Seam {
    bf16x8 qr[8];
    bf16x8 st_v0, st_v1, st_k0, st_k1; f32x4 sf0, sf1, sf2, sf3;
    f32x4 tq[16];
};
__device__ __forceinline__ int swa_jlo(int P0, int W) { const int lowk = P0 - W + 1; return lowk > 0 ? lowk / KVBLK : 0; }
#define ROW(p, k0, rr) ((p) + (size_t)((k0) + (rr)) * D + sc)
#define VMW() asm volatile("s_waitcnt vmcnt(0)" ::: "memory")
#define VMWN(n) asm volatile("s_waitcnt vmcnt(%0)" :: "i"(n) : "memory")
#define SLOAD_H(Kp, Vp, k0) do { S.st_v0 = load8<TIn>(ROW(Vp, k0, sr)); S.st_v1 = load8<TIn>(ROW(Vp, k0, 32 + sr));              \
                         S.st_k0 = load8<TIn>(ROW(Kp, k0, sr)); S.st_k1 = load8<TIn>(ROW(Kp, k0, 32 + sr)); } while (0)
#define SWRITE_HK(bf) do { *(bf16x8*)(K_lds + (bf) * SHM_K + kws) = S.st_k0; *(bf16x8*)(K_lds + (bf) * SHM_K + kws + 32 * 256) = S.st_k1; } while (0)
#define SWRITE_HV(bf) do { *(bf16x8*)(V_lds + (bf) * SHM_V + vst0) = S.st_v0; *(bf16x8*)(V_lds + (bf) * SHM_V + vst1) = S.st_v1; } while (0)
#define SWRITE_H(bf) do { SWRITE_HV(bf); SWRITE_HK(bf); } while (0)
#define SLOAD_F(p, k0) do { S.sf0 = *(const f32x4*)ROW(p, k0, sr); S.sf1 = *(const f32x4*)(ROW(p, k0, sr) + 4);                \
                            S.sf2 = *(const f32x4*)ROW(p, k0, 32 + sr); S.sf3 = *(const f32x4*)(ROW(p, k0, 32 + sr) + 4); } while (0)
#define SWRITE_KF(bf) do { *(bf16x8*)(K_lds + (bf) * SHM_K + kws) = pack8(S.sf0, S.sf1); *(bf16x8*)(K_lds + (bf) * SHM_K + kws + 32 * 256) = pack8(S.sf2, S.sf3); } while (0)
#define SWRITE_VF(bf) do { *(bf16x8*)(V_lds + (bf) * SHM_V + vst0) = pack8(S.sf0, S.sf1); *(bf16x8*)(V_lds + (bf) * SHM_V + vst1) = pack8(S.sf2, S.sf3); } while (0)
template <class TIn, class TOut>
__device__ __forceinline__ void causal_swa_prime(const BlockRef<TIn, TOut>& cur, int W, char* lds, Seam<TIn>& S) {
    constexpr bool F32 = same_t<TIn, float>::v;
    const int tid = tid_fresh(), wid = __builtin_amdgcn_readfirstlane(tid >> 6), lane = tid & 63, r32 = lane & 31, hi = lane >> 5;
    const int sr = tid >> 4, sc = (tid & 15) * 8, kws = KSWZ(sr, sc * 2); char* K_lds = lds + 2 * SHM_V;
    const int kb0 = swa_jlo(cur.P0, W) * KVBLK;
    for (int d0 = 0; d0 < 8; ++d0) S.qr[d0] = load8<TIn>(cur.Q + (size_t)(wid * QBLK + r32) * D + d0 * 16 + hi * 8);
    if constexpr (F32) { SLOAD_F((const float*)cur.K, kb0); VMW(); SWRITE_KF(0); SBAR(); SLOAD_F((const float*)cur.V, kb0); }
    else { SLOAD_H(cur.K, cur.V, kb0); VMW(); SWRITE_HK(0); }
    __syncthreads();
}
template <class TIn, class TOut>
__device__ __forceinline__ void causal_swa_block(const BlockRef<TIn, TOut>& cur, const BlockRef<TIn, TOut>& nxt, int skv, int W, char* lds, Seam<TIn>& S) {
    constexpr bool F32 = same_t<TIn, float>::v;
    const int tid = tid_fresh(), wid = __builtin_amdgcn_readfirstlane(tid >> 6), lane = tid & 63, r32 = lane & 31, hi = lane >> 5;
    const int j_lo = swa_jlo(cur.P0, W);
    int j_hi = (cur.P0 + QB - 1) / KVBLK + 1; if (j_hi > skv / KVBLK) j_hi = skv / KVBLK;
    const int NT = j_hi - j_lo;
    const int kbn = swa_jlo(nxt.P0, W) * KVBLK;
    const int qlo = cur.P0 + wid * QBLK, qm = qlo + r32 - 4 * hi;
    char* V_lds = lds; char* K_lds = lds + 2 * SHM_V;
    float* ws = (float*)(lds + 2 * SHM_V + 2 * SHM_K) + wid * 64; float* li_l = ws, * al_l = ws + 32;
    float m_reg = -1e30f, l_reg = 0; f32x16 o[4] = {};
    const int sr = tid >> 4, sc = (tid & 15) * 8, vst0 = v_st(sr, sc), vst1 = v_st(32 + sr, sc), kws = KSWZ(sr, sc * 2);
    const int vb0 = (int)(uintptr_t)V_lds + v_rd_base(lane);
    const TIn* Kh = cur.K; const TIn* Vh = cur.V;
#define RESC(a) do { if (__any((a) < 1.f)) { if (hi == 0) al_l[r32] = (a); asm volatile("s_waitcnt lgkmcnt(0)" ::: "memory");              \
                     for (int d_ = 0; d_ < 4; ++d_) for (int r = 0; r < 16; ++r) o[d_][r] *= al_l[crow(r, hi)]; } } while (0)
#define KBASE(t) ((j_lo + (t)) * KVBLK)
#define ACT(t) (KBASE(t) <= qlo + QBLK - 1 && KBASE(t) + KVBLK - 1 >= qlo - W + 1)
#define MASKT(P0_, P1_, t) do { const int kb_ = KBASE(t); if ((!SK || ACT(t)) && (kb_ + KVBLK - 1 > qlo || kb_ <= qlo + QBLK - 1 - W)) mask_tile(P0_, P1_, qm - kb_, (unsigned)W); } while (0)
    constexpr int NQL = F32 ? 16 : 8;
    constexpr bool SK = WSKIP && !F32;
#define SEAM_K0() do { VMWN(NQL); if constexpr (F32) { SWRITE_KF(0); SBAR(); SLOAD_F((const float*)nxt.V, kbn); } else { SWRITE_HK(0); } SBAR(); } while (0)
    f32x16 pA0, pA1, pB0, pB1; float mnA, mnB, alA, alB; bf16x8 pa0, pa1, pa2, pa3;
    if constexpr (F32) { VMW(); SWRITE_VF(0); SBAR(); } else { SWRITE_HV(0); SBAR(); }
    if (NT > 1) { if constexpr (F32) SLOAD_F((const float*)Kh, KBASE(1)); else SLOAD_H(Kh, Vh, KBASE(1)); }
    SBAR(); qkt<0, SK>(pA0, pA1, K_lds, r32, hi, S.qr, ACT(0));
    if constexpr (F32) { if (NT > 1) { VMW(); SWRITE_KF(1); SBAR(); SLOAD_F((const float*)Vh, KBASE(1)); } }
    MASKT(pA0, pA1, 0); partialSM(pA0, pA1, m_reg, mnA, alA);
    if (NT > 1) { VMW(); if constexpr (F32) { SWRITE_VF(1); SBAR(); if (NT > 2) SLOAD_F((const float*)Kh, KBASE(2)); } else SWRITE_H(1); }
    __syncthreads();
#define HALF_STEP(PX0, PX1, mnX, alX, PY0, PY1, alY, t, KB, VB, SB) do {                                                      \
        SBAR(); qkt<KB, SK>(PX0, PX1, K_lds, r32, hi, S.qr, ACT(t));                                             \
        finishSM(PY0, PY1, alY, l_reg, pa0, pa1, pa2, pa3); SBAR();                                                           \
        if ((t) + 1 < NT) { if constexpr (F32) { VMW(); SWRITE_KF(SB); SBAR(); SLOAD_F((const float*)Vh, KBASE((t) + 1)); }  \
                            else { SLOAD_H(Kh, Vh, KBASE((t) + 1)); } SBAR(); }                                               \
        pv_tile<VB, SK>(o, vb0, pa0, pa1, pa2, pa3, ACT((t) - 1)); MASKT(PX0, PX1, (t)); partialSM(PX0, PX1, m_reg, mnX, alX);                                        \
        __syncthreads();                                                                                                      \
        if ((t) + 1 < NT) { VMW(); if constexpr (F32) { SWRITE_VF(SB); SBAR(); if ((t) + 2 < NT) SLOAD_F((const float*)Kh, KBASE((t) + 2)); } \
                            else { SWRITE_H(SB); } }                                                                          \
        RESC(alX); __syncthreads(); } while (0)
    for (int t = 1; t + 1 < NT; t += 2) {
        HALF_STEP(pB0, pB1, mnB, alB, pA0, pA1, alA, t, 1, 0, 0);
        HALF_STEP(pA0, pA1, mnA, alA, pB0, pB1, alB, t + 1, 0, 1, 1);
    }
    const bool even = (NT & 1) == 0;
    if (even) { SBAR(); qkt<1, SK>(pB0, pB1, K_lds, r32, hi, S.qr, ACT(NT - 1)); SBAR(); }
#define QROW(e) (nxt.Q + (size_t)(wid * QBLK + r32) * D + ((e) >> 1) * 16 + hi * 8 + ((e) & 1) * 4)
    if constexpr (F32) { SLOAD_F((const float*)nxt.K, kbn); SBAR();
#pragma unroll
        for (int e = 0; e < 8; ++e) S.tq[e] = *(const f32x4*)QROW(e); }
    else { SLOAD_H(nxt.K, nxt.V, kbn); SBAR();
#pragma unroll
        for (int d0 = 0; d0 < 8; ++d0) S.qr[d0] = load8<TIn>(nxt.Q + (size_t)(wid * QBLK + r32) * D + d0 * 16 + hi * 8); }
    SBAR();
    finishSM(pA0, pA1, alA, l_reg, pa0, pa1, pa2, pa3); SBAR();
    if constexpr (F32) {
#pragma unroll
        for (int e = 8; e < 16; ++e) S.tq[e] = *(const f32x4*)QROW(e); SBAR(); }
#undef QROW
    pv_tile<0, SK>(o, vb0, pa0, pa1, pa2, pa3, ACT(even ? NT - 2 : NT - 1));
    if (even) { MASKT(pB0, pB1, NT - 1); partialSM(pB0, pB1, m_reg, mnB, alB); __syncthreads(); RESC(alB);
        finishSM(pB0, pB1, alB, l_reg, pa0, pa1, pa2, pa3); SBAR(); pv_tile<1, SK>(o, vb0, pa0, pa1, pa2, pa3, ACT(NT - 1)); }
    SBAR(); SEAM_K0();
    if (hi == 0) li_l[r32] = l_reg; asm volatile("s_waitcnt lgkmcnt(0)" ::: "memory");
    float rli[16];
#pragma unroll
    for (int r = 0; r < 16; ++r) rli[r] = __builtin_amdgcn_rcpf(li_l[crow(r, hi)]);
    TOut* Ow = cur.O + (size_t)(wid * QBLK) * D;
#pragma unroll
    for (int r = 0; r < 16; ++r) { const int orow = crow(r, hi);
#pragma unroll
        for (int d0 = 0; d0 < 4; ++d0) { const float v = o[d0][r] * rli[r];
            if constexpr (same_t<TOut, float>::v) { Ow[(size_t)orow * D + d0 * 32 + r32] = v; }
            else { const float vn = __shfl_xor(v, 1);
                   if ((r32 & 1) == 0) *(unsigned*)(Ow + (size_t)orow * D + d0 * 32 + r32) = cvtpk(v, vn); } } }
    if constexpr (F32) {
#pragma unroll
        for (int d0 = 0; d0 < 8; ++d0) S.qr[d0] = pack8(S.tq[2 * d0], S.tq[2 * d0 + 1]); }
    __syncthreads();
#undef RESC
#undef KBASE
#undef ACT
#undef MASKT
#undef SEAM_K0
#undef HALF_STEP
}
#undef ROW
#undef VMW
#undef VMWN
#undef SLOAD_H
#undef SWRITE_HK
#undef SWRITE_HV
#undef SWRITE_H
#undef SLOAD_F
#undef SWRITE_KF
#undef SWRITE_VF
constexpr int DA_K = 0, DA_V = 32768, DA_PX = 98304, DA_AL = 131072, DA_FL = DA_AL + 1024, DA_LL = DA_FL + 64, DA_OSC = DA_LL + 512  , DA_LDS = DA_OSC + 16384;
struct DaBlk { const bf16* Q; const bf16* K; const bf16* V0; const bf16* V1; bf16* O0; bf16* O1; int P0, nt; };
#if defined(DA_TESTRUN)
#define DA_TESTV(g) ((g).test)
#else
#define DA_TESTV(g) 0
#endif
struct DaGeom { const bf16* Qb; const bf16* Kb; const bf16* Vb; bf16* Ob; int vcu, G, nblk, skvp, seq, nmeta, test; };
template <int TEST = 0> __device__ __forceinline__ DaBlk da_blk_t(const DaGeom& g, int j) {
    const int item = g.vcu + g.G * (j >> 1), head = (DA_TESTV(g) == 1) ? 0 : ((DA_TESTV(g) == 2) ? ((item >> 5) & 7) : (item >> 5)), x = item & 31, qb = (j & 1) ? x : 63 - x;
    const int b = head >> 5, h = (head >> 1) & 15, c = head & 1;
    DaBlk B; const size_t hs = (size_t)g.skvp * D;
    B.Q = g.Qb + (size_t)(b * 32 + 2 * h + c) * hs + (size_t)(g.nmeta + 128 * qb) * D; B.K = g.Kb + (size_t)(b * 32 + 2 * h + c) * hs;
    B.V0 = g.Vb + (size_t)(b * 32 + 2 * h) * hs; B.V1 = B.V0 + hs;
    B.O0 = g.Ob + ((size_t)(head * 2) * g.seq + 128 * qb) * D; B.O1 = B.O0 + (size_t)g.seq * D;
    B.P0 = g.nmeta + 128 * qb; B.nt = (B.P0 + 127) / KVBLK + 1;
    return B;
}
__device__ __forceinline__ DaBlk da_blk(const DaGeom& g, int j) { return da_blk_t<0>(g, j); }
struct DaCur { int j, t, nt; };
__device__ __forceinline__ int da_tile(const DaCur& c) { return (c.j & 1) ? c.nt - 1 - c.t : c.t; }
__device__ __forceinline__ void da_adv(const DaGeom& g, DaCur& c) { if (c.t + 1 < c.nt) { ++c.t; } else if (c.j + 1 < g.nblk) { ++c.j; c.t = 0; c.nt = da_blk(g, c.j).nt; } }

template <int CTRL, bool BC> __device__ __forceinline__ float dppf(float x) { return __builtin_bit_cast(float, __builtin_amdgcn_update_dpp(0, __builtin_bit_cast(int, x), CTRL, 0xF, 0xF, BC)); }
template <int VB, class HOOK> __device__ __forceinline__ void da_pv2(f32x16* o, int vb0, bf16x8 pa0, bf16x8 pa1, bf16x8 pa2, bf16x8 pa3, bf16x8 pb0, bf16x8 pb1, bf16x8 pb2, bf16x8 pb3, HOOK&& hook) {
#define DA_TR(dst, off) asm volatile("ds_read_b64_tr_b16 %0, %1 offset:%2" : "=&v"(dst) : "v"(vb0), "i"(off) : "memory")
#define DA_TR8(S, d0) do { constexpr int b_ = VB * SHM_V + v_rd_off(d0, 0, 0); \
        DA_TR(S##l0, b_); DA_TR(S##h0, b_ + 2048); DA_TR(S##l1, b_ + 4096); DA_TR(S##h1, b_ + 6144); DA_TR(S##l2, b_ + 8192); DA_TR(S##h2, b_ + 10240); DA_TR(S##l3, b_ + 12288); DA_TR(S##h3, b_ + 14336); } while (0)
#define DA_VF(S, k) (bf16x8){S##l##k[0], S##l##k[1], S##l##k[2], S##l##k[3], S##h##k[0], S##h##k[1], S##h##k[2], S##h##k[3]}
#define DA_HK(h) do { if ((h) >= 0 && (h) < 0) { SBAR(); hook(h); SBAR(); } } while (0)
#define DA_MM(S, d0, H) do { \
        o[d0] = __builtin_amdgcn_mfma_f32_32x32x16_bf16(pa0, DA_VF(S, 0), o[d0], 0, 0, 0); DA_HK(H); o[4 + d0] = __builtin_amdgcn_mfma_f32_32x32x16_bf16(pb0, DA_VF(S, 0), o[4 + d0], 0, 0, 0); DA_HK(H + 1); \
        o[d0] = __builtin_amdgcn_mfma_f32_32x32x16_bf16(pa1, DA_VF(S, 1), o[d0], 0, 0, 0); DA_HK(H + 2); o[4 + d0] = __builtin_amdgcn_mfma_f32_32x32x16_bf16(pb1, DA_VF(S, 1), o[4 + d0], 0, 0, 0); DA_HK(H + 3); \
        o[d0] = __builtin_amdgcn_mfma_f32_32x32x16_bf16(pa2, DA_VF(S, 2), o[d0], 0, 0, 0); DA_HK(H + 4); o[4 + d0] = __builtin_amdgcn_mfma_f32_32x32x16_bf16(pb2, DA_VF(S, 2), o[4 + d0], 0, 0, 0); DA_HK(H + 5); \
        o[d0] = __builtin_amdgcn_mfma_f32_32x32x16_bf16(pa3, DA_VF(S, 3), o[d0], 0, 0, 0); DA_HK(H + 6); o[4 + d0] = __builtin_amdgcn_mfma_f32_32x32x16_bf16(pb3, DA_VF(S, 3), o[4 + d0], 0, 0, 0); DA_HK(H + 7); } while (0)
    s16x4 Al0, Al1, Al2, Al3, Ah0, Ah1, Ah2, Ah3, Bl0, Bl1, Bl2, Bl3, Bh0, Bh1, Bh2, Bh3;
    DA_TR8(A, 0);
    DA_TR8(B, 1); asm volatile("s_waitcnt lgkmcnt(8)" ::: "memory"); SBAR(); DA_MM(A, 0, 0); SBAR();
    DA_TR8(A, 2); asm volatile("s_waitcnt lgkmcnt(8)" ::: "memory"); SBAR(); DA_MM(B, 1, 8); SBAR();
    DA_TR8(B, 3); asm volatile("s_waitcnt lgkmcnt(8)" ::: "memory"); SBAR(); DA_MM(A, 2, -100); SBAR();
    asm volatile("s_waitcnt lgkmcnt(0)" ::: "memory"); SBAR(); DA_MM(B, 3, -100); SBAR();
#undef DA_TR
#undef DA_TR8
#undef DA_VF
#undef DA_MM
#undef DA_HK
}
#define DA_KSWZ(row, colB) ((row) * 256 + ((colB) ^ (((row) & 15) << 4)))
template <int KB> __device__ __forceinline__ void da_qkt(f32x16& p0, f32x16& p1, const char* K_lds, int r32, int hi, const bf16x8* qr) {
    const char* kb[4];
#pragma unroll
    for (int dd = 0; dd < 4; ++dd) kb[dd] = K_lds + KB * SHM_K + DA_KSWZ(r32, (dd * 16 + hi * 8) * 2);
    bf16x8 f0[8], f1[8];
#pragma unroll
    for (int d0 = 0; d0 < 8; ++d0) { const char* a = (d0 >> 2) ? K_lds + KB * SHM_K + DA_KSWZ(r32, ((d0 & 3) * 16 + hi * 8) * 2 + 128) : kb[d0 & 3]; f0[d0] = *reinterpret_cast<const bf16x8*>(a); f1[d0] = *reinterpret_cast<const bf16x8*>(a + 32 * 256); }
    SBAR();
    p0 = f32x16{}; p1 = f32x16{};
    __builtin_amdgcn_s_setprio(3);
#pragma unroll
    for (int d0 = 0; d0 < 8; ++d0) { p0 = __builtin_amdgcn_mfma_f32_32x32x16_bf16(f0[d0], qr[d0], p0, 0, 0, 0); p1 = __builtin_amdgcn_mfma_f32_32x32x16_bf16(f1[d0], qr[d0], p1, 0, 0, 0); }
    __builtin_amdgcn_s_setprio(0);
    SBAR();
}
typedef const __attribute__((address_space(1))) char* da_gptr;
__device__ __forceinline__ da_gptr da_uni(const char* p) { const unsigned long long v = (unsigned long long)p;
    const unsigned lo = __builtin_amdgcn_readfirstlane((unsigned)v), hi = __builtin_amdgcn_readfirstlane((unsigned)(v >> 32)); return (da_gptr)(((unsigned long long)hi << 32) | lo); }
__device__ __forceinline__ bool da_adv2(const DaGeom& g, DaCur& c) { if (c.t + 1 < c.nt) { ++c.t; return false; } if (c.j + 1 < g.nblk) { ++c.j; c.t = 0; c.nt = da_blk(g, c.j).nt; return true; } return false; }
__device__ __forceinline__ void da_phase(char* lds, const bf16* Qb, const bf16* Kb, const bf16* Vb, bf16* Ob, int vcu, int G, int skvp, int seq, int nmeta, int test = 0) {
    const int tid = tid_fresh(), wid = __builtin_amdgcn_readfirstlane(tid >> 6), lane = tid & 63, r32 = lane & 31, hi = lane >> 5;
    const bool prod = wid < 4; const int pw = wid & 3;
    DaGeom g{Qb, Kb, Vb, Ob, vcu, G, 0, skvp, seq, nmeta, test};
    { const int nitems = (2048 - vcu + G - 1) / G; g.nblk = vcu < 2048 ? 2 * nitems : 0; }
    if (g.nblk == 0) return;
    int nsteps = 1; for (int j = 0; j < g.nblk; ++j) nsteps += da_blk(g, j).nt;
    char* K_lds = lds + DA_K; char* V_lds = lds + DA_V;
    const int vb0 = (int)(uintptr_t)V_lds + v_rd_base(lane);
    float* al_w = (float*)(lds + DA_AL); unsigned* fl_w = (unsigned*)(lds + DA_FL); float* ll_w = (float*)(lds + DA_LL);
    const DaCur cstart{0, 0, da_blk(g, 0).nt};
    unsigned voffK[4], voffV[4];
#pragma unroll
    for (int j = 0; j < 4; ++j) { const int row = 16 * pw + 4 * j + (lane >> 4), chunk = (lane & 15) ^ (row & 15); voffK[j] = (unsigned)(row * 256 + chunk * 16);
        const int key = (pw << 4) | (((lane >> 4) & 1) << 3) | ((j >> 1) << 2) | ((lane >> 2) & 3), col = ((2 * (j & 1) + (lane >> 5)) << 5) | ((lane & 3) * 8); voffV[j] = (unsigned)(key * 256 + col * 2); }
    const unsigned dmaw = (unsigned)pw * 4096u;
#define DA_GLDS(src, ldsoff) __builtin_amdgcn_global_load_lds((const __attribute__((address_space(1))) unsigned*)(src), (__attribute__((address_space(3))) unsigned*)(lds + (ldsoff)), 16, 0, 0)
    DaCur ck = cstart, cv = cstart; const DaBlk Bkv = da_blk(g, 0);
    const char* kbase = (const char*)Bkv.K; const char* v0base = (const char*)Bkv.V0; const char* v1base = (const char*)Bkv.V1;
#define DA_ADVK() do { if (da_adv2(g, ck)) kbase = (const char*)da_blk(g, ck.j).K; } while (0)
#define DA_ADVV() do { if (da_adv2(g, cv)) { const DaBlk Bn_ = da_blk(g, cv.j); v0base = (const char*)Bn_.V0; v1base = (const char*)Bn_.V1; } } while (0)
#define DA_BAR() do { asm volatile("s_waitcnt lgkmcnt(0)" ::: "memory"); __builtin_amdgcn_s_barrier(); asm volatile("" ::: "memory"); } while (0)
#define DA_DMA1(PAR, i) do { const int j_ = (i) / 2, k_ = (i) % 2; unsigned vo_ = voffV[j_]; asm volatile("" : "+v"(vo_));     \
        if (k_ == 0) DA_GLDS(p0_ + vo_, DA_V + (2 * PAR) * SHM_V + dmaw + j_ * 1024); else DA_GLDS(p1_ + vo_, DA_V + (2 * PAR + 1) * SHM_V + dmaw + j_ * 1024); } while (0)
#define DA_DMAK(PAR) do { DA_ADVK(); const da_gptr kp = da_uni(kbase + (size_t)da_tile(ck) * 16384u); \
        _Pragma("unroll") for (int j_ = 0; j_ < 4; ++j_) { unsigned vo_ = voffK[j_]; asm volatile("" : "+v"(vo_)); DA_GLDS(kp + vo_, DA_K + (1 - PAR) * SHM_K + dmaw + j_ * 1024); } } while (0)
    if (prod) {
#pragma unroll
        for (int j = 0; j < 4; ++j) DA_GLDS(da_uni(kbase) + voffK[j], DA_K + dmaw + j * 1024);
    }
    if (prod) {
        bf16x8 qr[8]; float m_reg = -1e30f, l_reg = 0.f; DaCur cp = cstart; DaBlk Bp = da_blk(g, 0);
        bf16x8 qn[8];
#pragma unroll
        for (int d0 = 0; d0 < 8; ++d0) qn[d0] = bf16x8{};
#pragma unroll
        for (int d0 = 0; d0 < 8; ++d0) qr[d0] = load8<bf16>(Bp.Q + (size_t)(pw * QBLK + r32) * D + d0 * 16 + hi * 8);
        asm volatile("s_waitcnt vmcnt(0)" ::: "memory");
        DA_BAR();
#define DA_PSTEP(PAR, S, s_) do { bool qpf = false; \
            if ((s_) < nsteps - 1) { \
                f32x16 p0 = f32x16{}, p1 = f32x16{}; float mn, al = 1.f; bf16x8 pa0 = qr[0], pa1 = qr[1], pa2 = qr[2], pa3 = qr[3]; \
                { da_qkt<PAR>(p0, p1, K_lds, r32, hi, qr); DA_DMAK(PAR); SBAR();     \
                { const int qlo = Bp.P0 + pw * QBLK, kb_ = da_tile(cp) * KVBLK; if (kb_ + KVBLK - 1 > qlo) mask_tile(p0, p1, qlo + r32 - 4 * hi - kb_, 1u << 30); } \
                partialSM(p0, p1, m_reg, mn, al); finishSM(p0, p1, al, l_reg, pa0, pa1, pa2, pa3); } \
                char* px = lds + DA_PX + PAR * 16384 + pw * 4096 + lane * 16; \
                *(bf16x8*)(px) = pa0; *(bf16x8*)(px + 1024) = pa1; *(bf16x8*)(px + 2048) = pa2; *(bf16x8*)(px + 3072) = pa3; \
                if (hi == 0) al_w[PAR * 128 + pw * 32 + r32] = al; \
                const bool anyr = __any(al < 1.f); if (lane == 0) fl_w[PAR * 4 + pw] = anyr ? 1u : 0u; \
                if (cp.t == cp.nt - 2 && cp.j + 1 < g.nblk) { const DaBlk Bn = da_blk(g, cp.j + 1); qpf = true;     \
                    _Pragma("unroll") for (int d0 = 0; d0 < 8; ++d0) qn[d0] = load8<bf16>(Bn.Q + (size_t)(pw * QBLK + r32) * D + d0 * 16 + hi * 8); } \
                if (cp.t == cp.nt - 1) {                                     \
                    if (hi == 0) ll_w[pw * 32 + r32] = l_reg; m_reg = -1e30f; l_reg = 0.f; \
                    _Pragma("unroll") for (int d0 = 0; d0 < 8; ++d0) qr[d0] = qn[d0]; } \
                if (da_adv2(g, cp)) Bp = da_blk(g, cp.j); \
            } \
            if (qpf) asm volatile("s_waitcnt vmcnt(8)" ::: "memory"); else asm volatile("s_waitcnt vmcnt(0)" ::: "memory");     \
            DA_BAR(); } while (0)
        for (int s = 0; s < nsteps; s += 2) { DA_PSTEP(0, 0, s); if (s + 1 < nsteps) DA_PSTEP(1, 0, s + 1); }
#undef DA_PSTEP
    } else {
        f32x16 o[8]; DaCur cc = cstart; DaBlk Bc = da_blk(g, 0);
        const int rh = pw >> 1, ch = pw & 1, vb0c = vb0 + ch * SHM_V;
        bool stored = false;
#pragma unroll
        for (int d = 0; d < 8; ++d) o[d] = f32x16{};
        asm volatile("s_waitcnt vmcnt(0)" ::: "memory");
        DA_BAR();
        {
            const da_gptr p0_ = da_uni(v0base + (size_t)da_tile(cv) * 16384u), p1_ = da_uni(v1base + (size_t)da_tile(cv) * 16384u); DA_ADVV();
#pragma unroll
            for (int i_ = 0; i_ < 8; ++i_) DA_DMA1(0, i_);
            asm volatile("s_waitcnt vmcnt(0)" ::: "memory");
            DA_BAR();
        }
#define DA_CSTEP(PAR, S, s_) do { stored = false; \
            const da_gptr p0_ = da_uni(v0base + (size_t)da_tile(cv) * 16384u), p1_ = da_uni(v1base + (size_t)da_tile(cv) * 16384u); DA_ADVV(); \
            _Pragma("unroll") for (int i_ = 0; i_ < 8; ++i_) DA_DMA1(PAR, i_); SBAR();     \
            { \
                const char* px = lds + DA_PX + (1 - PAR) * 16384 + rh * 8192 + lane * 16; \
                const bf16x8 pa0 = *(const bf16x8*)(px), pa1 = *(const bf16x8*)(px + 1024), pa2 = *(const bf16x8*)(px + 2048), pa3 = *(const bf16x8*)(px + 3072); \
                const bf16x8 pb0 = *(const bf16x8*)(px + 4096), pb1 = *(const bf16x8*)(px + 5120), pb2 = *(const bf16x8*)(px + 6144), pb3 = *(const bf16x8*)(px + 7168); \
                _Pragma("unroll") for (int rb = 0; rb < 2; ++rb) { \
                    if (fl_w[(1 - PAR) * 4 + 2 * rh + rb] != 0u) { const float* alp = al_w + (1 - PAR) * 128 + (2 * rh + rb) * 32; \
                        _Pragma("unroll") for (int r = 0; r < 16; ++r) { const float a_ = alp[crow(r, hi)]; _Pragma("unroll") for (int d_ = 0; d_ < 4; ++d_) o[4 * rb + d_][r] *= a_; } } } \
                asm volatile("s_waitcnt lgkmcnt(0)" ::: "memory"); SBAR(); \
                da_pv2<2 * (1 - PAR)>(o, vb0c, pa0, pa1, pa2, pa3, pb0, pb1, pb2, pb3, [&](int i_) { DA_DMA1(PAR, i_); });     \
                if (cc.t == cc.nt - 1) {                                     \
                    char* osc = lds + DA_OSC + pw * 4096; const bool odd = (r32 & 1) != 0; bf16* Oh = ch ? Bc.O1 : Bc.O0; \
                    _Pragma("unroll") for (int rb = 0; rb < 2; ++rb) { \
                        float rli[16]; _Pragma("unroll") for (int r = 0; r < 16; ++r) rli[r] = __builtin_amdgcn_rcpf(ll_w[(2 * rh + rb) * 32 + crow(r, hi)]); \
                        _Pragma("unroll") for (int k = 0; k < 2; ++k) { \
                            _Pragma("unroll") for (int dd = 0; dd < 2; ++dd) _Pragma("unroll") for (int rp = 0; rp < 8; ++rp) { \
                                const float v0 = o[4 * rb + 2 * k + dd][2 * rp] * rli[2 * rp], v1 = o[4 * rb + 2 * k + dd][2 * rp + 1] * rli[2 * rp + 1]; \
                                const float snd = odd ? v0 : v1, rcv = dppf<0xB1, false>(snd);         \
                                const unsigned w = odd ? cvtpk(rcv, v1) : cvtpk(v0, rcv);                \
                                *(unsigned*)(osc + crow(odd ? 2 * rp + 1 : 2 * rp, hi) * 128 + (dd * 32 + (r32 & ~1)) * 2) = w; } \
                            asm volatile("s_waitcnt lgkmcnt(0)" ::: "memory"); \
                            bf16* Og = Oh + (size_t)((2 * rh + rb) * QBLK) * D + k * 64 + (lane & 7) * 8; \
                            _Pragma("unroll") for (int i = 0; i < 4; ++i) { const int row = (lane >> 3) + 8 * i; const bf16x8 vv = *(const bf16x8*)(osc + row * 128 + (lane & 7) * 16); \
                                if (DA_TESTV(g) == 0) __builtin_nontemporal_store(vv, (bf16x8*)(Og + (size_t)row * D)); } \
                            asm volatile("s_waitcnt lgkmcnt(0)" ::: "memory"); } } \
                    stored = true; _Pragma("unroll") for (int d0 = 0; d0 < 8; ++d0) o[d0] = f32x16{}; } \
                if (da_adv2(g, cc)) Bc = da_blk(g, cc.j); \
            } \
            if (stored) asm volatile("s_waitcnt vmcnt(16)" ::: "memory"); else asm volatile("s_waitcnt vmcnt(0)" ::: "memory");     \
            DA_BAR(); } while (0)
        for (int s = 1; s < nsteps; s += 2) { DA_CSTEP(1, 0, s); if (s + 1 < nsteps) DA_CSTEP(0, 0, s + 1); }
#undef DA_CSTEP
    }
#undef DA_DMA1
#undef DA_DMAK
#undef DA_GLDS
#undef DA_ADVK
#undef DA_ADVV
#undef DA_BAR
}
}
#define GAS __attribute__((address_space(1)))
#define LAS __attribute__((address_space(3)))
typedef unsigned short bf16;
typedef unsigned u32x4 __attribute__((ext_vector_type(4)));
typedef unsigned u32x2 __attribute__((ext_vector_type(2)));
typedef float f32x4 __attribute__((ext_vector_type(4)));
typedef float f32x2 __attribute__((ext_vector_type(2)));
typedef short bf16x8 __attribute__((ext_vector_type(8)));

#ifndef GEMM_SP2
#define GEMM_SP2 true
#endif
constexpr int DM = 4096, NB = 2, SEQ = 8192, NMETA = 16, FF = 16384, NH = 16, DH = 128, NSH = 32;
constexpr int MX = NB * SEQ;
constexpr int MP = MX + 256;
constexpr int SKVP = 8256, LPOS = 8208;
constexpr int SG = 256, SP = 64, SGS = 16;
constexpr float EPS = 1e-6f;
static_assert(SKVP == pg8::E_SKVP && NMETA == pg8::E_NMETA && MX / 256 == pg8::E_MXP, "epilogue constants");

constexpr size_t MiB = 1u << 20;
constexpr size_t WS_CTL = 0, CTL_ZERO_BYTES = 256 * 1024;
constexpr size_t WS_WQKV = 1 * MiB;
constexpr size_t WS_WO   = WS_WQKV + 96 * MiB;
constexpr size_t WS_WGLU = WS_WO + 32 * MiB;
constexpr size_t WS_WUP  = WS_WGLU + 64 * MiB;
constexpr size_t WS_WDN  = WS_WUP + 256 * MiB;
constexpr size_t WS_H    = WS_WDN + 256 * MiB;
constexpr size_t WS_PART = WS_H + 130 * MiB;
constexpr size_t WS_RSTD = WS_PART + 16 * MiB;
constexpr size_t WS_HN   = WS_H + 260 * MiB;
constexpr size_t WS_ATTO = WS_HN + 130 * MiB;
constexpr size_t WS_R    = WS_ATTO + 130 * MiB;
constexpr size_t QKV_T_BYTES = (size_t)NB * NSH * SKVP * DH * 2;
constexpr size_t WS_Q = WS_R, WS_K = WS_Q + QKV_T_BYTES, WS_V = WS_K + QKV_T_BYTES, WS_O = WS_V + QKV_T_BYTES;
constexpr size_t O_BYTES = (size_t)128 * SEQ * DH * 2;
constexpr size_t WS_MID = WS_R;
constexpr size_t WS_END = WS_O + O_BYTES;
static_assert((size_t)MP * DM * 4 == 260 * MiB && (size_t)MP * DM * 2 == 130 * MiB && QKV_T_BYTES == 129 * MiB && (size_t)MP * FF * 2 <= WS_END - WS_R, "ws map");
constexpr size_t WS_MPART = WS_END + 14 * MiB;
constexpr int CW_XRANK = 8192;
constexpr int CW_BAR = 4096;

constexpr int RING_BYTES = 131072;
constexpr int S5_BFRAG = 0, S5_CFRAG = 65536, S5_KTAB = 131072, S5_CPOW = 139264, S5_WPOW = 147456, S5_A256 = 149504, S5_A1024 = 150016, S5_F = 150528  , S5_EMETA = S5_F + 8192  ;
constexpr int MISC_OFF = 159232, LDS_BYTES = 159744;
static_assert(S5_EMETA + 512 == MISC_OFF && ab::LDS_BYTES <= RING_BYTES && 17 * 64 * 8 <= 8704, "LDS map");

#define LDS_WAIT() asm volatile("s_waitcnt lgkmcnt(0)" ::: "memory")
__device__ __forceinline__ unsigned pk2(float lo, float hi) { unsigned r; asm volatile("v_cvt_pk_bf16_f32 %0, %1, %2" : "=v"(r) : "v"(lo), "v"(hi)); return r; }
__device__ __forceinline__ float bflo(unsigned w) { return __builtin_bit_cast(float, w << 16); }
__device__ __forceinline__ float bfhi(unsigned w) { return __builtin_bit_cast(float, w & 0xffff0000u); }
__device__ __forceinline__ float wave_sum(float v) {
#pragma unroll
    for (int o = 1; o < 64; o <<= 1) v += __shfl_xor(v, o);
    return v;
}

#define XB_TMO      128
#define XB_XCNT(j)  (256  + 64 * (j))
#define XB_XSUB(j)  (1280 + 64 * (j))
#define XB_XGEN(j)  (2304 + 64 * (j))
#define XB_TOP      3328
#define XB_TOPGEN   3392
#define XCD_BAR_WORDS 3456
#define XB_SPIN_CAP (1u << 18)

__device__ __forceinline__ unsigned xb_ld(unsigned* p)              { return __hip_atomic_load(p, __ATOMIC_RELAXED, __HIP_MEMORY_SCOPE_AGENT); }
__device__ __forceinline__ unsigned xb_add(unsigned* p, unsigned v) { return __hip_atomic_fetch_add(p, v, __ATOMIC_RELAXED, __HIP_MEMORY_SCOPE_AGENT); }
__device__ __forceinline__ unsigned xb_xcc_id() { return (unsigned)__builtin_amdgcn_s_getreg((3 << 11) | 20) & 0xFu; }
#define XB_SPIN(cond, bar) do { unsigned _sp = 0; while (cond) { __builtin_amdgcn_s_sleep(1); \
    if ((++_sp & 255u) == 0u) { if (xb_ld(&(bar)[XB_TMO])) break; if (_sp > XB_SPIN_CAP) { atomicAdd(&(bar)[XB_TMO], 1u); break; } } } } while (0)

struct XcdBarrier {
    unsigned* bar; unsigned x;
    volatile LAS unsigned* st;
};

__device__ __forceinline__ XcdBarrier xcd_barrier_post(unsigned* bar, volatile LAS unsigned* st) {
    XcdBarrier b; b.bar = bar; b.x = xb_xcc_id(); b.st = st;
    if (threadIdx.x == 0) (void)xb_add(&bar[XB_XCNT(b.x)], 1u);
    return b;
}
__device__ __forceinline__ void xcd_barrier_complete(unsigned* bar, unsigned x, unsigned& nloc, unsigned& nx) {
    const unsigned G = gridDim.x * gridDim.y * gridDim.z;
    unsigned sum, cnt, mine, sp = 0u;
    for (;;) {
        sum = 0u; cnt = 0u; mine = 0u;
#pragma unroll
        for (unsigned j = 0; j < 16; ++j) { const unsigned c = xb_ld(&bar[XB_XCNT(j)]); sum += c; cnt += (c > 0u) ? 1u : 0u; mine = (j == x) ? c : mine; }
        if (sum == G) break;
        __builtin_amdgcn_s_sleep(1);
        if ((++sp & 255u) == 0u) { if (xb_ld(&bar[XB_TMO])) break; if (sp > XB_SPIN_CAP) { atomicAdd(&bar[XB_TMO], 1u); break; } }
    }
    nloc = mine > 0u ? mine : 1u; nx = cnt > 0u ? cnt : 1u;
}

__device__ __forceinline__ void xcd_barrier(const XcdBarrier& b) {
    asm volatile("s_waitcnt vmcnt(0)" ::: "memory");
    __syncthreads();
    if (threadIdx.x == 0) {
        unsigned* bar = b.bar;
        __builtin_amdgcn_s_waitcnt(0);
        unsigned nloc = b.st[0], nx = b.st[1];
        if (nloc == 0u) { xcd_barrier_complete(bar, b.x, nloc, nx); b.st[0] = nloc; b.st[1] = nx; }
        const unsigned old = xb_add(&bar[XB_XSUB(b.x)], 1u);
        const unsigned gen = old / nloc;
        if (old + 1u == (gen + 1u) * nloc) {
            __builtin_amdgcn_fence(__ATOMIC_RELEASE, "agent");
            asm volatile("s_waitcnt vmcnt(0)" ::: "memory");
            const unsigned og = xb_add(&bar[XB_TOP], 1u);
            const unsigned tg = og / nx;
            if (og + 1u == (tg + 1u) * nx) xb_add(&bar[XB_TOPGEN], 1u);
            else XB_SPIN(xb_ld(&bar[XB_TOPGEN]) == tg, bar);
            __builtin_amdgcn_fence(__ATOMIC_ACQUIRE, "agent");
            xb_add(&bar[XB_XGEN(b.x)], 1u);
            asm volatile("s_waitcnt vmcnt(0)" ::: "memory");
        } else {
            XB_SPIN(xb_ld(&bar[XB_XGEN(b.x)]) == gen, bar);
            __builtin_amdgcn_fence(__ATOMIC_ACQUIRE, "agent");
            asm volatile("s_waitcnt vmcnt(0)" ::: "memory");
        }
    }
    __syncthreads();
}

__device__ __forceinline__ void transpose_item(const float* __restrict__ W, int K, int N, bf16* __restrict__ WT, int k0, int n0, int drow0, LAS float* scr, int lane, const float* __restrict__ gk = nullptr) {
    const int kk0 = lane >> 4, nq = lane & 15;
#pragma unroll
    for (int half = 0; half < 2; ++half) {
        f32x4 v[8];
#pragma unroll
        for (int i = 0; i < 8; ++i) v[i] = *(const f32x4*)(W + (size_t)(k0 + (half * 8 + i) * 4 + kk0) * N + n0 + 4 * nq);
#pragma unroll
        for (int i = 0; i < 8; ++i) { LAS float* s = scr + ((half * 8 + i) * 4 + kk0) * 65 + 4 * nq; const float gs = gk ? gk[k0 + (half * 8 + i) * 4 + kk0] : 1.0f; s[0] = v[i].x * gs; s[1] = v[i].y * gs; s[2] = v[i].z * gs; s[3] = v[i].w * gs; }
    }
    LDS_WAIT(); asm volatile("" ::: "memory");
    const int c = lane & 7;
#pragma unroll
    for (int j = 0; j < 8; ++j) { const int n = (lane >> 3) + 8 * j; const LAS float* s = scr + (8 * c) * 65 + n;
        u32x4 o; o.x = pk2(s[0 * 65], s[1 * 65]); o.y = pk2(s[2 * 65], s[3 * 65]); o.z = pk2(s[4 * 65], s[5 * 65]); o.w = pk2(s[6 * 65], s[7 * 65]);
        *(u32x4*)(WT + (size_t)(drow0 + n) * K + k0 + 8 * c) = o; }
    LDS_WAIT(); asm volatile("" ::: "memory");
}
template <bool COPY> __device__ __forceinline__ void rms_row(const float* __restrict__ src, const float* __restrict__ g, bf16* __restrict__ dst, float* __restrict__ cp, int lane) {
    const f32x4* s4 = (const f32x4*)src + lane; f32x4 v[16]; float ss = 0.f;
#pragma unroll
    for (int j = 0; j < 16; ++j) { v[j] = s4[64 * j]; ss += (v[j].x * v[j].x + v[j].y * v[j].y) + (v[j].z * v[j].z + v[j].w * v[j].w); }
    if (COPY) {
#pragma unroll
        for (int j = 0; j < 16; ++j) ((f32x4*)cp + lane)[64 * j] = v[j]; }
    ss = wave_sum(ss); const float rstd = 1.0f / sqrtf(ss * (1.0f / DM) + EPS);
    const f32x4* g4 = (const f32x4*)g + lane; u32x2* d2 = (u32x2*)dst + lane;
#pragma unroll
    for (int j = 0; j < 16; ++j) { const f32x4 gv = g4[64 * j]; u32x2 o; o.x = pk2(v[j].x * rstd * gv.x, v[j].y * rstd * gv.y); o.y = pk2(v[j].z * rstd * gv.z, v[j].w * rstd * gv.w); d2[64 * j] = o; }
}
__device__ __forceinline__ void rms_row_bf(const bf16* __restrict__ src, const float* __restrict__ g, bf16* __restrict__ dst, int lane) {
    const u32x4* s4 = (const u32x4*)src + lane; u32x4 v[8]; float ss = 0.f;
#pragma unroll
    for (int j = 0; j < 8; ++j) { v[j] = s4[64 * j];
#pragma unroll
        for (int q = 0; q < 4; ++q) { const float a = bflo(v[j][q]), b = bfhi(v[j][q]); ss += a * a + b * b; } }
    ss = wave_sum(ss); const float rstd = 1.0f / sqrtf(ss * (1.0f / DM) + EPS);
    u32x4* d4 = (u32x4*)dst + lane;
#pragma unroll
    for (int j = 0; j < 8; ++j) { const f32x4 g0 = *(const f32x4*)(g + 8 * (lane + 64 * j)), g1 = *(const f32x4*)(g + 8 * (lane + 64 * j) + 4); u32x4 o;
        o.x = pk2(bflo(v[j].x) * rstd * g0.x, bfhi(v[j].x) * rstd * g0.y); o.y = pk2(bflo(v[j].y) * rstd * g0.z, bfhi(v[j].y) * rstd * g0.w);
        o.z = pk2(bflo(v[j].z) * rstd * g1.x, bfhi(v[j].z) * rstd * g1.y); o.w = pk2(bflo(v[j].w) * rstd * g1.z, bfhi(v[j].w) * rstd * g1.w); d4[64 * j] = o; }
}
__device__ __forceinline__ void zero_row(bf16* dst, float* cp, int lane) {
    u32x2* d2 = (u32x2*)dst + lane;
#pragma unroll
    for (int j = 0; j < 16; ++j) { d2[64 * j] = (u32x2){0u, 0u}; if (cp) ((f32x4*)cp + lane)[64 * j] = (f32x4){0.f, 0.f, 0.f, 0.f}; }
}

struct Ptrs {
    const float *x, *meta, *g_mix, *g_mlp, *wqkv, *qg, *kg, *lamv, *sg, *wo, *a_re, *a_im, *log_dt, *b_re, *b_im, *c_re, *c_im, *dsk, *wglu, *bglu, *wup, *wdn;
    float* out; unsigned char* ws;
};

__device__ __forceinline__ void p0_prologue(const Ptrs& P, LAS unsigned char* lds, int gw, int NGW, int wave, int lane) {
    LAS float* scr = (LAS float*)(lds + wave * 16640);
    bf16* Wqkv_t = (bf16*)(P.ws + WS_WQKV); bf16* Wo_t = (bf16*)(P.ws + WS_WO); bf16* Wglu_t = (bf16*)(P.ws + WS_WGLU); bf16* Wup_t = (bf16*)(P.ws + WS_WUP); bf16* Wdn_t = (bf16*)(P.ws + WS_WDN);
    constexpr int I_QKV = 64 * 192, I_O = 64 * 64, I_GLU = 64 * 128, I_UP = 64 * 256, I_DN = 256 * 64;
    constexpr int NITEMS = I_QKV + I_O + I_GLU + 2 * I_UP + 2 * I_DN;
    for (int it = gw; it < NITEMS; it += NGW) {
        int r = it;
        if (r < I_QKV) { const int kb = r / 192, nb = r % 192; transpose_item(P.wqkv, DM, 3 * DM, Wqkv_t, 64 * kb, 64 * nb, 64 * nb, scr, lane); continue; } r -= I_QKV;
        if (r < I_O) { const int kb = r / 64, nb = r % 64; transpose_item(P.wo, DM, DM, Wo_t, 64 * kb, 64 * nb, 64 * nb, scr, lane); continue; } r -= I_O;
        if (r < I_GLU) { const int kb = r / 128, nb = r % 128, n0 = 64 * nb, hf = n0 / DM, f0 = n0 % DM; transpose_item(P.wglu, DM, 2 * DM, Wglu_t, 64 * kb, n0, 256 * (f0 / 128) + 128 * hf + (f0 % 128), scr, lane); continue; } r -= I_GLU;
        if (r < 2 * I_UP) { const int l = r / I_UP; r -= l * I_UP; const int kb = r / 256, nb = r % 256; transpose_item(P.wup + (size_t)l * DM * FF, DM, FF, Wup_t + (size_t)l * DM * FF, 64 * kb, 64 * nb, 64 * nb, scr, lane, P.g_mlp + (size_t)l * DM); continue; } r -= 2 * I_UP;
        { const int l = r / I_DN; r -= l * I_DN; const int kb = r / 64, nb = r % 64; transpose_item(P.wdn + (size_t)l * DM * FF, FF, DM, Wdn_t + (size_t)l * DM * FF, 64 * kb, 64 * nb, 64 * nb, scr, lane); }
    }
    bf16* H = (bf16*)(P.ws + WS_H); bf16* HN = (bf16*)(P.ws + WS_HN);
    for (int m = gw; m < MP; m += NGW) {
        if (m < MX) rms_row<false>(P.x + (size_t)m * DM, P.g_mix, HN + (size_t)m * DM, nullptr, lane);
        else if (m < MX + NMETA) { rms_row<false>(P.meta + (size_t)(m - MX) * DM, P.g_mix, HN + (size_t)m * DM, nullptr, lane);
            const f32x4* ms = (const f32x4*)(P.meta + (size_t)(m - MX) * DM) + lane; u32x2* hd = (u32x2*)(H + (size_t)m * DM) + lane;
            for (int j = 0; j < 16; ++j) { const f32x4 t4 = ms[64 * j]; hd[64 * j] = (u32x2){pk2(t4.x, t4.y), pk2(t4.z, t4.w)}; } }
        else zero_row(HN + (size_t)m * DM, nullptr, lane);
    }
    for (int it = gw; it < 3 * 64 * (SKVP - LPOS); it += NGW) { const int t = it / (64 * (SKVP - LPOS)), r2 = it % (64 * (SKVP - LPOS)), bh = r2 / (SKVP - LPOS), pp = LPOS + r2 % (SKVP - LPOS);
        bf16* base = (bf16*)(P.ws + WS_Q + (size_t)t * QKV_T_BYTES) + ((size_t)bh * SKVP + pp) * DH; ((unsigned*)base)[lane] = 0u; }
}

template <class Epi> __device__ __forceinline__ void skinny16(LAS unsigned char* lds, const bf16* __restrict__ A  , const bf16* __restrict__ Bt  , int ld, int N, int kparts, int vcu, int G, int tid, const Epi& E) {
    const int wave = __builtin_amdgcn_readfirstlane(tid >> 6), lane = tid & 63, fr = lane & 15, fq = lane >> 4;
    const int kpart = vcu % kparts, slot = vcu / kparts, nslots = G / kparts;
    LAS f32x4* red = (LAS f32x4*)lds;
    const bf16* ap = A + (size_t)fr * ld + kpart * 4096 + wave * 512 + 16 * fq;
    bf16x8 a[16];
#pragma unroll
    for (int i = 0; i < 8; ++i) { a[2 * i] = *(const bf16x8*)(ap + 64 * i); a[2 * i + 1] = *(const bf16x8*)(ap + 64 * i + 8); }
    for (int task = slot; task < (N >> 4); task += nslots) {
        const int n0 = task * 16;
        const bf16* bp = Bt + (size_t)(n0 + fr) * ld + kpart * 4096 + wave * 512 + 16 * fq;
        bf16x8 b[16];
#pragma unroll
        for (int i = 0; i < 8; ++i) { b[2 * i] = *(const bf16x8*)(bp + 64 * i); b[2 * i + 1] = *(const bf16x8*)(bp + 64 * i + 8); }
        f32x4 acc = (f32x4){0.f, 0.f, 0.f, 0.f};
#pragma unroll
        for (int i = 0; i < 16; ++i) acc = __builtin_amdgcn_mfma_f32_16x16x32_bf16(b[i], a[i], acc, 0, 0, 0);
        __syncthreads();
        red[wave * 64 + lane] = acc;
        __syncthreads();
        if (wave == 0) { f32x4 s = red[lane];
#pragma unroll
            for (int w = 1; w < 8; ++w) s += red[w * 64 + lane];
            E(s, n0 + 4 * fq, fr, kpart); }
    }
    __syncthreads();
}
struct SkQKV { bf16* Q; __device__ __forceinline__ void operator()(f32x4 v, int n, int row, int) const {
    const int sec = n / DM, hid = (n % DM) / DH, d = n % DH; bf16* dst = Q + (size_t)sec * (QKV_T_BYTES / 2) + ((size_t)hid * SKVP + row) * DH + d;
    const u32x2 w = (u32x2){pk2(v.x, v.y), pk2(v.z, v.w)}; *(u32x2*)dst = w; *(u32x2*)(dst + (size_t)NSH * SKVP * DH) = w; } };
struct SkRes { bf16* H; __device__ __forceinline__ void operator()(f32x4 v, int n, int row, int) const { u32x2* p = (u32x2*)(H + (size_t)(MX + row) * DM + n); const u32x2 w = *p;
    *p = (u32x2){pk2(bflo(w.x) + v.x, bfhi(w.x) + v.y), pk2(bflo(w.y) + v.z, bfhi(w.y) + v.w)}; } };
struct SkPart { float* part; __device__ __forceinline__ void operator()(f32x4 v, int n, int row, int kpart) const { *(f32x4*)(part + ((size_t)kpart * NMETA + row) * DM + n) = v; } };
struct SkRelu2 { bf16* MID; const float* rstd; __device__ __forceinline__ void operator()(f32x4 v, int n, int row, int) const { const float rs = rstd[MX + row], q = rs * rs;
    const float a = fmaxf(v.x, 0.f), b = fmaxf(v.y, 0.f), c = fmaxf(v.z, 0.f), d = fmaxf(v.w, 0.f); *(u32x2*)(MID + (size_t)(MX + row) * FF + n) = (u32x2){pk2(a * a * q, b * b * q), pk2(c * c * q, d * d * q)}; } };

__device__ __forceinline__ void norm_phase(const bf16* H, const float* g, bf16* HN, int nrows, int gw, int NGW, int lane) {
    for (int m = gw; m < nrows; m += NGW) rms_row_bf(H + (size_t)m * DM, g, HN + (size_t)m * DM, lane);
}

__device__ __forceinline__ void rstd_phase(const float* part, int npart  , float* rstd, const bf16* H, bool with_meta, int gw, int NGW, int lane) {
    for (int m = gw; m < MX; m += NGW) { const float* pr = part + (size_t)m * 128; float s = pr[lane]; if (npart > 64) s += pr[64 + lane];
        s = wave_sum(s); if (lane == 0) rstd[m] = 1.0f / sqrtf(s * (1.0f / DM) + EPS); }
    if (with_meta) for (int m = MX + gw; m < MX + NMETA; m += NGW) { const u32x4* s4 = (const u32x4*)(H + (size_t)m * DM) + lane; float ss = 0.f;
#pragma unroll
        for (int j = 0; j < 8; ++j) { const u32x4 v = s4[64 * j];
#pragma unroll
            for (int q = 0; q < 4; ++q) { const float a = bflo(v[q]), b = bfhi(v[q]); ss += a * a + b * b; } }
        ss = wave_sum(ss); if (lane == 0) rstd[m] = 1.0f / sqrtf(ss * (1.0f / DM) + EPS); }
}
__device__ __forceinline__ void qk_rope_phase(bf16* Q, bf16* K, const float* qg, const float* kg, int gw, int NGW, int lane) {
    const int j16 = lane & 15, rr = lane >> 4;
    float inv[4];
#pragma unroll
    for (int t = 0; t < 4; ++t) inv[t] = exp2f(-(float)(2 * (4 * j16 + t)) * (13.287712379549449f / 128.0f));
    for (int item = gw; item < NB * LPOS; item += NGW) {
        const int b = item / LPOS, p = item % LPOS;
        float cs[4], sn[4];
#pragma unroll
        for (int t = 0; t < 4; ++t) { const float ang = (float)p * inv[t]; cs[t] = cosf(ang); sn[t] = sinf(ang); }
#pragma unroll 1
        for (int ten = 0; ten < 2; ++ten) {
            bf16* T = ten ? K : Q; const float* g = ten ? kg : qg;
            const f32x4 g1 = *(const f32x4*)(g + 4 * j16), g2 = *(const f32x4*)(g + 64 + 4 * j16);
            bf16* row0 = T + ((size_t)(b * NSH + rr) * SKVP + p) * DH;
            u32x2 a[8], c[8];
#pragma unroll
            for (int ps = 0; ps < 8; ++ps) { const bf16* row = row0 + (size_t)(4 * ps) * SKVP * DH; a[ps] = *(const u32x2*)(row + 4 * j16); c[ps] = *(const u32x2*)(row + 64 + 4 * j16); }
#pragma unroll
            for (int ps = 0; ps < 8; ++ps) {
                bf16* row = row0 + (size_t)(4 * ps) * SKVP * DH;
                float x1[4] = {bflo(a[ps].x), bfhi(a[ps].x), bflo(a[ps].y), bfhi(a[ps].y)}, x2[4] = {bflo(c[ps].x), bfhi(c[ps].x), bflo(c[ps].y), bfhi(c[ps].y)};
                float ss = 0.f;
#pragma unroll
                for (int t = 0; t < 4; ++t) ss += x1[t] * x1[t] + x2[t] * x2[t];
                ss += __shfl_xor(ss, 1); ss += __shfl_xor(ss, 2); ss += __shfl_xor(ss, 4); ss += __shfl_xor(ss, 8);
                const float rstd = 1.0f / sqrtf(ss * (1.0f / DH) + EPS);
                float o1[4], o2[4];
#pragma unroll
                for (int t = 0; t < 4; ++t) { const float y1 = x1[t] * rstd * g1[t], y2 = x2[t] * rstd * g2[t]; o1[t] = y1 * cs[t] - y2 * sn[t]; o2[t] = y2 * cs[t] + y1 * sn[t]; }
                *(u32x2*)(row + 4 * j16) = (u32x2){pk2(o1[0], o1[1]), pk2(o1[2], o1[3])};
                *(u32x2*)(row + 64 + 4 * j16) = (u32x2){pk2(o2[0], o2[1]), pk2(o2[2], o2[3])};
            }
        }
    }
}

typedef ab::BlockRef<ab::bf16, ab::bf16> ARef;
__device__ __forceinline__ ARef attn_ref(int L, int pass, const bf16* Q, const bf16* K, const bf16* V, bf16* O) {
    const int inst = L >> 4, x = L & 15, qb = pass ? 31 - x : x;
    const int b = inst >> 6, h = (inst >> 2) & 15, c = (inst >> 1) & 1, vh = inst & 1;
    ARef r;
    r.Q = Q + ((size_t)(b * NSH + 2 * h + c) * SKVP + NMETA + 256 * qb) * DH;
    r.K = K + (size_t)(b * NSH + 2 * h + c) * SKVP * DH;
    r.V = V + (size_t)(b * NSH + 2 * h + vh) * SKVP * DH;
    r.O = O + ((size_t)inst * SEQ + 256 * qb) * DH;
    r.P0 = NMETA + 256 * qb;
    return r;
}
__device__ __forceinline__ void attn_phase(char* lds, const bf16* Q, const bf16* K, const bf16* V, bf16* O, int vcu, int G) {
    constexpr int TOTAL = 128 * 16, W = 1 << 30;
    int L = vcu; if (L >= TOTAL) return;
    int pass = 0;
    ARef cur = attn_ref(L, 0, Q, K, V, O);
    ab::Seam<ab::bf16> S;
    ab::causal_swa_prime<ab::bf16, ab::bf16>(cur, W, lds, S);
    for (;;) {
        const bool more_pass = pass == 0, more_item = L + G < TOTAL, last = !more_pass && !more_item;
        int passn = pass + 1, Ln = L;
        if (!more_pass) { passn = 0; Ln = more_item ? L + G : L; }
        const ARef nxt = last ? cur : attn_ref(Ln, passn, Q, K, V, O);
        ab::causal_swa_block<ab::bf16, ab::bf16>(cur, nxt, SKVP, W, lds, S);
        if (last) break;
        cur = nxt; pass = passn; L = Ln;
    }
}

__device__ __forceinline__ void combine_phase(const Ptrs& P, int gw, int NGW, int lane) {
    const bf16* Ob = (const bf16*)(P.ws + WS_O); bf16* ATTO = (bf16*)(P.ws + WS_ATTO);
    const bf16* Qb = (const bf16*)(P.ws + WS_Q); const bf16* Kb = (const bf16*)(P.ws + WS_K); const bf16* Vb = (const bf16*)(P.ws + WS_V);
    float lam; { const float s1 = wave_sum(P.lamv[lane] * P.lamv[128 + lane] + P.lamv[64 + lane] * P.lamv[192 + lane]);
                 const float s2 = wave_sum(P.lamv[256 + lane] * P.lamv[384 + lane] + P.lamv[320 + lane] * P.lamv[448 + lane]); lam = expf(s1) - expf(s2) + 0.2f; }
    const f32x4 sgv = *(const f32x4*)(P.sg + 4 * lane);
    const int vh = lane >> 5, d = (lane & 31) * 4;
    for (int r = gw; r < MX; r += NGW) {
        const int b = r >> 13, i = r & (SEQ - 1);
#pragma unroll 4
        for (int h = 0; h < NH; ++h) {
            const int inst0 = ((b * NH + h) * 2 + 0) * 2 + vh;
            const u32x2 a = *(const u32x2*)(Ob + ((size_t)inst0 * SEQ + i) * DH + d), c = *(const u32x2*)(Ob + ((size_t)(inst0 + 2) * SEQ + i) * DH + d);
            float v[4] = {bflo(a.x) - lam * bflo(c.x), bfhi(a.x) - lam * bfhi(c.x), bflo(a.y) - lam * bflo(c.y), bfhi(a.y) - lam * bfhi(c.y)};
            const float ss = wave_sum((v[0] * v[0] + v[1] * v[1]) + (v[2] * v[2] + v[3] * v[3]));
            const float rs = 0.8f / sqrtf(ss * (1.0f / 256.0f) + EPS);
            *(u32x2*)(ATTO + (size_t)r * DM + h * 256 + 4 * lane) = (u32x2){pk2(v[0] * rs * sgv.x, v[1] * rs * sgv.y), pk2(v[2] * rs * sgv.z, v[3] * rs * sgv.w)};
        }
    }
    for (int t = gw; t < NMETA * NH; t += NGW) {
        const int qi = t >> 4, h = t & 15, j = lane & 15, part = lane >> 4;
        float am = 0.f;
#pragma unroll
        for (int c = 0; c < 2; ++c) {
            const bf16* qrow = Qb + ((size_t)(2 * h + c) * SKVP + qi) * DH + part * 32; const bf16* krow = Kb + ((size_t)(2 * h + c) * SKVP + j) * DH + part * 32;
            float s = 0.f;
#pragma unroll
            for (int e = 0; e < 4; ++e) { const u32x4 qv = *(const u32x4*)(qrow + 8 * e), kv = *(const u32x4*)(krow + 8 * e);
                s += bflo(qv.x) * bflo(kv.x) + bfhi(qv.x) * bfhi(kv.x) + bflo(qv.y) * bflo(kv.y) + bfhi(qv.y) * bfhi(kv.y) + bflo(qv.z) * bflo(kv.z) + bfhi(qv.z) * bfhi(kv.z) + bflo(qv.w) * bflo(kv.w) + bfhi(qv.w) * bfhi(kv.w); }
            s += __shfl_xor(s, 16); s += __shfl_xor(s, 32);
            s = (j <= qi) ? s * 0.08838834764831845f : -__builtin_inff();
            float mx = s; mx = fmaxf(mx, __shfl_xor(mx, 1)); mx = fmaxf(mx, __shfl_xor(mx, 2)); mx = fmaxf(mx, __shfl_xor(mx, 4)); mx = fmaxf(mx, __shfl_xor(mx, 8));
            const float e_ = expf(s - mx); float sm = e_; sm += __shfl_xor(sm, 1); sm += __shfl_xor(sm, 2); sm += __shfl_xor(sm, 4); sm += __shfl_xor(sm, 8);
            const float p_ = e_ / sm; am = c == 0 ? p_ : am - lam * p_;
        }
        float o[4] = {0.f, 0.f, 0.f, 0.f};
        for (int jj = 0; jj <= qi; ++jj) { const float aj = __shfl(am, jj); const u32x2 vv = *(const u32x2*)(Vb + ((size_t)(2 * h + vh) * SKVP + jj) * DH + d);
            o[0] += aj * bflo(vv.x); o[1] += aj * bfhi(vv.x); o[2] += aj * bflo(vv.y); o[3] += aj * bfhi(vv.y); }
        const float ss = wave_sum((o[0] * o[0] + o[1] * o[1]) + (o[2] * o[2] + o[3] * o[3]));
        const float rs = 0.8f / sqrtf(ss * (1.0f / 256.0f) + EPS);
        *(u32x2*)(ATTO + (size_t)(MX + qi) * DM + h * 256 + 4 * lane) = (u32x2){pk2(o[0] * rs * sgv.x, o[1] * rs * sgv.y), pk2(o[2] * rs * sgv.z, o[3] * rs * sgv.w)};
    }
    for (int m = MX + NMETA + gw; m < MP; m += NGW) zero_row(ATTO + (size_t)m * DM, nullptr, lane);
}

__device__ __forceinline__ f32x2 cpowf2(float dar, float dai, int tau) { const float m = expf((float)tau * dar), a = (float)tau * dai; return (f32x2){m * cosf(a), m * sinf(a)}; }
template <int CTRL, bool BC> __device__ __forceinline__ float dppf(float x) { return __builtin_bit_cast(float, __builtin_amdgcn_update_dpp(0, __builtin_bit_cast(int, x), CTRL, 0xF, 0xF, BC)); }
__device__ __forceinline__ f32x4 cmul_add2(f32x4 w, f32x4 v, f32x4 acc) {
    acc.x += w.x * v.x - w.y * v.y; acc.y += w.x * v.y + w.y * v.x; acc.z += w.z * v.z - w.w * v.w; acc.w += w.z * v.w + w.w * v.z; return acc; }
template <int CTRL, bool BC> __device__ __forceinline__ f32x4 dpp4(f32x4 v) { return (f32x4){dppf<CTRL, BC>(v.x), dppf<CTRL, BC>(v.y), dppf<CTRL, BC>(v.z), dppf<CTRL, BC>(v.w)}; }

__device__ __forceinline__ void s5_load_u(bf16x8 (&uf)[8], const bf16* rowbase  , int fq) {
#pragma unroll
    for (int kt = 0; kt < 8; ++kt) uf[kt] = *(const bf16x8*)(rowbase + (size_t)(2 * kt + (fq >> 1)) * DM + 8 * (fq & 1));
}
__device__ __forceinline__ void s5_bmat(f32x4 (&Lc)[8], const bf16x8 (&uf)[8], LAS unsigned char* bfr  ) {
#pragma unroll
    for (int mt = 0; mt < 8; ++mt) Lc[mt] = (f32x4){0.f, 0.f, 0.f, 0.f};
#pragma unroll
    for (int ks = 0; ks < 8; ++ks) { asm volatile("" ::: "memory");
#pragma unroll
        for (int mt = 0; mt < 8; ++mt) Lc[mt] = __builtin_amdgcn_mfma_f32_16x16x32_bf16(*(const LAS bf16x8*)(bfr + (mt * 8 + ks) * 1024), uf[ks], Lc[mt], 0, 0, 0); }
}
__device__ __forceinline__ void s5_scan(f32x4 (&Lc)[8], const LAS f32x4* wp  ) {
    asm volatile("" ::: "memory");
#pragma unroll
    for (int mt = 0; mt < 8; ++mt) { Lc[mt] = cmul_add2(wp[0 * 32 + mt * 4], dpp4<0x111, true>(Lc[mt]), Lc[mt]); }
    asm volatile("" ::: "memory");
#pragma unroll
    for (int mt = 0; mt < 8; ++mt) { Lc[mt] = cmul_add2(wp[1 * 32 + mt * 4], dpp4<0x112, true>(Lc[mt]), Lc[mt]); }
    asm volatile("" ::: "memory");
#pragma unroll
    for (int mt = 0; mt < 8; ++mt) { Lc[mt] = cmul_add2(wp[2 * 32 + mt * 4], dpp4<0x114, true>(Lc[mt]), Lc[mt]); }
    asm volatile("" ::: "memory");
#pragma unroll
    for (int mt = 0; mt < 8; ++mt) { Lc[mt] = cmul_add2(wp[3 * 32 + mt * 4], dpp4<0x118, true>(Lc[mt]), Lc[mt]); }
}

__device__ __forceinline__ void dbg4(float* dbg, int comp0, int fr, f32x4 v, bool dd) { if (dd) { float* p = dbg; asm volatile("" : "+v"(p)); p += comp0 * 16 + fr; p[0] = v.x; p[16] = v.y; p[32] = v.z; p[48] = v.w; } }
template <int DUMP> __device__ __forceinline__ void s5_tile(unsigned char* ws, const bf16* HN, bf16* Z, int b, int tl, int g, int fr, int fq, f32x4 (&carry)[8],
        LAS unsigned char* bfr, LAS unsigned char* cfr, LAS unsigned char* ktb, const LAS f32x4* wp, const LAS f32x4* cpw, const LAS f32x4* a256) {
                bf16x8 uf[8]; f32x4 Lc[8];
                const size_t row0 = (size_t)b * SEQ + (size_t)(16 * tl + fr) * 16;
                s5_load_u(uf, HN + row0 * DM + g * SGS, fq); s5_bmat(Lc, uf, bfr);
#if defined(CHK) && CHK
                float* dbg = (float*)(ws + WS_END + 8 * MiB); constexpr int dm = DUMP; const bool dd = (g == 37 && b == 0 && tl == 5);
                if constexpr ((dm & 1) != 0) {
_Pragma("unroll") for (int mt = 0; mt < 8; ++mt) dbg4(dbg, 0 * 128 + 16 * mt + 4 * fq, fr, Lc[mt], dd); }
#endif
                s5_scan(Lc, wp);
#if defined(CHK) && CHK
                if constexpr ((dm & 2) != 0) {
_Pragma("unroll") for (int mt = 0; mt < 8; ++mt) { dbg4(dbg, 1 * 128 + 16 * mt + 4 * fq, fr, Lc[mt], dd); dbg4(dbg, 3 * 128 + 16 * mt + 4 * fq, fr, carry[mt], dd); } }
#endif
                bf16x8 sf[4]; asm volatile("" ::: "memory");
#pragma unroll
                for (int ks = 0; ks < 4; ++ks) { f32x4 s0 = cmul_add2(cpw[(2 * ks) * 4], carry[2 * ks], dpp4<0x111, true>(Lc[2 * ks])), s1 = cmul_add2(cpw[(2 * ks + 1) * 4], carry[2 * ks + 1], dpp4<0x111, true>(Lc[2 * ks + 1]));
                    const u32x4 w = (u32x4){pk2(s0.x, s0.y), pk2(s0.z, s0.w), pk2(s1.x, s1.y), pk2(s1.z, s1.w)}; sf[ks] = __builtin_bit_cast(bf16x8, w);
#if defined(CHK) && CHK
                    if constexpr ((dm & 4) != 0) {
#if CHK_ALT == 1
                        const f32x4 d0 = dpp4<0x111, true>(Lc[2 * ks]), d1 = dpp4<0x111, true>(Lc[2 * ks + 1]);
#elif CHK_ALT == 2
                        const f32x4 d0 = s0 - dpp4<0x111, true>(Lc[2 * ks]), d1 = s1 - dpp4<0x111, true>(Lc[2 * ks + 1]);
#elif CHK_ALT == 3
                        const f32x4 d0 = carry[2 * ks], d1 = carry[2 * ks + 1];
#else
                        const f32x4 d0 = s0, d1 = s1;
#endif
                        dbg4(dbg, 2 * 128 + 16 * (2 * ks) + 4 * fq, fr, d0, dd); dbg4(dbg, 2 * 128 + 16 * (2 * ks + 1) + 4 * fq, fr, d1, dd); }
#endif
                }
                asm volatile("" ::: "memory");
#pragma unroll
                for (int mt = 0; mt < 8; ++mt) carry[mt] = cmul_add2(a256[mt * 4], carry[mt], dpp4<0x15F, false>(Lc[mt]));
                bf16* zrow = Z + row0 * DM + g * SGS + 4 * fq;
#pragma unroll
                for (int hf = 0; hf < 2; ++hf) {
                    f32x4 Y[8];
#pragma unroll
                    for (int m8 = 0; m8 < 8; ++m8) Y[m8] = (f32x4){0.f, 0.f, 0.f, 0.f};
#pragma unroll
                    for (int ks = 0; ks < 4; ++ks) { asm volatile("" ::: "memory");
#pragma unroll
                        for (int m8 = 0; m8 < 8; ++m8) Y[m8] = __builtin_amdgcn_mfma_f32_16x16x32_bf16(*(const LAS bf16x8*)(cfr + ((8 * hf + m8) * 4 + ks) * 1024), sf[ks], Y[m8], 0, 0, 0); }
#if defined(CHK) && CHK
                    if constexpr ((dm & 8) != 0) {
_Pragma("unroll") for (int m8 = 0; m8 < 8; ++m8) dbg4(dbg, 4 * 128 + 16 * (8 * hf + m8) + 4 * fq, fr, Y[m8], dd); }
#endif
#pragma unroll
                    for (int kt = 0; kt < 4 * hf + 4; ++kt) { asm volatile("" ::: "memory");
#pragma unroll
                        for (int m8 = 0; m8 < 8; ++m8) { const int mt = 8 * hf + m8; if (mt < 2 * kt) continue;
                            bf16x8 a = *(const LAS bf16x8*)(ktb + (mt - 2 * kt) * 512);
                            if (mt == 2 * kt && fq >= 2) a = (bf16x8){0, 0, 0, 0, 0, 0, 0, 0};
                            Y[m8] = __builtin_amdgcn_mfma_f32_16x16x32_bf16(a, uf[kt], Y[m8], 0, 0, 0); } }
#if defined(CHK) && CHK
                    if constexpr ((dm & 16) != 0) {
_Pragma("unroll") for (int m8 = 0; m8 < 8; ++m8) dbg4(dbg, 6 * 128 + 16 * (8 * hf + m8) + 4 * fq, fr, Y[m8], dd); }
#endif
#pragma unroll
                    for (int m8 = 0; m8 < 8; ++m8) { float o[4];
#pragma unroll
                        for (int i = 0; i < 4; ++i) { const float y = Y[m8][i]; o[i] = y * __builtin_amdgcn_rcpf(1.0f + __builtin_amdgcn_exp2f(-2.3022082f * (y + 0.044715f * y * y * y))); }
                        *(u32x2*)(zrow + (size_t)(8 * hf + m8) * DM) = (u32x2){pk2(o[0], o[1]), pk2(o[2], o[3])}; }
                }
}
template <int DMASK> __device__ __forceinline__ void s5_phase(const Ptrs& P, LAS unsigned char* lds, int vcu, int G, int tid, bool tables_only = false) {
    const int wave = __builtin_amdgcn_readfirstlane(tid >> 6), lane = tid & 63, fr = lane & 15, fq = lane >> 4;
    const bf16* HN = (const bf16*)(P.ws + WS_HN); bf16* Z = (bf16*)(P.ws + WS_ATTO);
    for (int g = vcu; g < SG; g += G) {
        __syncthreads();
        const float dt = expf(P.log_dt[g]);
        LAS f32x2* Apow = (LAS f32x2*)(lds + S5_F);
        LAS f32x2* Bbar = (LAS f32x2*)(lds + S5_CFRAG);
        for (int e = tid; e < 17 * 64; e += 512) { const int tau = e >> 6, p = e & 63; Apow[e] = cpowf2(dt * P.a_re[g * SP + p], dt * P.a_im[g * SP + p], tau); }
        for (int e = tid; e < SP * SGS; e += 512) { const int p = e >> 4;
            const float ar = P.a_re[g * SP + p], ai = P.a_im[g * SP + p]; const f32x2 ab_ = cpowf2(dt * ar, dt * ai, 1);
            const float nr = ab_.x - 1.0f, ni = ab_.y, den = ar * ar + ai * ai, fre = (nr * ar + ni * ai) / den, fim = (ni * ar - nr * ai) / den;
            const float br = P.b_re[(size_t)g * SP * SGS + e], bi = P.b_im[(size_t)g * SP * SGS + e];
            Bbar[e] = (f32x2){fre * br - fim * bi, fre * bi + fim * br}; }
        __syncthreads();
        for (int f = tid; f < 4096; f += 512) {
            const int l2 = f & 63, ks = (f >> 6) & 7, mt = f >> 9, comp = 16 * mt + (l2 & 15), p = comp >> 1, ri = comp & 1; float v[8];
#pragma unroll
            for (int j = 0; j < 8; ++j) { const int k = 32 * ks + 8 * (l2 >> 4) + j, s = k >> 4, hh = k & 15; const f32x2 pw = Apow[(15 - s) * 64 + p], bb = Bbar[p * 16 + hh];
                v[j] = ri ? (pw.x * bb.y + pw.y * bb.x) : (pw.x * bb.x - pw.y * bb.y); }
            *(LAS u32x4*)(lds + S5_BFRAG + f * 16) = (u32x4){pk2(v[0], v[1]), pk2(v[2], v[3]), pk2(v[4], v[5]), pk2(v[6], v[7])}; }
        for (int e = tid; e < 4096; e += 512) {
            const int hp = e & 15, h = (e >> 4) & 15, tau = e >> 8; float acc = 0.f;
            const float* cr = P.c_re + ((size_t)g * SGS + h) * SP; const float* ci = P.c_im + ((size_t)g * SGS + h) * SP;
            for (int p = 0; p < SP; ++p) { const f32x2 pw = Apow[tau * 64 + p], bb = Bbar[p * 16 + hp]; const float wr_ = pw.x * bb.x - pw.y * bb.y, wi_ = pw.x * bb.y + pw.y * bb.x; acc += cr[p] * wr_ - ci[p] * wi_; }
            if (tau == 0 && h == hp) acc += P.dsk[g * SGS + h];
            ((LAS bf16*)(lds + S5_KTAB))[e] = (bf16)(pk2(acc, 0.f) & 0xffffu); }
        for (int e = tid; e < 16 * 64 + 4 * 64 + 64 + 64; e += 512) {
            int tau, off; const int p = e & 63;
            if (e < 1024) { tau = 16 * (e >> 6); off = S5_CPOW + e * 8; } else if (e < 1280) { tau = 16 << ((e - 1024) >> 6); off = S5_WPOW + (e - 1024) * 8; }
            else if (e < 1344) { tau = 256; off = S5_A256 + p * 8; } else { tau = 1024; off = S5_A1024 + p * 8; }
            *(LAS f32x2*)(lds + off) = cpowf2(dt * P.a_re[g * SP + p], dt * P.a_im[g * SP + p], tau); }
        __syncthreads();
        for (int f = tid; f < 4096; f += 512) {
            const int l2 = f & 63, ks = (f >> 6) & 3, mt = f >> 8, h = l2 & 15; float v[8];
            const float* cr = P.c_re + ((size_t)g * SGS + h) * SP; const float* ci = P.c_im + ((size_t)g * SGS + h) * SP;
#pragma unroll
            for (int j = 0; j < 8; ++j) { const int comp = 16 * (2 * ks + (j >> 2)) + 4 * (l2 >> 4) + (j & 3), p = comp >> 1, ri = comp & 1; const f32x2 pw = Apow[(mt + 1) * 64 + p];
                v[j] = ri ? (-cr[p] * pw.y - ci[p] * pw.x) : (cr[p] * pw.x - ci[p] * pw.y); }
            *(LAS u32x4*)(lds + S5_CFRAG + f * 16) = (u32x4){pk2(v[0], v[1]), pk2(v[2], v[3]), pk2(v[4], v[5]), pk2(v[6], v[7])}; }
        __syncthreads();
        if (tables_only) continue;
        LAS unsigned char* bfr = lds + S5_BFRAG + lane * 16; LAS unsigned char* cfr = lds + S5_CFRAG + lane * 16;
        LAS unsigned char* ktb = lds + S5_KTAB + ((fr * 16 + 8 * (fq & 1)) * 2) - (fq >> 1) * 512;
        const LAS f32x4* wp = (const LAS f32x4*)(lds + S5_WPOW) + fq;
        const LAS f32x4* cpw = (const LAS f32x4*)(lds + S5_CPOW) + fr * 32 + fq;
        const LAS f32x4* a256 = (const LAS f32x4*)(lds + S5_A256) + fq; const LAS f32x4* a1024 = (const LAS f32x4*)(lds + S5_A1024) + fq;
        LAS f32x4* Fw = (LAS f32x4*)(lds + S5_F); LAS f32x4* Em = (LAS f32x4*)(lds + S5_EMETA);
        bf16x8 uf[8]; f32x4 Lc[8];
        if (wave == 0) {
            s5_load_u(uf, HN + (size_t)MX * DM + g * SGS, fq); s5_bmat(Lc, uf, bfr);
            if (fr == 0) {
#pragma unroll
                for (int mt = 0; mt < 8; ++mt) Em[mt * 4 + fq] = Lc[mt]; }
        }
#pragma unroll 1
        for (int b = 0; b < NB; ++b) {
            f32x4 seg[8];
#pragma unroll
            for (int mt = 0; mt < 8; ++mt) seg[mt] = (f32x4){0.f, 0.f, 0.f, 0.f};
#pragma unroll 1
            for (int tl = 4 * wave; tl < 4 * wave + 4; ++tl) {
                s5_load_u(uf, HN + ((size_t)b * SEQ + (size_t)(16 * tl + fr) * 16) * DM + g * SGS, fq); s5_bmat(Lc, uf, bfr); s5_scan(Lc, wp);
                asm volatile("" ::: "memory");
#pragma unroll
                for (int mt = 0; mt < 8; ++mt) seg[mt] = cmul_add2(a256[mt * 4], seg[mt], dpp4<0x15F, false>(Lc[mt]));
            }
            if (fr == 0) {
#pragma unroll
                for (int mt = 0; mt < 8; ++mt) Fw[(b * 8 + wave) * 32 + mt * 4 + fq] = seg[mt]; }
            __syncthreads();
            f32x4 carry[8];
#pragma unroll
            for (int mt = 0; mt < 8; ++mt) carry[mt] = Em[mt * 4 + fq];
            for (int w2 = 0; w2 < wave; ++w2) {
#pragma unroll
                for (int mt = 0; mt < 8; ++mt) carry[mt] = cmul_add2(a1024[mt * 4], carry[mt], Fw[(b * 8 + w2) * 32 + mt * 4 + fq]); }
#pragma unroll 1
            for (int tl = 4 * wave; tl < 4 * wave + 4; ++tl) {
                                s5_tile<DMASK>(P.ws, HN, Z, b, tl, g, fr, fq, carry, bfr, cfr, ktb, wp, cpw, a256);
            }
        }
    }
}

#ifndef PH_ALL
#define PH_ALL 1
#endif
#ifndef PH_P0
#define PH_P0 PH_ALL
#endif
#ifndef PH_QKV
#define PH_QKV PH_ALL
#endif
#ifndef PH_ROPE
#define PH_ROPE PH_ALL
#endif
#ifndef PH_ATTN
#define PH_ATTN PH_ALL
#endif
#ifndef PH_COMB
#define PH_COMB PH_ALL
#endif
#ifndef PH_WO
#define PH_WO PH_ALL
#endif
#ifndef PH_NORM
#define PH_NORM PH_ALL
#endif
#ifndef PH_UP
#define PH_UP PH_ALL
#endif
#ifndef PH_DN
#define PH_DN PH_ALL
#endif
#ifndef PH_S5
#define PH_S5 PH_ALL
#endif
#ifndef PH_GLU
#define PH_GLU PH_ALL
#endif
struct Args { const float* in[22]; float* out; unsigned char* ws; int ph_lo, ph_hi; };
__device__ __forceinline__ Ptrs load_ptrs() {
    const __attribute__((address_space(4))) Args* ap = (const __attribute__((address_space(4))) Args*)__builtin_amdgcn_kernarg_segment_ptr();
    asm volatile("" : "+s"(ap));
    Ptrs P;
    P.x = ap->in[0]; P.meta = ap->in[1]; P.g_mix = ap->in[2]; P.g_mlp = ap->in[3]; P.wqkv = ap->in[4]; P.qg = ap->in[5]; P.kg = ap->in[6]; P.lamv = ap->in[7]; P.sg = ap->in[8]; P.wo = ap->in[9];
    P.a_re = ap->in[10]; P.a_im = ap->in[11]; P.log_dt = ap->in[12]; P.b_re = ap->in[13]; P.b_im = ap->in[14]; P.c_re = ap->in[15]; P.c_im = ap->in[16]; P.dsk = ap->in[17]; P.wglu = ap->in[18]; P.bglu = ap->in[19];
    P.wup = ap->in[20]; P.wdn = ap->in[21]; P.out = ap->out; P.ws = ap->ws;
    return P;
}
#if defined(HV_DEBUG)
#define HV_DBG(ok) do { if (!(ok) && blockIdx.x == 0 && threadIdx.x == 0) { const unsigned long long t0_ = __builtin_amdgcn_s_memrealtime(); while (__builtin_amdgcn_s_memrealtime() - t0_ < 20000ull) __builtin_amdgcn_s_sleep(8); } } while (0)
#else
#define HV_DBG(ok) do {} while (0)
#endif
#define PHASE_VARS() const Ptrs P = load_ptrs(); int tid = tid_fresh(); const int lane = tid & 63, wave = __builtin_amdgcn_readfirstlane(tid >> 6); \
    const int G = gridDim.x, bx = blockIdx.x, vcu = (G % 8 == 0) ? (bx % 8) * (G / 8) + bx / 8 : bx; const int gw = vcu * 8 + wave, NGW = G * 8; (void)lane; (void)gw; (void)NGW; (void)vcu; \
    int hvcu = vcu; { const volatile LAS unsigned* M_ = (const volatile LAS unsigned*)(lds + MISC_OFF); bool ok_ = (G == 256); const unsigned* xr_ = (const unsigned*)(P.ws + WS_CTL) + CW_XRANK; \
      for (int j_ = 0; j_ < 8; ++j_) ok_ = ok_ && (__hip_atomic_load(xr_ + 64 * j_, __ATOMIC_RELAXED, __HIP_MEMORY_SCOPE_AGENT) == 32u); if (ok_) hvcu = (int)(M_[16] * 32u + M_[17]); hvcu = __builtin_amdgcn_readfirstlane(hvcu); HV_DBG(ok_); } (void)hvcu; const int hbx = (G == 256) ? (hvcu & 31) * 8 + (hvcu >> 5) : bx; (void)hbx; \
    bf16* H = (bf16*)(P.ws + WS_H); bf16* HN = (bf16*)(P.ws + WS_HN); bf16* ATTO = (bf16*)(P.ws + WS_ATTO); bf16* MID = (bf16*)(P.ws + WS_MID); \
    bf16* Qb = (bf16*)(P.ws + WS_Q); bf16* Kb = (bf16*)(P.ws + WS_K); bf16* Vb = (bf16*)(P.ws + WS_V); bf16* Ob = (bf16*)(P.ws + WS_O); \
    const bf16* Wqkv_t = (const bf16*)(P.ws + WS_WQKV); const bf16* Wo_t = (const bf16*)(P.ws + WS_WO); const bf16* Wglu_t = (const bf16*)(P.ws + WS_WGLU); \
    const bf16* Wup_t = (const bf16*)(P.ws + WS_WUP); const bf16* Wdn_t = (const bf16*)(P.ws + WS_WDN); \
    (void)H; (void)HN; (void)ATTO; (void)MID; (void)Qb; (void)Kb; (void)Vb; (void)Ob; (void)Wqkv_t; (void)Wo_t; (void)Wglu_t; (void)Wup_t; (void)Wdn_t;

__global__ void __launch_bounds__(512, 2) fwd_kernel(Args args) {
    extern __shared__ __attribute__((aligned(16))) unsigned char lds_raw[];
    LAS unsigned char* lds = (LAS unsigned char*)lds_raw;
    (void)args;
    int ph_lo_, ph_hi_; { const __attribute__((address_space(4))) Args* ap = (const __attribute__((address_space(4))) Args*)__builtin_amdgcn_kernarg_segment_ptr(); ph_lo_ = ap->ph_lo; ph_hi_ = ap->ph_hi; }
#define RUN(k) (ph_lo_ <= (k) && (k) < ph_hi_)
#if defined(PROBE_W)
#define STAMP(k) do { if (blockIdx.x == 0 && threadIdx.x == 0) { const Ptrs Ps = load_ptrs(); ((volatile unsigned long long*)(Ps.ws + WS_CTL + 65536))[k] = __builtin_amdgcn_s_memrealtime(); } } while (0)
#else
#define STAMP(k) do {} while (0)
#endif
    STAMP(0);
    XcdBarrier bar;
    { PHASE_VARS();
      volatile LAS unsigned* MISC = (volatile LAS unsigned*)(lds + MISC_OFF);
      if (tid < 32) MISC[tid] = 0u;
      __syncthreads();
      bar = xcd_barrier_post((unsigned*)(P.ws + WS_CTL) + CW_BAR, MISC + 8);
      if (tid == 0) { const unsigned xcc = xb_xcc_id() & 7u; MISC[16] = xcc; MISC[17] = __hip_atomic_fetch_add((unsigned*)(P.ws + WS_CTL) + CW_XRANK + 64 * xcc, 1u, __ATOMIC_RELAXED, __HIP_MEMORY_SCOPE_AGENT); }
      __syncthreads(); }

#if PH_P0
    if (RUN(0)) {
    { PHASE_VARS(); p0_prologue(P, lds, gw, NGW, wave, lane); }
    }
#endif
    if (RUN(0) && RUN(1)) xcd_barrier(bar);
    STAMP(1);
#if PH_QKV
    if (RUN(1)) {
    { PHASE_VARS(); pg8::Gemm g{HN, Wqkv_t, MX, 3 * DM, DM}; pg8::StaticOrder S; S.init(MX, 3 * DM, G, hbx); pg8::EpiQKV E{Qb, QKV_T_BYTES / 2};
      pg8::gemm_phase<pg8::EpiQKV, pg8::StaticOrder, true, GEMM_SP2>(lds, g, S, E);
      skinny16(lds, HN + (size_t)MX * DM, Wqkv_t, DM, 3 * DM, 1, vcu, G, tid, SkQKV{Qb}); }
    }
#endif
    if (RUN(1) && RUN(2)) xcd_barrier(bar);
    STAMP(2);
#if PH_ROPE
    if (RUN(2)) {
    { PHASE_VARS(); qk_rope_phase(Qb, Kb, P.qg, P.kg, gw, NGW, lane); }
    }
#endif
    if (RUN(2) && RUN(3)) xcd_barrier(bar);
    STAMP(3);
#if PH_ATTN
    if (RUN(3)) {
    { PHASE_VARS();
      ab::da_phase((char*)lds_raw, Qb, Kb, Vb, Ob, hvcu, G, SKVP, SEQ, NMETA); }
    }
#endif
    if (RUN(3) && RUN(4)) xcd_barrier(bar);
    STAMP(4);
#if PH_COMB
    if (RUN(4)) {
    { PHASE_VARS();
#if defined(DA_TESTRUN)
      ab::da_phase((char*)lds_raw, Qb, Kb, Vb, Ob, hvcu, G, SKVP, SEQ, NMETA, DA_TESTRUN); __syncthreads();
#endif
      combine_phase(P, gw, NGW, lane); }
    }
#endif
    if (RUN(4) && RUN(5)) xcd_barrier(bar);
    STAMP(5);
#if PH_WO
    if (RUN(5)) {
    { PHASE_VARS(); pg8::Gemm g{ATTO, Wo_t, MX, DM, DM}; pg8::StaticOrder S; S.init(MX, DM, G, hbx); pg8::EpiRes<true, false, true> E{P.x, H, (float*)(P.ws + WS_PART)};
      pg8::gemm_phase<pg8::EpiRes<true, false, true>, pg8::StaticOrder, true, GEMM_SP2>(lds, g, S, E);
      skinny16(lds, ATTO + (size_t)MX * DM, Wo_t, DM, DM, 1, vcu, G, tid, SkRes{H}); }
    }
#endif
    if (RUN(5) && RUN(6)) xcd_barrier(bar);
    STAMP(6);
#if PH_NORM
    if (RUN(6)) {
    { PHASE_VARS(); rstd_phase((const float*)(P.ws + WS_PART), 64, (float*)(P.ws + WS_RSTD), H, true, gw, NGW, lane); }
    }
#endif
    if (RUN(6) && RUN(7)) xcd_barrier(bar);
    STAMP(7);
#if PH_UP
    if (RUN(7)) {
    { PHASE_VARS(); pg8::Gemm g{H, Wup_t, MX, FF, DM}; pg8::StaticOrder S; S.init(MX, FF, G, hbx); pg8::EpiRelu2 E{MID, FF, (const float*)(P.ws + WS_RSTD)};
      pg8::gemm_phase<pg8::EpiRelu2, pg8::StaticOrder, true, GEMM_SP2>(lds, g, S, E);
      skinny16(lds, H + (size_t)MX * DM, Wup_t, DM, FF, 1, vcu, G, tid, SkRelu2{MID, (const float*)(P.ws + WS_RSTD)}); }
    }
#endif
    if (RUN(7) && RUN(8)) xcd_barrier(bar);
    STAMP(8);
#if PH_DN
    if (RUN(8)) {
    { PHASE_VARS(); pg8::Gemm g{MID, Wdn_t, MX, DM, FF}; pg8::StaticOrder S; S.init(MX, DM, G, hbx); pg8::EpiRes<false, false> E{H, H, nullptr};
      pg8::gemm_phase<pg8::EpiRes<false, false>, pg8::StaticOrder, true, GEMM_SP2>(lds, g, S, E);
      skinny16(lds, MID + (size_t)MX * FF, Wdn_t, FF, DM, 4, vcu, G, tid, SkPart{(float*)(P.ws + WS_MPART)}); }
    }
#endif
    if (RUN(8) && RUN(9)) xcd_barrier(bar);
    STAMP(9);
#if PH_NORM
    if (RUN(9)) {
    { PHASE_VARS();
      if (gw < NMETA) {
          bf16* hr = H + (size_t)(MX + gw) * DM; const float* pp = (const float*)(P.ws + WS_MPART) + (size_t)gw * DM;
#pragma unroll 4
          for (int j = 0; j < 16; ++j) { const int o = 4 * (lane + 64 * j); const u32x2 w = *(const u32x2*)(hr + o); f32x4 v = (f32x4){bflo(w.x), bfhi(w.x), bflo(w.y), bfhi(w.y)};
              v += *(const f32x4*)(pp + o); v += *(const f32x4*)(pp + (size_t)NMETA * DM + o); v += *(const f32x4*)(pp + (size_t)2 * NMETA * DM + o); v += *(const f32x4*)(pp + (size_t)3 * NMETA * DM + o);
              *(u32x2*)(hr + o) = (u32x2){pk2(v.x, v.y), pk2(v.z, v.w)}; }
          asm volatile("s_waitcnt vmcnt(0)" ::: "memory"); }
      norm_phase(H, P.g_mix + DM, HN, MX + NMETA, gw, NGW, lane); }
    }
#endif
    if (RUN(9) && RUN(10)) xcd_barrier(bar);
    STAMP(10);
#if PH_S5
    if (RUN(10)) {
    { PHASE_VARS();
#if defined(S5_TESTRUN)
      s5_phase<0>(P, lds, vcu, G, tid, true); __syncthreads();
#endif
      s5_phase<0>(P, lds, vcu, G, tid); }
    }
#endif
    if (RUN(10) && RUN(11)) xcd_barrier(bar);
    STAMP(11);
#if PH_GLU
    if (RUN(11)) {
    { PHASE_VARS(); pg8::Gemm g{ATTO, Wglu_t, MX, 2 * DM, DM}; pg8::StaticOrder S; S.init(MX, 2 * DM, G, hbx); pg8::EpiGlu E{H, P.bglu, (float*)(P.ws + WS_PART)};
      pg8::gemm_phase<pg8::EpiGlu, pg8::StaticOrder, true, GEMM_SP2>(lds, g, S, E); }
    }
#endif
    if (RUN(11) && RUN(12)) xcd_barrier(bar);
    STAMP(12);
#if PH_NORM
    if (RUN(12)) {
    { PHASE_VARS(); rstd_phase((const float*)(P.ws + WS_PART), 128, (float*)(P.ws + WS_RSTD), H, false, gw, NGW, lane); }
    }
#endif
    if (RUN(12) && RUN(13)) xcd_barrier(bar);
    STAMP(13);
#if PH_UP
    if (RUN(13)) {
    { PHASE_VARS(); pg8::Gemm g{H, Wup_t + (size_t)DM * FF, MX, FF, DM}; pg8::StaticOrder S; S.init(MX, FF, G, hbx); pg8::EpiRelu2 E{MID, FF, (const float*)(P.ws + WS_RSTD)};
      pg8::gemm_phase<pg8::EpiRelu2, pg8::StaticOrder, true, GEMM_SP2>(lds, g, S, E); }
    }
#endif
    if (RUN(13) && RUN(14)) xcd_barrier(bar);
    STAMP(14);
#if PH_DN
    if (RUN(14)) {
    { PHASE_VARS(); pg8::Gemm g{MID, Wdn_t + (size_t)DM * FF, MX, DM, FF}; pg8::StaticOrder S; S.init(MX, DM, G, hbx); pg8::EpiRes<false, true> E{H, P.out, nullptr};
      pg8::gemm_phase<pg8::EpiRes<false, true>, pg8::StaticOrder, true, GEMM_SP2>(lds, g, S, E); }
    }
#endif
#if defined(PROBE_W)
    STAMP(15);
    if (blockIdx.x == 0 && threadIdx.x == 0) { const Ptrs Ps = load_ptrs(); volatile unsigned long long* st = (volatile unsigned long long*)(Ps.ws + WS_CTL + 65536); const int w[15] = PROBE_W; unsigned long long dur = 0;
#pragma unroll
        for (int k = 0; k < 15; ++k) dur += (unsigned long long)w[k] * (st[k + 1] - st[k]);
        const unsigned long long t0 = __builtin_amdgcn_s_memrealtime(); while (__builtin_amdgcn_s_memrealtime() - t0 < dur) __builtin_amdgcn_s_sleep(8); }
#endif
}

#undef STAMP
#undef RUN
#if defined(CHK) && CHK && defined(CHK_DUMP)
__global__ void __launch_bounds__(512, 2) s5_dbg_kernel(Args args) {
    extern __shared__ __attribute__((aligned(16))) unsigned char lds_raw[];
    LAS unsigned char* lds = (LAS unsigned char*)lds_raw; (void)args;
    PHASE_VARS(); s5_phase<CHK_DUMP>(P, lds, vcu, G, tid);
}
#endif
extern "C" void kernel_launch(void* const* d_in, const int* in_sizes, int n_in, void* d_out, int out_size, void* d_ws, size_t ws_size, hipStream_t stream) {
    static int grid = 0;
    if (grid == 0) {
        if (n_in != 22 || in_sizes[0] != MX * DM || out_size != MX * DM || ws_size < WS_END + 16 * MiB) {
            fprintf(stderr, "kernel_launch: built for 22 inputs, x/out of %d floats, >= %zu bytes of workspace; got n_in %d, in0 %d, out %d, ws %zu; nothing launched\n", MX * DM, (size_t)WS_END, n_in, n_in > 0 ? in_sizes[0] : -1, out_size, ws_size); grid = -1; return; }
        int dev = 0, cus = 0, per_cu = 0;
        if (hipGetDevice(&dev) != hipSuccess || hipDeviceGetAttribute(&cus, hipDeviceAttributeMultiprocessorCount, dev) != hipSuccess) { fprintf(stderr, "kernel_launch: device query failed\n"); grid = -1; return; }
        if (hipFuncSetAttribute((const void*)fwd_kernel, hipFuncAttributeMaxDynamicSharedMemorySize, LDS_BYTES) != hipSuccess) { fprintf(stderr, "kernel_launch: hipFuncSetAttribute(%d B LDS) failed\n", LDS_BYTES); grid = -1; return; }
        if (hipOccupancyMaxActiveBlocksPerMultiprocessor(&per_cu, (const void*)fwd_kernel, 512, LDS_BYTES) != hipSuccess || per_cu < 1)
            fprintf(stderr, "kernel_launch: note: occupancy query reports %d workgroups per CU; launching one per CU anyway (%d B LDS)\n", per_cu, LDS_BYTES);
        (void)hipGetLastError();
        grid = cus;
    }
    if (grid < 0) return;
    if (hipMemsetAsync((char*)d_ws + WS_CTL, 0, CTL_ZERO_BYTES, stream) != hipSuccess) { fprintf(stderr, "kernel_launch: memset failed\n"); return; }
    Args a{};
    for (int i = 0; i < 22; ++i) a.in[i] = (const float*)d_in[i];
    a.out = (float*)d_out; a.ws = (unsigned char*)d_ws;
#if defined(CHK) && CHK
    (void)hipMemsetAsync((char*)d_ws + WS_RES, 0, 1024, stream);
    for (int k = 0; k < 15; ++k) {
        if (k == 8 || k == 11) hipLaunchKernelGGL(chk_snap, dim3(64), dim3(256), 0, stream, (const float*)((char*)d_ws + WS_H), (float*)((char*)d_ws + WS_SNAP));
        a.ph_lo = k; a.ph_hi = k + 1;
        hipLaunchKernelGGL(fwd_kernel, dim3(grid), dim3(512), LDS_BYTES, stream, a);
        if (k == 3) hipLaunchKernelGGL(chk_attn, dim3(48), dim3(128), 0, stream, a);
        else if (k == 10) { hipLaunchKernelGGL(chk_s5, dim3(12), dim3(64), 0, stream, a);
#if defined(CHK_DUMP)
            (void)hipFuncSetAttribute((const void*)s5_dbg_kernel, hipFuncAttributeMaxDynamicSharedMemorySize, LDS_BYTES);
            hipLaunchKernelGGL(s5_dbg_kernel, dim3(grid), dim3(512), LDS_BYTES, stream, a);
            hipLaunchKernelGGL(chk_s5_int, dim3(1), dim3(64), 0, stream, a);
#endif
        }
        else hipLaunchKernelGGL(chk_kernel, dim3(64), dim3(64), 0, stream, a, k);
    }
    hipLaunchKernelGGL(chk_report, dim3(1), dim3(1), 0, stream, a);
#else
    a.ph_lo = 0; a.ph_hi = 15;
    hipLaunchKernelGGL(fwd_kernel, dim3(grid), dim3(512), LDS_BYTES, stream, a);
#endif
    const hipError_t le = hipPeekAtLastError();
    if (le != hipSuccess) fprintf(stderr, "kernel_launch: launch failed: %s\n", hipGetErrorName(le));
}
```

```cpp
#include <hip/hip_runtime.h>
#include <cstdio>
#include <cstdint>
__device__ __forceinline__ int tid_fresh() { int t = threadIdx.x; asm volatile("" : "+v"(t)); return t; }
namespace pg8 {
#define PG8_LAS __attribute__((address_space(3)))
typedef unsigned short bf16_t;
typedef short bf16x8 __attribute__((ext_vector_type(8)));
typedef float f32x4 __attribute__((ext_vector_type(4)));
typedef unsigned u32x4 __attribute__((ext_vector_type(4)));
constexpr int BM = 256, BK = 64, HALF = 128, HTB = HALF * BK * 2  , STAGE_BYTES = 8 * HTB, NXCD = 8, WGM = 8;

__host__ __device__ __forceinline__ int lds_byte(int r, int c) { const int st = (r >> 4) * 2 + (c >> 5), rr = r & 15, cc = c & 31, ob = rr * 64 + cc * 2; return st * 1024 + (ob ^ (((ob >> 9) & 1) << 5)); }
__host__ __device__ __forceinline__ void stage_rc(int b, int& R, int& C) { const int st = b / 1024, sb = b % 1024, swz = sb ^ (((sb >> 9) & 1) << 5); R = (st >> 1) * 16 + swz / 64; C = (st & 1) * 32 + (swz % 64) / 2; }
__host__ __device__ __forceinline__ int perm32(int rho) { const int n = rho >> 4, i = rho & 15; return 8 * (i >> 2) + 4 * n + (i & 3); }

struct Unit { int pm, pn; };
struct Gemm { const bf16_t* A; const bf16_t* Bt; int M, N, K; };

struct StaticOrder {
    int nM, nN, nwg, G, c;
    __host__ __device__ void init(int M, int N, int G_, int c_) { nM = M / BM; nN = N / BM; nwg = nM * nN; G = G_; c = c_; }
    __host__ __device__ bool next(int i, Unit& u) const {
        const long L = (long)i * G + c; if (L >= nwg) return false;
        int wgid = (int)L; { const int q = nwg / NXCD, r = nwg % NXCD, xcd = wgid % NXCD, off = wgid / NXCD; wgid = (xcd < r ? xcd * (q + 1) : r * (q + 1) + (xcd - r) * q) + off; }
        const int nig = WGM * nN, gid = wgid / nig, fm = gid * WGM, gsz = (nM - fm) < WGM ? (nM - fm) : WGM;
        u.pm = fm + ((wgid % nig) % gsz); u.pn = (wgid % nig) / gsz; return true;
    }
    __device__ __forceinline__ void a_ready(const Unit&) const {}
    __device__ __forceinline__ void done(const Unit&) const {}
};
typedef unsigned u32x2v __attribute__((ext_vector_type(2)));
__device__ __forceinline__ unsigned cvt_pk_bf16(float lo, float hi) { unsigned r; asm volatile("v_cvt_pk_bf16_f32 %0, %1, %2" : "=v"(r) : "v"(lo), "v"(hi)); return r; }
constexpr int E_SKVP = 8256, E_NMETA = 16, E_MXP = 64  ;
struct EpiQKV {
    static constexpr bool PERM = true, AFTER_DRAIN = false;
    bf16_t* Q; size_t sec_stride;
    __device__ __forceinline__ void operator()(const f32x4 (&acc)[2][2][4][2], const Unit& u, int wr, int wc, int fr, int fq) const {
        const int sec = u.pn >> 4; bf16_t* base = Q + (size_t)sec * sec_stride;
        const int hid0 = (u.pn & 15) * 2, d0 = wc * 32 + 8 * fq;
        const bool meta = u.pm >= E_MXP; const int b = meta ? 0 : (u.pm >> 5), pos0 = meta ? 0 : E_NMETA + (u.pm & 31) * 256;
#pragma unroll
        for (int ai = 0; ai < 2; ++ai)
#pragma unroll
            for (int m = 0; m < 4; ++m) { const int r = ai * HALF + wr * 64 + m * 16 + fr;
                if (meta && r >= E_NMETA) continue;
#pragma unroll
                for (int bj = 0; bj < 2; ++bj) { const f32x4 v0 = acc[ai][bj][m][0], v1 = acc[ai][bj][m][1];
                    u32x4 w; w.x = cvt_pk_bf16(v0[0], v0[1]); w.y = cvt_pk_bf16(v0[2], v0[3]); w.z = cvt_pk_bf16(v1[0], v1[1]); w.w = cvt_pk_bf16(v1[2], v1[3]);
                    bf16_t* dst = base + ((size_t)(b * 32 + hid0 + bj) * E_SKVP + pos0 + r) * 128 + d0;
                    *(u32x4*)dst = w;
                    if (meta) *(u32x4*)(dst + (size_t)32 * E_SKVP * 128) = w; } }
    }
};
__device__ __forceinline__ f32x4 bf4_to_f32(u32x2v w) { return (f32x4){__builtin_bit_cast(float, w.x << 16), __builtin_bit_cast(float, w.x & 0xffff0000u), __builtin_bit_cast(float, w.y << 16), __builtin_bit_cast(float, w.y & 0xffff0000u)}; }
template <bool BASE_F32, bool OUT_F32, bool STATS = false> struct EpiRes {
    static constexpr bool PERM = false, AFTER_DRAIN = false;
    const void* base; void* out; float* part;
    __device__ __forceinline__ void operator()(const f32x4 (&acc)[2][2][4][2], const Unit& u, int wr, int wc, int fr, int fq) const {
        const int row0 = u.pm * BM + wr * 64 + fr, col0 = u.pn * BM + wc * 32 + 4 * fq;
#pragma unroll
        for (int ai = 0; ai < 2; ++ai)
#pragma unroll
            for (int m = 0; m < 4; ++m) { const size_t off = (size_t)(row0 + ai * HALF + m * 16) * 4096 + col0; float ssq = 0.f;
#pragma unroll
                for (int bj = 0; bj < 2; ++bj)
#pragma unroll
                    for (int n = 0; n < 2; ++n) { const size_t o2 = off + bj * HALF + n * 16;
                        f32x4 bs; if (BASE_F32) bs = *(const f32x4*)((const float*)base + o2); else bs = bf4_to_f32(*(const u32x2v*)((const bf16_t*)base + o2));
                        const f32x4 r = bs + acc[ai][bj][m][n];
                        if (STATS) ssq += (r[0] * r[0] + r[1] * r[1]) + (r[2] * r[2] + r[3] * r[3]);
                        if (OUT_F32) *(f32x4*)((float*)out + o2) = r; else *(u32x2v*)((bf16_t*)out + o2) = (u32x2v){cvt_pk_bf16(r[0], r[1]), cvt_pk_bf16(r[2], r[3])}; }
                if (STATS) { ssq += __shfl_xor(ssq, 16); ssq += __shfl_xor(ssq, 32); if (fq == 0) part[(size_t)(row0 + ai * HALF + m * 16) * 128 + 4 * u.pn + wc] = ssq; }
                if (m & 1) asm volatile("" ::: "memory"); }
    }
};
struct EpiRelu2 {
    static constexpr bool PERM = true, AFTER_DRAIN = false;
    bf16_t* O; int ldc; const float* rstd;
    __device__ __forceinline__ void operator()(const f32x4 (&acc)[2][2][4][2], const Unit& u, int wr, int wc, int fr, int fq) const {
        const int row0 = u.pm * BM + wr * 64 + fr, col0 = u.pn * BM + wc * 32 + 8 * fq;
#pragma unroll
        for (int ai = 0; ai < 2; ++ai)
#pragma unroll
            for (int m = 0; m < 4; ++m) { bf16_t* rowp = O + (size_t)(row0 + ai * HALF + m * 16) * ldc + col0; float rs2 = 1.0f; if (rstd) { const float rs = rstd[row0 + ai * HALF + m * 16]; rs2 = rs * rs; }
#pragma unroll
                for (int bj = 0; bj < 2; ++bj) { f32x4 v0 = acc[ai][bj][m][0], v1 = acc[ai][bj][m][1];
#pragma unroll
                    for (int j = 0; j < 4; ++j) { const float a = fmaxf(v0[j], 0.f), b = fmaxf(v1[j], 0.f); v0[j] = a * a * rs2; v1[j] = b * b * rs2; }
                    u32x4 w; w.x = cvt_pk_bf16(v0[0], v0[1]); w.y = cvt_pk_bf16(v0[2], v0[3]); w.z = cvt_pk_bf16(v1[0], v1[1]); w.w = cvt_pk_bf16(v1[2], v1[3]);
                    *(u32x4*)(rowp + bj * HALF) = w; } }
    }
};
struct EpiGlu {
    static constexpr bool PERM = false, AFTER_DRAIN = false;
    bf16_t* h; const float* bias; float* part;
    __device__ __forceinline__ void operator()(const f32x4 (&acc)[2][2][4][2], const Unit& u, int wr, int wc, int fr, int fq) const {
        const int row0 = u.pm * BM + wr * 64 + fr, f0 = u.pn * HALF + wc * 32 + 4 * fq;
        f32x4 bv[2], bg[2];
#pragma unroll
        for (int n = 0; n < 2; ++n) { bv[n] = *(const f32x4*)(bias + f0 + n * 16); bg[n] = *(const f32x4*)(bias + 4096 + f0 + n * 16); }
#pragma unroll
        for (int ai = 0; ai < 2; ++ai)
#pragma unroll
            for (int m = 0; m < 4; ++m) { bf16_t* rowp = h + (size_t)(row0 + ai * HALF + m * 16) * 4096 + f0;
                float ssq = 0.f;
#pragma unroll
                for (int n = 0; n < 2; ++n) { const f32x4 val = acc[ai][0][m][n] + bv[n], gt = acc[ai][1][m][n] + bg[n]; f32x4 o = bf4_to_f32(*(const u32x2v*)(rowp + n * 16));
#pragma unroll
                    for (int j = 0; j < 4; ++j) o[j] += val[j] * __builtin_amdgcn_rcpf(1.0f + __builtin_amdgcn_exp2f(-1.4426950408889634f * gt[j]));
                    ssq += (o[0] * o[0] + o[1] * o[1]) + (o[2] * o[2] + o[3] * o[3]);
                    *(u32x2v*)(rowp + n * 16) = (u32x2v){cvt_pk_bf16(o[0], o[1]), cvt_pk_bf16(o[2], o[3])}; }
                ssq += __shfl_xor(ssq, 16); ssq += __shfl_xor(ssq, 32); if (fq == 0) part[(size_t)(row0 + ai * HALF + m * 16) * 128 + 4 * u.pn + wc] = ssq;
                if (m & 1) asm volatile("" ::: "memory"); }
    }
};
template <class Epi, class Sched, bool ALIGN_EPI = false, bool SP2 = false>
__device__ __forceinline__ void gemm_phase(PG8_LAS unsigned char* lds, const Gemm g, const Sched& S, const Epi& E) {
    const int tid = tid_fresh(), wid = __builtin_amdgcn_readfirstlane(tid >> 6), lane = tid & 63, wr = wid >> 2, wc = wid & 3, fr = lane & 15, fq = lane >> 4;
    const int K = g.K, nt = K / BK;
    unsigned voffA[2], voffB[2];
#pragma unroll
    for (int i = 0; i < 2; ++i) { int R, C; stage_rc(tid * 16 + i * 8192, R, C); const int Rb = Epi::PERM ? ((R & ~31) + perm32(R & 31)) : R;
        voffA[i] = (unsigned)(R * K + C) * 2u; voffB[i] = (unsigned)(Rb * K + C) * 2u; }
    const size_t kstep = (size_t)(BK * 2);
    const size_t hstep = (size_t)HALF * K * 2;
    const size_t tstep = 2 * hstep;
    const unsigned ldsw = (unsigned)wid * 1024u;
    const int aoff = lds_byte(wr * 64 + fr, fq * 8), boff = lds_byte(wc * 32 + fr, fq * 8);
#define PG8_SA(b, h) (((b) * 2 + (h)) * HTB)
#define PG8_SB(b, h) ((4 + (b) * 2 + (h)) * HTB)
#define PG8_STAGE(bufoff, gbase, voff) do { _Pragma("unroll") for (int _i = 0; _i < 2; ++_i) \
        __builtin_amdgcn_global_load_lds((const unsigned*)((const char*)(gbase) + (voff)[_i]), (PG8_LAS unsigned*)(lds + (bufoff) + ldsw + _i * 8192), 16, 0, 0); } while (0)
#define PG8_LDA(dst, b, h) do { _Pragma("unroll") for (int m = 0; m < 4; ++m) _Pragma("unroll") for (int k = 0; k < 2; ++k) dst[m][k] = *(const PG8_LAS bf16x8*)(lds + PG8_SA(b, h) + aoff + m * 2048 + k * 1024); } while (0)
#define PG8_LDB(dst, b, h) do { _Pragma("unroll") for (int n = 0; n < 2; ++n) _Pragma("unroll") for (int k = 0; k < 2; ++k) dst[n][k] = *(const PG8_LAS bf16x8*)(lds + PG8_SB(b, h) + boff + n * 2048 + k * 1024); } while (0)
#define PG8_MMA(ai, bj, At, Bt) do { __builtin_amdgcn_s_setprio(1); _Pragma("unroll") for (int m = 0; m < 4; ++m) _Pragma("unroll") for (int n = 0; n < 2; ++n) _Pragma("unroll") for (int k = 0; k < 2; ++k) \
        acc[ai][bj][m][n] = __builtin_amdgcn_mfma_f32_16x16x32_bf16(Bt[n][k], At[m][k], acc[ai][bj][m][n], 0, 0, 0); __builtin_amdgcn_s_setprio(0); } while (0)
#define PG8_WAIT_V(n) asm volatile("s_waitcnt vmcnt(" #n ")" ::: "memory")
#define PG8_WAIT_L(n) asm volatile("s_waitcnt lgkmcnt(" #n ")" ::: "memory")
#define PG8_BAR __builtin_amdgcn_s_barrier()
#define PG8_SCHED __builtin_amdgcn_sched_barrier(0)
    Unit cur, nxt; int ui = 0;
    if (!S.next(0, cur)) return;
    f32x4 acc[2][2][4][2];
#pragma unroll
    for (int a = 0; a < 2; ++a)
#pragma unroll
        for (int b = 0; b < 2; ++b)
#pragma unroll
            for (int m = 0; m < 4; ++m)
#pragma unroll
                for (int n = 0; n < 2; ++n) acc[a][b][m][n] = (f32x4){0.f, 0.f, 0.f, 0.f};
    bf16x8 At[4][2], B0[2][2], B1[2][2];
    const char* cA = (const char*)g.A + (size_t)cur.pm * tstep; const char* cB = (const char*)g.Bt + (size_t)cur.pn * tstep;
    S.a_ready(cur);
    if constexpr (SP2) {
        PG8_STAGE(PG8_SB(0, 0), cB, voffB); PG8_STAGE(PG8_SB(0, 1), cB + hstep, voffB); PG8_STAGE(PG8_SA(0, 0), cA, voffA); PG8_STAGE(PG8_SA(0, 1), cA + hstep, voffA);
        if (wr == 1) PG8_BAR;
        PG8_WAIT_V(2); PG8_BAR;
        PG8_STAGE(PG8_SB(1, 0), cB + kstep, voffB); PG8_STAGE(PG8_SA(1, 0), cA + kstep, voffA); PG8_STAGE(PG8_SB(1, 1), cB + hstep + kstep, voffB);
        PG8_WAIT_V(6); PG8_BAR;
    } else {
        PG8_STAGE(PG8_SB(0, 0), cB, voffB); PG8_STAGE(PG8_SA(0, 0), cA, voffA); PG8_STAGE(PG8_SB(0, 1), cB + hstep, voffB); PG8_STAGE(PG8_SA(0, 1), cA + hstep, voffA);
        if (wr == 1) PG8_BAR;
        PG8_WAIT_V(4); PG8_BAR;
        PG8_STAGE(PG8_SB(1, 0), cB + kstep, voffB); PG8_STAGE(PG8_SA(1, 0), cA + kstep, voffA); PG8_STAGE(PG8_SB(1, 1), cB + hstep + kstep, voffB);
        PG8_WAIT_V(6); PG8_BAR;
    }
    for (;;) {
        const bool has_next = S.next(ui + 1, nxt);
        const char* nA = has_next ? (const char*)g.A + (size_t)nxt.pm * tstep : cA; const char* nB = has_next ? (const char*)g.Bt + (size_t)nxt.pn * tstep : cB;
        for (int t = 0; t < nt; t += 2) {
            const bool last = (t == nt - 2);
            const char* a1 = cA + (size_t)(t + 1) * kstep;
            const char* a2 = last ? nA : cA + (size_t)(t + 2) * kstep; const char* b2 = last ? nB : cB + (size_t)(t + 2) * kstep;
            const char* a3 = a2 + kstep; const char* b3 = b2 + kstep;
            if (last && has_next) S.a_ready(nxt);
            if constexpr (SP2) {
            PG8_LDB(B0, 0, 0); PG8_LDB(B1, 0, 1); PG8_SCHED; PG8_LDA(At, 0, 0); PG8_STAGE(PG8_SA(1, 1), a1 + hstep, voffA);
            PG8_WAIT_V(8); PG8_WAIT_L(0); PG8_BAR; PG8_MMA(0, 0, At, B0); PG8_MMA(0, 1, At, B1); PG8_BAR; PG8_SCHED;
            PG8_LDA(At, 0, 1); PG8_STAGE(PG8_SB(0, 0), b2, voffB); PG8_STAGE(PG8_SB(0, 1), b2 + hstep, voffB); PG8_STAGE(PG8_SA(0, 0), a2, voffA);
            PG8_WAIT_V(8); PG8_WAIT_L(0); PG8_BAR; PG8_MMA(1, 0, At, B0); PG8_MMA(1, 1, At, B1); PG8_BAR; PG8_SCHED;
            PG8_LDB(B0, 1, 0); PG8_LDB(B1, 1, 1); PG8_SCHED; PG8_LDA(At, 1, 0); PG8_STAGE(PG8_SA(0, 1), a2 + hstep, voffA);
            PG8_WAIT_V(8); PG8_WAIT_L(0); PG8_BAR; PG8_MMA(0, 0, At, B0); PG8_MMA(0, 1, At, B1); PG8_BAR; PG8_SCHED;
            PG8_LDA(At, 1, 1); PG8_STAGE(PG8_SB(1, 0), b3, voffB); PG8_STAGE(PG8_SB(1, 1), b3 + hstep, voffB); PG8_STAGE(PG8_SA(1, 0), a3, voffA);
            PG8_WAIT_V(8); PG8_WAIT_L(0); PG8_BAR; PG8_MMA(1, 0, At, B0); PG8_MMA(1, 1, At, B1); PG8_BAR; PG8_SCHED;
            } else {
            PG8_LDB(B0, 0, 0); PG8_SCHED; PG8_LDA(At, 0, 0); PG8_STAGE(PG8_SA(1, 1), a1 + hstep, voffA);
            PG8_WAIT_L(8); PG8_BAR; PG8_WAIT_L(0); PG8_MMA(0, 0, At, B0); PG8_BAR; PG8_SCHED;
            PG8_LDB(B1, 0, 1); PG8_STAGE(PG8_SB(0, 0), b2, voffB);
            PG8_BAR; PG8_WAIT_L(0); PG8_MMA(0, 1, At, B1); PG8_BAR;
            PG8_LDA(At, 0, 1); PG8_STAGE(PG8_SA(0, 0), a2, voffA);
            PG8_BAR; PG8_WAIT_L(0); PG8_MMA(1, 0, At, B0); PG8_BAR; PG8_SCHED;
            PG8_STAGE(PG8_SB(0, 1), b2 + hstep, voffB);
            PG8_WAIT_V(6); PG8_BAR; PG8_MMA(1, 1, At, B1); PG8_BAR;
            PG8_LDB(B0, 1, 0); PG8_SCHED; PG8_LDA(At, 1, 0); PG8_STAGE(PG8_SA(0, 1), a2 + hstep, voffA);
            PG8_WAIT_L(8); PG8_BAR; PG8_WAIT_L(0); PG8_MMA(0, 0, At, B0); PG8_BAR; PG8_SCHED;
            PG8_LDB(B1, 1, 1); PG8_STAGE(PG8_SB(1, 0), b3, voffB);
            PG8_BAR; PG8_WAIT_L(0); PG8_MMA(0, 1, At, B1); PG8_BAR;
            PG8_LDA(At, 1, 1); PG8_STAGE(PG8_SA(1, 0), a3, voffA);
            PG8_BAR; PG8_WAIT_L(0); PG8_MMA(1, 0, At, B0); PG8_BAR; PG8_SCHED;
            PG8_STAGE(PG8_SB(1, 1), b3 + hstep, voffB);
            PG8_WAIT_V(6); PG8_BAR; PG8_MMA(1, 1, At, B1); PG8_BAR;
            }
        }
        if constexpr (ALIGN_EPI) { if (wr == 0) PG8_BAR; }
        if constexpr (!Epi::AFTER_DRAIN) { E(acc, cur, wr, wc, fr, fq); S.done(cur); }
        if (!has_next) break;
#pragma unroll
        for (int a = 0; a < 2; ++a)
#pragma unroll
            for (int b = 0; b < 2; ++b)
#pragma unroll
                for (int m = 0; m < 4; ++m)
#pragma unroll
                    for (int n = 0; n < 2; ++n) acc[a][b][m][n] = (f32x4){0.f, 0.f, 0.f, 0.f};
        cur = nxt; cA = nA; cB = nB; ++ui;
        if constexpr (ALIGN_EPI) { if (wr == 1) PG8_BAR; }
    }
    PG8_WAIT_V(0);
    if constexpr (!ALIGN_EPI) { if (wr == 0) PG8_BAR; }
    PG8_BAR;
    if constexpr (Epi::AFTER_DRAIN) { E.fused(acc, cur, wr, wc, fr, fq, lds, wid, lane); S.done(cur); }
#undef PG8_SA
#undef PG8_SB
#undef PG8_STAGE
#undef PG8_LDA
#undef PG8_LDB
#undef PG8_MMA
#undef PG8_WAIT_V
#undef PG8_WAIT_L
#undef PG8_BAR
#undef PG8_SCHED
}
}
namespace ab {
constexpr int D = 128;
constexpr float THR = 8.f;
constexpr bool WSKIP = false;
constexpr float SCALE = 0.08838834764831845f;
constexpr int NW = 8, QBLK = 32, KVBLK = 64, QB = NW * QBLK;
constexpr int SHM_V = KVBLK * D * 2, SHM_K = KVBLK * D * 2;
constexpr int LDS_BYTES = 2 * SHM_V + 2 * SHM_K + NW * 64 * 4;
typedef unsigned short bf16;
typedef short bf16x8 __attribute__((ext_vector_type(8)));
typedef short s16x4 __attribute__((ext_vector_type(4)));
typedef float f32x16 __attribute__((ext_vector_type(16)));
typedef float f32x4 __attribute__((ext_vector_type(4)));
typedef unsigned u32x4 __attribute__((ext_vector_type(4)));
template <class A, class Bt> struct same_t { static constexpr bool v = false; };
template <class A> struct same_t<A, A> { static constexpr bool v = true; };

#define KSWZ(row, colB) ((row) * 256 + ((colB) ^ (((row) & 7) << 4)))
#define SBAR() __builtin_amdgcn_sched_barrier(0)
__device__ __forceinline__ int v_st(int k, int c) { const int kk = (k & ~0xC) | ((k & 4) << 1) | ((k & 8) >> 1); return ((kk >> 3) * 4 + (c >> 5)) * 512 + ((kk & 7) * 32 + (c & 31)) * 2; }
__device__ __forceinline__ int v_rd_base(int lane) { return ((lane & 3) << 3) | (((lane >> 2) & 3) << 6) | (((lane >> 4) & 1) << 5) | (((lane >> 5) & 1) << 8); }
constexpr int v_rd_off(int d0, int ks, int half) { return d0 * 512 + ks * 4096 + half * 2048; }
__device__ __forceinline__ int crow(int r, int hi) { return (r & 3) + 8 * (r >> 2) + 4 * hi; }
__device__ __forceinline__ unsigned cvtpk(float lo, float hi) {
    unsigned r; asm volatile("v_cvt_pk_bf16_f32 %0, %1, %2" : "=v"(r) : "v"(lo), "v"(hi)); return r;
}
__device__ __forceinline__ bf16x8 pack8(f32x4 a, f32x4 b) {
    u32x4 w = {cvtpk(a[0], a[1]), cvtpk(a[2], a[3]), cvtpk(b[0], b[1]), cvtpk(b[2], b[3])};
    return *reinterpret_cast<bf16x8*>(&w);
}
template <class T> __device__ __forceinline__ bf16x8 load8(const T* p) {
    if constexpr (same_t<T, float>::v) { return pack8(*(const f32x4*)p, *(const f32x4*)(p + 4)); }
    else { return *reinterpret_cast<const bf16x8*>(p); }
}
__device__ __forceinline__ void mask_tile(f32x16& p0, f32x16& p1, int dq, unsigned W) {
    const float NEG = -__builtin_inff();
#pragma unroll
    for (int r = 0; r < 16; ++r) {
        const int c = (r & 3) + 8 * (r >> 2);
        if ((unsigned)(dq - c) >= W) p0[r] = NEG;
        if ((unsigned)(dq - c - 32) >= W) p1[r] = NEG;
    }
}
__device__ __forceinline__ void partialSM(f32x16& p0, f32x16& p1, float& m_reg, float& mn, float& alpha) {
    float pmax = p0[0]; for (int r = 1; r < 16; ++r) pmax = fmaxf(pmax, p0[r]); for (int r = 0; r < 16; ++r) pmax = fmaxf(pmax, p1[r]);
    { auto rr = __builtin_amdgcn_permlane32_swap(__float_as_uint(pmax), __float_as_uint(pmax), false, false);
      pmax = fmaxf(__uint_as_float(rr[0]), __uint_as_float(rr[1])); }
    constexpr float C2 = 1.4426950408889634f * SCALE;
    if (__builtin_expect(__all((pmax - m_reg) * SCALE <= THR), 1)) { mn = m_reg; alpha = 1.f; }
    else { mn = fmaxf(m_reg, pmax); alpha = __builtin_amdgcn_exp2f((m_reg - mn) * C2); m_reg = mn; }
    const float mnL = -mn * C2;
    for (int r = 0; r < 16; ++r) p0[r] = fmaf(p0[r], C2, mnL); for (int r = 0; r < 16; ++r) p1[r] = fmaf(p1[r], C2, mnL);
    for (int r = 0; r < 16; ++r) p0[r] = __builtin_amdgcn_exp2f(p0[r]);
}
__device__ __forceinline__ void finishSM(f32x16& p0, f32x16& p1, float alpha, float& l_reg, bf16x8& pa0, bf16x8& pa1, bf16x8& pa2, bf16x8& pa3) {
    for (int r = 0; r < 16; ++r) p1[r] = __builtin_amdgcn_exp2f(p1[r]);
    float ps = 0; for (int r = 0; r < 16; ++r) ps += p0[r]; for (int r = 0; r < 16; ++r) ps += p1[r];
    { auto rr = __builtin_amdgcn_permlane32_swap(__float_as_uint(ps), __float_as_uint(ps), false, false);
      ps = __uint_as_float(rr[0]) + __uint_as_float(rr[1]); }
    l_reg = l_reg * alpha + ps;
#define PK4(P, B_, OUT) do { unsigned a0 = cvtpk(P[B_+0], P[B_+1]), a1 = cvtpk(P[B_+2], P[B_+3]);                          \
        unsigned b0 = cvtpk(P[B_+4], P[B_+5]), b1 = cvtpk(P[B_+6], P[B_+7]);                                             \
        auto r0 = __builtin_amdgcn_permlane32_swap(a0, b0, false, false); auto r1 = __builtin_amdgcn_permlane32_swap(a1, b1, false, false); \
        u32x4 w = {r0[0], r1[0], r0[1], r1[1]}; OUT = *reinterpret_cast<bf16x8*>(&w); } while (0)
    PK4(p0, 0, pa0); PK4(p0, 8, pa1); PK4(p1, 0, pa2); PK4(p1, 8, pa3);
#undef PK4
}
template <int KB, bool SK>
__device__ __forceinline__ void qkt(f32x16& p0, f32x16& p1, const char* K_lds, int r32, int hi, const bf16x8* qr, bool act) {
    if (SK && !act) { const float NEG = -__builtin_inff();
#pragma unroll
        for (int r = 0; r < 16; ++r) { p0[r] = NEG; p1[r] = NEG; } return; }
    p0 = f32x16{}; p1 = f32x16{};
    const char* kb[4];
#pragma unroll
    for (int dd = 0; dd < 4; ++dd) kb[dd] = K_lds + KB * SHM_K + KSWZ(r32, (dd * 16 + hi * 8) * 2);
#pragma unroll
    for (int d0 = 0; d0 < 8; ++d0) { const char* a = kb[d0 & 3] + (d0 >> 2) * 128;
        bf16x8 b0 = *reinterpret_cast<const bf16x8*>(a);
        bf16x8 b1 = *reinterpret_cast<const bf16x8*>(a + 32 * 256);
        p0 = __builtin_amdgcn_mfma_f32_32x32x16_bf16(b0, qr[d0], p0, 0, 0, 0);
        p1 = __builtin_amdgcn_mfma_f32_32x32x16_bf16(b1, qr[d0], p1, 0, 0, 0); }
}
template <int VB, bool SK>
__device__ __forceinline__ void pv_tile(f32x16* o, int vb0, bf16x8 pa0, bf16x8 pa1, bf16x8 pa2, bf16x8 pa3, bool act) {
    if (SK && !act) return;
#define TRRD(dst, off) asm volatile("ds_read_b64_tr_b16 %0, %1 offset:%2" : "=&v"(dst) : "v"(vb0), "i"(off) : "memory")
#define PV_D0(d0) do { s16x4 l0, l1, l2, l3, h0, h1, h2, h3; constexpr int b_ = VB * SHM_V + v_rd_off(d0, 0, 0);     \
        TRRD(l0, b_); TRRD(h0, b_ + 2048); TRRD(l1, b_ + 4096); TRRD(h1, b_ + 6144); TRRD(l2, b_ + 8192); TRRD(h2, b_ + 10240); TRRD(l3, b_ + 12288); TRRD(h3, b_ + 14336); \
        asm volatile("s_waitcnt lgkmcnt(0)" ::: "memory"); SBAR();                 \
        o[d0] = __builtin_amdgcn_mfma_f32_32x32x16_bf16(pa0, (bf16x8){l0[0], l0[1], l0[2], l0[3], h0[0], h0[1], h0[2], h0[3]}, o[d0], 0, 0, 0);   \
        o[d0] = __builtin_amdgcn_mfma_f32_32x32x16_bf16(pa1, (bf16x8){l1[0], l1[1], l1[2], l1[3], h1[0], h1[1], h1[2], h1[3]}, o[d0], 0, 0, 0);   \
        o[d0] = __builtin_amdgcn_mfma_f32_32x32x16_bf16(pa2, (bf16x8){l2[0], l2[1], l2[2], l2[3], h2[0], h2[1], h2[2], h2[3]}, o[d0], 0, 0, 0);   \
        o[d0] = __builtin_amdgcn_mfma_f32_32x32x16_bf16(pa3, (bf16x8){l3[0], l3[1], l3[2], l3[3], h3[0], h3[1], h3[2], h3[3]}, o[d0], 0, 0, 0); } while (0)
    PV_D0(0); PV_D0(1); PV_D0(2); PV_D0(3);
#undef PV_D0
#undef TRRD
}

template <class TIn, class TOut> struct BlockRef { const TIn* Q; const TIn* K; const TIn* V; TOut* O; int P0; };
template <class TIn> struct Seam {
    bf16x8 qr[8];
    bf16x8 st_v0, st_v1, st_k0, st_k1; f32x4 sf0, sf1, sf2, sf3;
    f32x4 tq[16];
};
__device__ __forceinline__ int swa_jlo(int P0, int W) { const int lowk = P0 - W + 1; return lowk > 0 ? lowk / KVBLK : 0; }
#define ROW(p, k0, rr) ((p) + (size_t)((k0) + (rr)) * D + sc)
#define VMW() asm volatile("s_waitcnt vmcnt(0)" ::: "memory")
#define VMWN(n) asm volatile("s_waitcnt vmcnt(%0)" :: "i"(n) : "memory")
#define SLOAD_H(Kp, Vp, k0) do { S.st_v0 = load8<TIn>(ROW(Vp, k0, sr)); S.st_v1 = load8<TIn>(ROW(Vp, k0, 32 + sr));              \
                         S.st_k0 = load8<TIn>(ROW(Kp, k0, sr)); S.st_k1 = load8<TIn>(ROW(Kp, k0, 32 + sr)); } while (0)
#define SWRITE_HK(bf) do { *(bf16x8*)(K_lds + (bf) * SHM_K + kws) = S.st_k0; *(bf16x8*)(K_lds + (bf) * SHM_K + kws + 32 * 256) = S.st_k1; } while (0)
#define SWRITE_HV(bf) do { *(bf16x8*)(V_lds + (bf) * SHM_V + vst0) = S.st_v0; *(bf16x8*)(V_lds + (bf) * SHM_V + vst1) = S.st_v1; } while (0)
#define SWRITE_H(bf) do { SWRITE_HV(bf); SWRITE_HK(bf); } while (0)
#define SLOAD_F(p, k0) do { S.sf0 = *(const f32x4*)ROW(p, k0, sr); S.sf1 = *(const f32x4*)(ROW(p, k0, sr) + 4);                \
                            S.sf2 = *(const f32x4*)ROW(p, k0, 32 + sr); S.sf3 = *(const f32x4*)(ROW(p, k0, 32 + sr) + 4); } while (0)
#define SWRITE_KF(bf) do { *(bf16x8*)(K_lds + (bf) * SHM_K + kws) = pack8(S.sf0, S.sf1); *(bf16x8*)(K_lds + (bf) * SHM_K + kws + 32 * 256) = pack8(S.sf2, S.sf3); } while (0)
#define SWRITE_VF(bf) do { *(bf16x8*)(V_lds + (bf) * SHM_V + vst0) = pack8(S.sf0, S.sf1); *(bf16x8*)(V_lds + (bf) * SHM_V + vst1) = pack8(S.sf2, S.sf3); } while (0)
template <class TIn, class TOut>
__device__ __forceinline__ void causal_swa_prime(const BlockRef<TIn, TOut>& cur, int W, char* lds, Seam<TIn>& S) {
    constexpr bool F32 = same_t<TIn, float>::v;
    const int tid = tid_fresh(), wid = __builtin_amdgcn_readfirstlane(tid >> 6), lane = tid & 63, r32 = lane & 31, hi = lane >> 5;
    const int sr = tid >> 4, sc = (tid & 15) * 8, kws = KSWZ(sr, sc * 2); char* K_lds = lds + 2 * SHM_V;
    const int kb0 = swa_jlo(cur.P0, W) * KVBLK;
    for (int d0 = 0; d0 < 8; ++d0) S.qr[d0] = load8<TIn>(cur.Q + (size_t)(wid * QBLK + r32) * D + d0 * 16 + hi * 8);
    if constexpr (F32) { SLOAD_F((const float*)cur.K, kb0); VMW(); SWRITE_KF(0); SBAR(); SLOAD_F((const float*)cur.V, kb0); }
    else { SLOAD_H(cur.K, cur.V, kb0); VMW(); SWRITE_HK(0); }
    __syncthreads();
}
template <class TIn, class TOut>
__device__ __forceinline__ void causal_swa_block(const BlockRef<TIn, TOut>& cur, const BlockRef<TIn, TOut>& nxt, int skv, int W, char* lds, Seam<TIn>& S) {
    constexpr bool F32 = same_t<TIn, float>::v;
    const int tid = tid_fresh(), wid = __builtin_amdgcn_readfirstlane(tid >> 6), lane = tid & 63, r32 = lane & 31, hi = lane >> 5;
    const int j_lo = swa_jlo(cur.P0, W);
    int j_hi = (cur.P0 + QB - 1) / KVBLK + 1; if (j_hi > skv / KVBLK) j_hi = skv / KVBLK;
    const int NT = j_hi - j_lo;
    const int kbn = swa_jlo(nxt.P0, W) * KVBLK;
    const int qlo = cur.P0 + wid * QBLK, qm = qlo + r32 - 4 * hi;
    char* V_lds = lds; char* K_lds = lds + 2 * SHM_V;
    float* ws = (float*)(lds + 2 * SHM_V + 2 * SHM_K) + wid * 64; float* li_l = ws, * al_l = ws + 32;
    float m_reg = -1e30f, l_reg = 0; f32x16 o[4] = {};
    const int sr = tid >> 4, sc = (tid & 15) * 8, vst0 = v_st(sr, sc), vst1 = v_st(32 + sr, sc), kws = KSWZ(sr, sc * 2);
    const int vb0 = (int)(uintptr_t)V_lds + v_rd_base(lane);
    const TIn* Kh = cur.K; const TIn* Vh = cur.V;
#define RESC(a) do { if (__any((a) < 1.f)) { if (hi == 0) al_l[r32] = (a); asm volatile("s_waitcnt lgkmcnt(0)" ::: "memory");              \
                     for (int d_ = 0; d_ < 4; ++d_) for (int r = 0; r < 16; ++r) o[d_][r] *= al_l[crow(r, hi)]; } } while (0)
#define KBASE(t) ((j_lo + (t)) * KVBLK)
#define ACT(t) (KBASE(t) <= qlo + QBLK - 1 && KBASE(t) + KVBLK - 1 >= qlo - W + 1)
#define MASKT(P0_, P1_, t) do { const int kb_ = KBASE(t); if ((!SK || ACT(t)) && (kb_ + KVBLK - 1 > qlo || kb_ <= qlo + QBLK - 1 - W)) mask_tile(P0_, P1_, qm - kb_, (unsigned)W); } while (0)
    constexpr int NQL = F32 ? 16 : 8;
    constexpr bool SK = WSKIP && !F32;
#define SEAM_K0() do { VMWN(NQL); if constexpr (F32) { SWRITE_KF(0); SBAR(); SLOAD_F((const float*)nxt.V, kbn); } else { SWRITE_HK(0); } SBAR(); } while (0)
    f32x16 pA0, pA1, pB0, pB1; float mnA, mnB, alA, alB; bf16x8 pa0, pa1, pa2, pa3;
    if constexpr (F32) { VMW(); SWRITE_VF(0); SBAR(); } else { SWRITE_HV(0); SBAR(); }
    if (NT > 1) { if constexpr (F32) SLOAD_F((const float*)Kh, KBASE(1)); else SLOAD_H(Kh, Vh, KBASE(1)); }
    SBAR(); qkt<0, SK>(pA0, pA1, K_lds, r32, hi, S.qr, ACT(0));
    if constexpr (F32) { if (NT > 1) { VMW(); SWRITE_KF(1); SBAR(); SLOAD_F((const float*)Vh, KBASE(1)); } }
    MASKT(pA0, pA1, 0); partialSM(pA0, pA1, m_reg, mnA, alA);
    if (NT > 1) { VMW(); if constexpr (F32) { SWRITE_VF(1); SBAR(); if (NT > 2) SLOAD_F((const float*)Kh, KBASE(2)); } else SWRITE_H(1); }
    __syncthreads();
#define HALF_STEP(PX0, PX1, mnX, alX, PY0, PY1, alY, t, KB, VB, SB) do {                                                      \
        SBAR(); qkt<KB, SK>(PX0, PX1, K_lds, r32, hi, S.qr, ACT(t));                                             \
        finishSM(PY0, PY1, alY, l_reg, pa0, pa1, pa2, pa3); SBAR();                                                           \
        if ((t) + 1 < NT) { if constexpr (F32) { VMW(); SWRITE_KF(SB); SBAR(); SLOAD_F((const float*)Vh, KBASE((t) + 1)); }  \
                            else { SLOAD_H(Kh, Vh, KBASE((t) + 1)); } SBAR(); }                                               \
        pv_tile<VB, SK>(o, vb0, pa0, pa1, pa2, pa3, ACT((t) - 1)); MASKT(PX0, PX1, (t)); partialSM(PX0, PX1, m_reg, mnX, alX);                                        \
        __syncthreads();                                                                                                      \
        if ((t) + 1 < NT) { VMW(); if constexpr (F32) { SWRITE_VF(SB); SBAR(); if ((t) + 2 < NT) SLOAD_F((const float*)Kh, KBASE((t) + 2)); } \
                            else { SWRITE_H(SB); } }                                                                          \
        RESC(alX); __syncthreads(); } while (0)
    for (int t = 1; t + 1 < NT; t += 2) {
        HALF_STEP(pB0, pB1, mnB, alB, pA0, pA1, alA, t, 1, 0, 0);
        HALF_STEP(pA0, pA1, mnA, alA, pB0, pB1, alB, t + 1, 0, 1, 1);
    }
    const bool even = (NT & 1) == 0;
    if (even) { SBAR(); qkt<1, SK>(pB0, pB1, K_lds, r32, hi, S.qr, ACT(NT - 1)); SBAR(); }
#define QROW(e) (nxt.Q + (size_t)(wid * QBLK + r32) * D + ((e) >> 1) * 16 + hi * 8 + ((e) & 1) * 4)
    if constexpr (F32) { SLOAD_F((const float*)nxt.K, kbn); SBAR();
#pragma unroll
        for (int e = 0; e < 8; ++e) S.tq[e] = *(const f32x4*)QROW(e); }
    else { SLOAD_H(nxt.K, nxt.V, kbn); SBAR();
#pragma unroll
        for (int d0 = 0; d0 < 8; ++d0) S.qr[d0] = load8<TIn>(nxt.Q + (size_t)(wid * QBLK + r32) * D + d0 * 16 + hi * 8); }
    SBAR();
    finishSM(pA0, pA1, alA, l_reg, pa0, pa1, pa2, pa3); SBAR();
    if constexpr (F32) {
#pragma unroll
        for (int e = 8; e < 16; ++e) S.tq[e] = *(const f32x4*)QROW(e); SBAR(); }
#undef QROW
    pv_tile<0, SK>(o, vb0, pa0, pa1, pa2, pa3, ACT(even ? NT - 2 : NT - 1));
    if (even) { MASKT(pB0, pB1, NT - 1); partialSM(pB0, pB1, m_reg, mnB, alB); __syncthreads(); RESC(alB);
        finishSM(pB0, pB1, alB, l_reg, pa0, pa1, pa2, pa3); SBAR(); pv_tile<1, SK>(o, vb0, pa0, pa1, pa2, pa3, ACT(NT - 1)); }
    SBAR(); SEAM_K0();
    if (hi == 0) li_l[r32] = l_reg; asm volatile("s_waitcnt lgkmcnt(0)" ::: "memory");
    float rli[16];
#pragma unroll
    for (int r = 0; r < 16; ++r) rli[r] = __builtin_amdgcn_rcpf(li_l[crow(r, hi)]);
    TOut* Ow = cur.O + (size_t)(wid * QBLK) * D;
#pragma unroll
    for (int r = 0; r < 16; ++r) { const int orow = crow(r, hi);
#pragma unroll
        for (int d0 = 0; d0 < 4; ++d0) { const float v = o[d0][r] * rli[r];
            if constexpr (same_t<TOut, float>::v) { Ow[(size_t)orow * D + d0 * 32 + r32] = v; }
            else { const float vn = __shfl_xor(v, 1);
                   if ((r32 & 1) == 0) *(unsigned*)(Ow + (size_t)orow * D + d0 * 32 + r32) = cvtpk(v, vn); } } }
    if constexpr (F32) {
#pragma unroll
        for (int d0 = 0; d0 < 8; ++d0) S.qr[d0] = pack8(S.tq[2 * d0], S.tq[2 * d0 + 1]); }
    __syncthreads();
#undef RESC
#undef KBASE
#undef ACT
#undef MASKT
#undef SEAM_K0
#undef HALF_STEP
}
#undef ROW
#undef VMW
#undef VMWN
#undef SLOAD_H
#undef SWRITE_HK
#undef SWRITE_HV
#undef SWRITE_H
#undef SLOAD_F
#undef SWRITE_KF
#undef SWRITE_VF
constexpr int DA_K = 0, DA_V = 32768, DA_PX = 98304, DA_AL = 131072, DA_FL = DA_AL + 1024, DA_LL = DA_FL + 64, DA_OSC = DA_LL + 512  , DA_LDS = DA_OSC + 16384;
struct DaBlk { const bf16* Q; const bf16* K; const bf16* V0; const bf16* V1; bf16* O0; bf16* O1; int P0, nt; };
#if defined(DA_TESTRUN)
#define DA_TESTV(g) ((g).test)
#else
#define DA_TESTV(g) 0
#endif
struct DaGeom { const bf16* Qb; const bf16* Kb; const bf16* Vb; bf16* Ob; int vcu, G, nblk, skvp, seq, nmeta, test; };
template <int TEST = 0> __device__ __forceinline__ DaBlk da_blk_t(const DaGeom& g, int j) {
    const int item = g.vcu + g.G * (j >> 1), head = (DA_TESTV(g) == 1) ? 0 : ((DA_TESTV(g) == 2) ? ((item >> 5) & 7) : (item >> 5)), x = item & 31, qb = (j & 1) ? x : 63 - x;
    const int b = head >> 5, h = (head >> 1) & 15, c = head & 1;
    DaBlk B; const size_t hs = (size_t)g.skvp * D;
    B.Q = g.Qb + (size_t)(b * 32 + 2 * h + c) * hs + (size_t)(g.nmeta + 128 * qb) * D; B.K = g.Kb + (size_t)(b * 32 + 2 * h + c) * hs;
    B.V0 = g.Vb + (size_t)(b * 32 + 2 * h) * hs; B.V1 = B.V0 + hs;
    B.O0 = g.Ob + ((size_t)(head * 2) * g.seq + 128 * qb) * D; B.O1 = B.O0 + (size_t)g.seq * D;
    B.P0 = g.nmeta + 128 * qb; B.nt = (B.P0 + 127) / KVBLK + 1;
    return B;
}
__device__ __forceinline__ DaBlk da_blk(const DaGeom& g, int j) { return da_blk_t<0>(g, j); }
struct DaCur { int j, t, nt; };
__device__ __forceinline__ int da_tile(const DaCur& c) { return (c.j & 1) ? c.nt - 1 - c.t : c.t; }
__device__ __forceinline__ void da_adv(const DaGeom& g, DaCur& c) { if (c.t + 1 < c.nt) { ++c.t; } else if (c.j + 1 < g.nblk) { ++c.j; c.t = 0; c.nt = da_blk(g, c.j).nt; } }

template <int CTRL, bool BC> __device__ __forceinline__ float dppf(float x) { return __builtin_bit_cast(float, __builtin_amdgcn_update_dpp(0, __builtin_bit_cast(int, x), CTRL, 0xF, 0xF, BC)); }
template <int VB, class HOOK> __device__ __forceinline__ void da_pv2(f32x16* o, int vb0, bf16x8 pa0, bf16x8 pa1, bf16x8 pa2, bf16x8 pa3, bf16x8 pb0, bf16x8 pb1, bf16x8 pb2, bf16x8 pb3, HOOK&& hook) {
#define DA_TR(dst, off) asm volatile("ds_read_b64_tr_b16 %0, %1 offset:%2" : "=&v"(dst) : "v"(vb0), "i"(off) : "memory")
#define DA_TR8(S, d0) do { constexpr int b_ = VB * SHM_V + v_rd_off(d0, 0, 0); \
        DA_TR(S##l0, b_); DA_TR(S##h0, b_ + 2048); DA_TR(S##l1, b_ + 4096); DA_TR(S##h1, b_ + 6144); DA_TR(S##l2, b_ + 8192); DA_TR(S##h2, b_ + 10240); DA_TR(S##l3, b_ + 12288); DA_TR(S##h3, b_ + 14336); } while (0)
#define DA_VF(S, k) (bf16x8){S##l##k[0], S##l##k[1], S##l##k[2], S##l##k[3], S##h##k[0], S##h##k[1], S##h##k[2], S##h##k[3]}
#define DA_HK(h) do { if ((h) >= 0 && (h) < 0) { SBAR(); hook(h); SBAR(); } } while (0)
#define DA_MM(S, d0, H) do { \
        o[d0] = __builtin_amdgcn_mfma_f32_32x32x16_bf16(pa0, DA_VF(S, 0), o[d0], 0, 0, 0); DA_HK(H); o[4 + d0] = __builtin_amdgcn_mfma_f32_32x32x16_bf16(pb0, DA_VF(S, 0), o[4 + d0], 0, 0, 0); DA_HK(H + 1); \
        o[d0] = __builtin_amdgcn_mfma_f32_32x32x16_bf16(pa1, DA_VF(S, 1), o[d0], 0, 0, 0); DA_HK(H + 2); o[4 + d0] = __builtin_amdgcn_mfma_f32_32x32x16_bf16(pb1, DA_VF(S, 1), o[4 + d0], 0, 0, 0); DA_HK(H + 3); \
        o[d0] = __builtin_amdgcn_mfma_f32_32x32x16_bf16(pa2, DA_VF(S, 2), o[d0], 0, 0, 0); DA_HK(H + 4); o[4 + d0] = __builtin_amdgcn_mfma_f32_32x32x16_bf16(pb2, DA_VF(S, 2), o[4 + d0], 0, 0, 0); DA_HK(H + 5); \
        o[d0] = __builtin_amdgcn_mfma_f32_32x32x16_bf16(pa3, DA_VF(S, 3), o[d0], 0, 0, 0); DA_HK(H + 6); o[4 + d0] = __builtin_amdgcn_mfma_f32_32x32x16_bf16(pb3, DA_VF(S, 3), o[4 + d0], 0, 0, 0); DA_HK(H + 7); } while (0)
    s16x4 Al0, Al1, Al2, Al3, Ah0, Ah1, Ah2, Ah3, Bl0, Bl1, Bl2, Bl3, Bh0, Bh1, Bh2, Bh3;
    DA_TR8(A, 0);
    DA_TR8(B, 1); asm volatile("s_waitcnt lgkmcnt(8)" ::: "memory"); SBAR(); DA_MM(A, 0, 0); SBAR();
    DA_TR8(A, 2); asm volatile("s_waitcnt lgkmcnt(8)" ::: "memory"); SBAR(); DA_MM(B, 1, 8); SBAR();
    DA_TR8(B, 3); asm volatile("s_waitcnt lgkmcnt(8)" ::: "memory"); SBAR(); DA_MM(A, 2, -100); SBAR();
    asm volatile("s_waitcnt lgkmcnt(0)" ::: "memory"); SBAR(); DA_MM(B, 3, -100); SBAR();
#undef DA_TR
#undef DA_TR8
#undef DA_VF
#undef DA_MM
#undef DA_HK
}
#define DA_KSWZ(row, colB) ((row) * 256 + ((colB) ^ (((row) & 15) << 4)))
template <int KB> __device__ __forceinline__ void da_qkt(f32x16& p0, f32x16& p1, const char* K_lds, int r32, int hi, const bf16x8* qr) {
    const char* kb[4];
#pragma unroll
    for (int dd = 0; dd < 4; ++dd) kb[dd] = K_lds + KB * SHM_K + DA_KSWZ(r32, (dd * 16 + hi * 8) * 2);
    bf16x8 f0[8], f1[8];
#pragma unroll
    for (int d0 = 0; d0 < 8; ++d0) { const char* a = (d0 >> 2) ? K_lds + KB * SHM_K + DA_KSWZ(r32, ((d0 & 3) * 16 + hi * 8) * 2 + 128) : kb[d0 & 3]; f0[d0] = *reinterpret_cast<const bf16x8*>(a); f1[d0] = *reinterpret_cast<const bf16x8*>(a + 32 * 256); }
    SBAR();
    p0 = f32x16{}; p1 = f32x16{};
    __builtin_amdgcn_s_setprio(3);
#pragma unroll
    for (int d0 = 0; d0 < 8; ++d0) { p0 = __builtin_amdgcn_mfma_f32_32x32x16_bf16(f0[d0], qr[d0], p0, 0, 0, 0); p1 = __builtin_amdgcn_mfma_f32_32x32x16_bf16(f1[d0], qr[d0], p1, 0, 0, 0); }
    __builtin_amdgcn_s_setprio(0);
    SBAR();
}
typedef const __attribute__((address_space(1))) char* da_gptr;
__device__ __forceinline__ da_gptr da_uni(const char* p) { const unsigned long long v = (unsigned long long)p;
    const unsigned lo = __builtin_amdgcn_readfirstlane((unsigned)v), hi = __builtin_amdgcn_readfirstlane((unsigned)(v >> 32)); return (da_gptr)(((unsigned long long)hi << 32) | lo); }
__device__ __forceinline__ bool da_adv2(const DaGeom& g, DaCur& c) { if (c.t + 1 < c.nt) { ++c.t; return false; } if (c.j + 1 < g.nblk) { ++c.j; c.t = 0; c.nt = da_blk(g, c.j).nt; return true; } return false; }
__device__ __forceinline__ void da_phase(char* lds, const bf16* Qb, const bf16* Kb, const bf16* Vb, bf16* Ob, int vcu, int G, int skvp, int seq, int nmeta, int test = 0) {
    const int tid = tid_fresh(), wid = __builtin_amdgcn_readfirstlane(tid >> 6), lane = tid & 63, r32 = lane & 31, hi = lane >> 5;
    const bool prod = wid < 4; const int pw = wid & 3;
    DaGeom g{Qb, Kb, Vb, Ob, vcu, G, 0, skvp, seq, nmeta, test};
    { const int nitems = (2048 - vcu + G - 1) / G; g.nblk = vcu < 2048 ? 2 * nitems : 0; }
    if (g.nblk == 0) return;
    int nsteps = 1; for (int j = 0; j < g.nblk; ++j) nsteps += da_blk(g, j).nt;
    char* K_lds = lds + DA_K; char* V_lds = lds + DA_V;
    const int vb0 = (int)(uintptr_t)V_lds + v_rd_base(lane);
    float* al_w = (float*)(lds + DA_AL); unsigned* fl_w = (unsigned*)(lds + DA_FL); float* ll_w = (float*)(lds + DA_LL);
    const DaCur cstart{0, 0, da_blk(g, 0).nt};
    unsigned voffK[4], voffV[4];
#pragma unroll
    for (int j = 0; j < 4; ++j) { const int row = 16 * pw + 4 * j + (lane >> 4), chunk = (lane & 15) ^ (row & 15); voffK[j] = (unsigned)(row * 256 + chunk * 16);
        const int key = (pw << 4) | (((lane >> 4) & 1) << 3) | ((j >> 1) << 2) | ((lane >> 2) & 3), col = ((2 * (j & 1) + (lane >> 5)) << 5) | ((lane & 3) * 8); voffV[j] = (unsigned)(key * 256 + col * 2); }
    const unsigned dmaw = (unsigned)pw * 4096u;
#define DA_GLDS(src, ldsoff) __builtin_amdgcn_global_load_lds((const __attribute__((address_space(1))) unsigned*)(src), (__attribute__((address_space(3))) unsigned*)(lds + (ldsoff)), 16, 0, 0)
    DaCur ck = cstart, cv = cstart; const DaBlk Bkv = da_blk(g, 0);
    const char* kbase = (const char*)Bkv.K; const char* v0base = (const char*)Bkv.V0; const char* v1base = (const char*)Bkv.V1;
#define DA_ADVK() do { if (da_adv2(g, ck)) kbase = (const char*)da_blk(g, ck.j).K; } while (0)
#define DA_ADVV() do { if (da_adv2(g, cv)) { const DaBlk Bn_ = da_blk(g, cv.j); v0base = (const char*)Bn_.V0; v1base = (const char*)Bn_.V1; } } while (0)
#define DA_BAR() do { asm volatile("s_waitcnt lgkmcnt(0)" ::: "memory"); __builtin_amdgcn_s_barrier(); asm volatile("" ::: "memory"); } while (0)
#define DA_DMA1(PAR, i) do { const int j_ = (i) / 2, k_ = (i) % 2; unsigned vo_ = voffV[j_]; asm volatile("" : "+v"(vo_));     \
        if (k_ == 0) DA_GLDS(p0_ + vo_, DA_V + (2 * PAR) * SHM_V + dmaw + j_ * 1024); else DA_GLDS(p1_ + vo_, DA_V + (2 * PAR + 1) * SHM_V + dmaw + j_ * 1024); } while (0)
#define DA_DMAK(PAR) do { DA_ADVK(); const da_gptr kp = da_uni(kbase + (size_t)da_tile(ck) * 16384u); \
        _Pragma("unroll") for (int j_ = 0; j_ < 4; ++j_) { unsigned vo_ = voffK[j_]; asm volatile("" : "+v"(vo_)); DA_GLDS(kp + vo_, DA_K + (1 - PAR) * SHM_K + dmaw + j_ * 1024); } } while (0)
    if (prod) {
#pragma unroll
        for (int j = 0; j < 4; ++j) DA_GLDS(da_uni(kbase) + voffK[j], DA_K + dmaw + j * 1024);
    }
    if (prod) {
        bf16x8 qr[8]; float m_reg = -1e30f, l_reg = 0.f; DaCur cp = cstart; DaBlk Bp = da_blk(g, 0);
        bf16x8 qn[8];
#pragma unroll
        for (int d0 = 0; d0 < 8; ++d0) qn[d0] = bf16x8{};
#pragma unroll
        for (int d0 = 0; d0 < 8; ++d0) qr[d0] = load8<bf16>(Bp.Q + (size_t)(pw * QBLK + r32) * D + d0 * 16 + hi * 8);
        asm volatile("s_waitcnt vmcnt(0)" ::: "memory");
        DA_BAR();
#define DA_PSTEP(PAR, S, s_) do { bool qpf = false; \
            if ((s_) < nsteps - 1) { \
                f32x16 p0 = f32x16{}, p1 = f32x16{}; float mn, al = 1.f; bf16x8 pa0 = qr[0], pa1 = qr[1], pa2 = qr[2], pa3 = qr[3]; \
                { da_qkt<PAR>(p0, p1, K_lds, r32, hi, qr); DA_DMAK(PAR); SBAR();     \
                { const int qlo = Bp.P0 + pw * QBLK, kb_ = da_tile(cp) * KVBLK; if (kb_ + KVBLK - 1 > qlo) mask_tile(p0, p1, qlo + r32 - 4 * hi - kb_, 1u << 30); } \
                partialSM(p0, p1, m_reg, mn, al); finishSM(p0, p1, al, l_reg, pa0, pa1, pa2, pa3); } \
                char* px = lds + DA_PX + PAR * 16384 + pw * 4096 + lane * 16; \
                *(bf16x8*)(px) = pa0; *(bf16x8*)(px + 1024) = pa1; *(bf16x8*)(px + 2048) = pa2; *(bf16x8*)(px + 3072) = pa3; \
                if (hi == 0) al_w[PAR * 128 + pw * 32 + r32] = al; \
                const bool anyr = __any(al < 1.f); if (lane == 0) fl_w[PAR * 4 + pw] = anyr ? 1u : 0u; \
                if (cp.t == cp.nt - 2 && cp.j + 1 < g.nblk) { const DaBlk Bn = da_blk(g, cp.j + 1); qpf = true;     \
                    _Pragma("unroll") for (int d0 = 0; d0 < 8; ++d0) qn[d0] = load8<bf16>(Bn.Q + (size_t)(pw * QBLK + r32) * D + d0 * 16 + hi * 8); } \
                if (cp.t == cp.nt - 1) {                                     \
                    if (hi == 0) ll_w[pw * 32 + r32] = l_reg; m_reg = -1e30f; l_reg = 0.f; \
                    _Pragma("unroll") for (int d0 = 0; d0 < 8; ++d0) qr[d0] = qn[d0]; } \
                if (da_adv2(g, cp)) Bp = da_blk(g, cp.j); \
            } \
            if (qpf) asm volatile("s_waitcnt vmcnt(8)" ::: "memory"); else asm volatile("s_waitcnt vmcnt(0)" ::: "memory");     \
            DA_BAR(); } while (0)
        for (int s = 0; s < nsteps; s += 2) { DA_PSTEP(0, 0, s); if (s + 1 < nsteps) DA_PSTEP(1, 0, s + 1); }
#undef DA_PSTEP
    } else {
        f32x16 o[8]; DaCur cc = cstart; DaBlk Bc = da_blk(g, 0);
        const int rh = pw >> 1, ch = pw & 1, vb0c = vb0 + ch * SHM_V;
        bool stored = false;
#pragma unroll
        for (int d = 0; d < 8; ++d) o[d] = f32x16{};
        asm volatile("s_waitcnt vmcnt(0)" ::: "memory");
        DA_BAR();
        {
            const da_gptr p0_ = da_uni(v0base + (size_t)da_tile(cv) * 16384u), p1_ = da_uni(v1base + (size_t)da_tile(cv) * 16384u); DA_ADVV();
#pragma unroll
            for (int i_ = 0; i_ < 8; ++i_) DA_DMA1(0, i_);
            asm volatile("s_waitcnt vmcnt(0)" ::: "memory");
            DA_BAR();
        }
#define DA_CSTEP(PAR, S, s_) do { stored = false; \
            const da_gptr p0_ = da_uni(v0base + (size_t)da_tile(cv) * 16384u), p1_ = da_uni(v1base + (size_t)da_tile(cv) * 16384u); DA_ADVV(); \
            { \
                const char* px = lds + DA_PX + (1 - PAR) * 16384 + rh * 8192 + lane * 16; \
                const bf16x8 pa0 = *(const bf16x8*)(px), pa1 = *(const bf16x8*)(px + 1024), pa2 = *(const bf16x8*)(px + 2048), pa3 = *(const bf16x8*)(px + 3072); \
                const bf16x8 pb0 = *(const bf16x8*)(px + 4096), pb1 = *(const bf16x8*)(px + 5120), pb2 = *(const bf16x8*)(px + 6144), pb3 = *(const bf16x8*)(px + 7168); \
                SBAR(); _Pragma("unroll") for (int i_ = 0; i_ < 8; ++i_) DA_DMA1(PAR, i_); SBAR();     \
                _Pragma("unroll") for (int rb = 0; rb < 2; ++rb) { \
                    if (fl_w[(1 - PAR) * 4 + 2 * rh + rb] != 0u) { const float* alp = al_w + (1 - PAR) * 128 + (2 * rh + rb) * 32; \
                        _Pragma("unroll") for (int r = 0; r < 16; ++r) { const float a_ = alp[crow(r, hi)]; _Pragma("unroll") for (int d_ = 0; d_ < 4; ++d_) o[4 * rb + d_][r] *= a_; } } } \
                asm volatile("s_waitcnt lgkmcnt(0)" ::: "memory"); SBAR(); \
                da_pv2<2 * (1 - PAR)>(o, vb0c, pa0, pa1, pa2, pa3, pb0, pb1, pb2, pb3, [&](int i_) { DA_DMA1(PAR, i_); });     \
                if (cc.t == cc.nt - 1) {                                     \
                    char* osc = lds + DA_OSC + pw * 4096; const bool odd = (r32 & 1) != 0; bf16* Oh = ch ? Bc.O1 : Bc.O0; \
                    _Pragma("unroll") for (int rb = 0; rb < 2; ++rb) { \
                        float rli[16]; _Pragma("unroll") for (int r = 0; r < 16; ++r) rli[r] = __builtin_amdgcn_rcpf(ll_w[(2 * rh + rb) * 32 + crow(r, hi)]); \
                        _Pragma("unroll") for (int k = 0; k < 2; ++k) { \
                            _Pragma("unroll") for (int dd = 0; dd < 2; ++dd) _Pragma("unroll") for (int rp = 0; rp < 8; ++rp) { \
                                const float v0 = o[4 * rb + 2 * k + dd][2 * rp] * rli[2 * rp], v1 = o[4 * rb + 2 * k + dd][2 * rp + 1] * rli[2 * rp + 1]; \
                                const float snd = odd ? v0 : v1, rcv = dppf<0xB1, false>(snd);         \
                                const unsigned w = odd ? cvtpk(rcv, v1) : cvtpk(v0, rcv);                \
                                *(unsigned*)(osc + crow(odd ? 2 * rp + 1 : 2 * rp, hi) * 128 + (dd * 32 + (r32 & ~1)) * 2) = w; } \
                            asm volatile("s_waitcnt lgkmcnt(0)" ::: "memory"); \
                            bf16* Og = Oh + (size_t)((2 * rh + rb) * QBLK) * D + k * 64 + (lane & 7) * 8; \
                            _Pragma("unroll") for (int i = 0; i < 4; ++i) { const int row = (lane >> 3) + 8 * i; const bf16x8 vv = *(const bf16x8*)(osc + row * 128 + (lane & 7) * 16); \
                                if (DA_TESTV(g) == 0) __builtin_nontemporal_store(vv, (bf16x8*)(Og + (size_t)row * D)); } \
                            asm volatile("s_waitcnt lgkmcnt(0)" ::: "memory"); } } \
                    stored = true; _Pragma("unroll") for (int d0 = 0; d0 < 8; ++d0) o[d0] = f32x16{}; } \
                if (da_adv2(g, cc)) Bc = da_blk(g, cc.j); \
            } \
            if (stored) asm volatile("s_waitcnt vmcnt(16)" ::: "memory"); else asm volatile("s_waitcnt vmcnt(0)" ::: "memory");     \
            DA_BAR(); } while (0)
        for (int s = 1; s < nsteps; s += 2) { DA_CSTEP(1, 0, s); if (s + 1 < nsteps) DA_CSTEP(0, 0, s + 1); }
#undef DA_CSTEP
    }
#undef DA_DMA1
#undef DA_DMAK
#undef DA_GLDS
#undef DA_ADVK
#undef DA_ADVV
#undef DA_BAR
}
}
#define GAS __attribute__((address_space(1)))
#define LAS __attribute__((address_space(3)))
typedef unsigned short bf16;
typedef unsigned u32x4 __attribute__((ext_vector_type(4)));
typedef unsigned u32x2 __attribute__((ext_vector_type(2)));
typedef float f32x4 __attribute__((ext_vector_type(4)));
typedef float f32x2 __attribute__((ext_vector_type(2)));
typedef short bf16x8 __attribute__((ext_vector_type(8)));

#ifndef GEMM_SP2
#define GEMM_SP2 true
#endif
constexpr int DM = 4096, NB = 2, SEQ = 8192, NMETA = 16, FF = 16384, NH = 16, DH = 128, NSH = 32;
constexpr int MX = NB * SEQ;
constexpr int MP = MX + 256;
constexpr int SKVP = 8256, LPOS = 8208;
constexpr int SG = 256, SP = 64, SGS = 16;
constexpr float EPS = 1e-6f;
static_assert(SKVP == pg8::E_SKVP && NMETA == pg8::E_NMETA && MX / 256 == pg8::E_MXP, "epilogue constants");

constexpr size_t MiB = 1u << 20;
constexpr size_t WS_CTL = 0, CTL_ZERO_BYTES = 256 * 1024;
constexpr size_t WS_WQKV = 1 * MiB;
constexpr size_t WS_WO   = WS_WQKV + 96 * MiB;
constexpr size_t WS_WGLU = WS_WO + 32 * MiB;
constexpr size_t WS_WUP  = WS_WGLU + 64 * MiB;
constexpr size_t WS_WDN  = WS_WUP + 256 * MiB;
constexpr size_t WS_H    = WS_WDN + 256 * MiB;
constexpr size_t WS_PART = WS_H + 130 * MiB;
constexpr size_t WS_RSTD = WS_PART + 16 * MiB;
constexpr size_t WS_HN   = WS_H + 260 * MiB;
constexpr size_t WS_ATTO = WS_HN + 130 * MiB;
constexpr size_t WS_R    = WS_ATTO + 130 * MiB;
constexpr size_t QKV_T_BYTES = (size_t)NB * NSH * SKVP * DH * 2;
constexpr size_t WS_Q = WS_R, WS_K = WS_Q + QKV_T_BYTES, WS_V = WS_K + QKV_T_BYTES, WS_O = WS_V + QKV_T_BYTES;
constexpr size_t O_BYTES = (size_t)128 * SEQ * DH * 2;
constexpr size_t WS_MID = WS_R;
constexpr size_t WS_END = WS_O + O_BYTES;
static_assert((size_t)MP * DM * 4 == 260 * MiB && (size_t)MP * DM * 2 == 130 * MiB && QKV_T_BYTES == 129 * MiB && (size_t)MP * FF * 2 <= WS_END - WS_R, "ws map");
constexpr size_t WS_MPART = WS_END + 14 * MiB;
constexpr int CW_XRANK = 8192;
constexpr int CW_BAR = 4096;

constexpr int RING_BYTES = 131072;
constexpr int S5_BFRAG = 0, S5_CFRAG = 65536, S5_KTAB = 131072, S5_CPOW = 139264, S5_WPOW = 147456, S5_A256 = 149504, S5_A1024 = 150016, S5_F = 150528  , S5_EMETA = S5_F + 8192  ;
constexpr int MISC_OFF = 159232, LDS_BYTES = 159744;
static_assert(S5_EMETA + 512 == MISC_OFF && ab::LDS_BYTES <= RING_BYTES && 17 * 64 * 8 <= 8704, "LDS map");

#define LDS_WAIT() asm volatile("s_waitcnt lgkmcnt(0)" ::: "memory")
__device__ __forceinline__ unsigned pk2(float lo, float hi) { unsigned r; asm volatile("v_cvt_pk_bf16_f32 %0, %1, %2" : "=v"(r) : "v"(lo), "v"(hi)); return r; }
__device__ __forceinline__ float bflo(unsigned w) { return __builtin_bit_cast(float, w << 16); }
__device__ __forceinline__ float bfhi(unsigned w) { return __builtin_bit_cast(float, w & 0xffff0000u); }
__device__ __forceinline__ float wave_sum(float v) {
#pragma unroll
    for (int o = 1; o < 64; o <<= 1) v += __shfl_xor(v, o);
    return v;
}

#define XB_TMO      128
#define XB_XCNT(j)  (256  + 64 * (j))
#define XB_XSUB(j)  (1280 + 64 * (j))
#define XB_XGEN(j)  (2304 + 64 * (j))
#define XB_TOP      3328
#define XB_TOPGEN   3392
#define XCD_BAR_WORDS 3456
#define XB_SPIN_CAP (1u << 18)

__device__ __forceinline__ unsigned xb_ld(unsigned* p)              { return __hip_atomic_load(p, __ATOMIC_RELAXED, __HIP_MEMORY_SCOPE_AGENT); }
__device__ __forceinline__ unsigned xb_add(unsigned* p, unsigned v) { return __hip_atomic_fetch_add(p, v, __ATOMIC_RELAXED, __HIP_MEMORY_SCOPE_AGENT); }
__device__ __forceinline__ unsigned xb_xcc_id() { return (unsigned)__builtin_amdgcn_s_getreg((3 << 11) | 20) & 0xFu; }
#define XB_SPIN(cond, bar) do { unsigned _sp = 0; while (cond) { __builtin_amdgcn_s_sleep(1); \
    if ((++_sp & 255u) == 0u) { if (xb_ld(&(bar)[XB_TMO])) break; if (_sp > XB_SPIN_CAP) { atomicAdd(&(bar)[XB_TMO], 1u); break; } } } } while (0)

struct XcdBarrier {
    unsigned* bar; unsigned x;
    volatile LAS unsigned* st;
};

__device__ __forceinline__ XcdBarrier xcd_barrier_post(unsigned* bar, volatile LAS unsigned* st) {
    XcdBarrier b; b.bar = bar; b.x = xb_xcc_id(); b.st = st;
    if (threadIdx.x == 0) (void)xb_add(&bar[XB_XCNT(b.x)], 1u);
    return b;
}
__device__ __forceinline__ void xcd_barrier_complete(unsigned* bar, unsigned x, unsigned& nloc, unsigned& nx) {
    const unsigned G = gridDim.x * gridDim.y * gridDim.z;
    unsigned sum, cnt, mine, sp = 0u;
    for (;;) {
        sum = 0u; cnt = 0u; mine = 0u;
#pragma unroll
        for (unsigned j = 0; j < 16; ++j) { const unsigned c = xb_ld(&bar[XB_XCNT(j)]); sum += c; cnt += (c > 0u) ? 1u : 0u; mine = (j == x) ? c : mine; }
        if (sum == G) break;
        __builtin_amdgcn_s_sleep(1);
        if ((++sp & 255u) == 0u) { if (xb_ld(&bar[XB_TMO])) break; if (sp > XB_SPIN_CAP) { atomicAdd(&bar[XB_TMO], 1u); break; } }
    }
    nloc = mine > 0u ? mine : 1u; nx = cnt > 0u ? cnt : 1u;
}

__device__ __forceinline__ void xcd_barrier(const XcdBarrier& b) {
    asm volatile("s_waitcnt vmcnt(0)" ::: "memory");
    __syncthreads();
    if (threadIdx.x == 0) {
        unsigned* bar = b.bar;
        __builtin_amdgcn_s_waitcnt(0);
        unsigned nloc = b.st[0], nx = b.st[1];
        if (nloc == 0u) { xcd_barrier_complete(bar, b.x, nloc, nx); b.st[0] = nloc; b.st[1] = nx; }
        const unsigned old = xb_add(&bar[XB_XSUB(b.x)], 1u);
        const unsigned gen = old / nloc;
        if (old + 1u == (gen + 1u) * nloc) {
            __builtin_amdgcn_fence(__ATOMIC_RELEASE, "agent");
            asm volatile("s_waitcnt vmcnt(0)" ::: "memory");
            const unsigned og = xb_add(&bar[XB_TOP], 1u);
            const unsigned tg = og / nx;
            if (og + 1u == (tg + 1u) * nx) xb_add(&bar[XB_TOPGEN], 1u);
            else XB_SPIN(xb_ld(&bar[XB_TOPGEN]) == tg, bar);
            __builtin_amdgcn_fence(__ATOMIC_ACQUIRE, "agent");
            xb_add(&bar[XB_XGEN(b.x)], 1u);
            asm volatile("s_waitcnt vmcnt(0)" ::: "memory");
        } else {
            XB_SPIN(xb_ld(&bar[XB_XGEN(b.x)]) == gen, bar);
            __builtin_amdgcn_fence(__ATOMIC_ACQUIRE, "agent");
            asm volatile("s_waitcnt vmcnt(0)" ::: "memory");
        }
    }
    __syncthreads();
}

__device__ __forceinline__ void transpose_item(const float* __restrict__ W, int K, int N, bf16* __restrict__ WT, int k0, int n0, int drow0, LAS float* scr, int lane, const float* __restrict__ gk = nullptr) {
    const int kk0 = lane >> 4, nq = lane & 15;
#pragma unroll
    for (int half = 0; half < 2; ++half) {
        f32x4 v[8];
#pragma unroll
        for (int i = 0; i < 8; ++i) v[i] = *(const f32x4*)(W + (size_t)(k0 + (half * 8 + i) * 4 + kk0) * N + n0 + 4 * nq);
#pragma unroll
        for (int i = 0; i < 8; ++i) { LAS float* s = scr + ((half * 8 + i) * 4 + kk0) * 65 + 4 * nq; const float gs = gk ? gk[k0 + (half * 8 + i) * 4 + kk0] : 1.0f; s[0] = v[i].x * gs; s[1] = v[i].y * gs; s[2] = v[i].z * gs; s[3] = v[i].w * gs; }
    }
    LDS_WAIT(); asm volatile("" ::: "memory");
    const int c = lane & 7;
#pragma unroll
    for (int j = 0; j < 8; ++j) { const int n = (lane >> 3) + 8 * j; const LAS float* s = scr + (8 * c) * 65 + n;
        u32x4 o; o.x = pk2(s[0 * 65], s[1 * 65]); o.y = pk2(s[2 * 65], s[3 * 65]); o.z = pk2(s[4 * 65], s[5 * 65]); o.w = pk2(s[6 * 65], s[7 * 65]);
        *(u32x4*)(WT + (size_t)(drow0 + n) * K + k0 + 8 * c) = o; }
    LDS_WAIT(); asm volatile("" ::: "memory");
}
template <bool COPY> __device__ __forceinline__ void rms_row(const float* __restrict__ src, const float* __restrict__ g, bf16* __restrict__ dst, float* __restrict__ cp, int lane) {
    const f32x4* s4 = (const f32x4*)src + lane; f32x4 v[16]; float ss = 0.f;
#pragma unroll
    for (int j = 0; j < 16; ++j) { v[j] = s4[64 * j]; ss += (v[j].x * v[j].x + v[j].y * v[j].y) + (v[j].z * v[j].z + v[j].w * v[j].w); }
    if (COPY) {
#pragma unroll
        for (int j = 0; j < 16; ++j) ((f32x4*)cp + lane)[64 * j] = v[j]; }
    ss = wave_sum(ss); const float rstd = 1.0f / sqrtf(ss * (1.0f / DM) + EPS);
    const f32x4* g4 = (const f32x4*)g + lane; u32x2* d2 = (u32x2*)dst + lane;
#pragma unroll
    for (int j = 0; j < 16; ++j) { const f32x4 gv = g4[64 * j]; u32x2 o; o.x = pk2(v[j].x * rstd * gv.x, v[j].y * rstd * gv.y); o.y = pk2(v[j].z * rstd * gv.z, v[j].w * rstd * gv.w); d2[64 * j] = o; }
}
__device__ __forceinline__ void rms_row_bf(const bf16* __restrict__ src, const float* __restrict__ g, bf16* __restrict__ dst, int lane) {
    const u32x4* s4 = (const u32x4*)src + lane; u32x4 v[8]; float ss = 0.f;
#pragma unroll
    for (int j = 0; j < 8; ++j) { v[j] = s4[64 * j];
#pragma unroll
        for (int q = 0; q < 4; ++q) { const float a = bflo(v[j][q]), b = bfhi(v[j][q]); ss += a * a + b * b; } }
    ss = wave_sum(ss); const float rstd = 1.0f / sqrtf(ss * (1.0f / DM) + EPS);
    u32x4* d4 = (u32x4*)dst + lane;
#pragma unroll
    for (int j = 0; j < 8; ++j) { const f32x4 g0 = *(const f32x4*)(g + 8 * (lane + 64 * j)), g1 = *(const f32x4*)(g + 8 * (lane + 64 * j) + 4); u32x4 o;
        o.x = pk2(bflo(v[j].x) * rstd * g0.x, bfhi(v[j].x) * rstd * g0.y); o.y = pk2(bflo(v[j].y) * rstd * g0.z, bfhi(v[j].y) * rstd * g0.w);
        o.z = pk2(bflo(v[j].z) * rstd * g1.x, bfhi(v[j].z) * rstd * g1.y); o.w = pk2(bflo(v[j].w) * rstd * g1.z, bfhi(v[j].w) * rstd * g1.w); d4[64 * j] = o; }
}
__device__ __forceinline__ void zero_row(bf16* dst, float* cp, int lane) {
    u32x2* d2 = (u32x2*)dst + lane;
#pragma unroll
    for (int j = 0; j < 16; ++j) { d2[64 * j] = (u32x2){0u, 0u}; if (cp) ((f32x4*)cp + lane)[64 * j] = (f32x4){0.f, 0.f, 0.f, 0.f}; }
}

struct Ptrs {
    const float *x, *meta, *g_mix, *g_mlp, *wqkv, *qg, *kg, *lamv, *sg, *wo, *a_re, *a_im, *log_dt, *b_re, *b_im, *c_re, *c_im, *dsk, *wglu, *bglu, *wup, *wdn;
    float* out; unsigned char* ws;
};

__device__ __forceinline__ void p0_prologue(const Ptrs& P, LAS unsigned char* lds, int gw, int NGW, int wave, int lane) {
    LAS float* scr = (LAS float*)(lds + wave * 16640);
    bf16* Wqkv_t = (bf16*)(P.ws + WS_WQKV); bf16* Wo_t = (bf16*)(P.ws + WS_WO); bf16* Wglu_t = (bf16*)(P.ws + WS_WGLU); bf16* Wup_t = (bf16*)(P.ws + WS_WUP); bf16* Wdn_t = (bf16*)(P.ws + WS_WDN);
    constexpr int I_QKV = 64 * 192, I_O = 64 * 64, I_GLU = 64 * 128, I_UP = 64 * 256, I_DN = 256 * 64;
    constexpr int NITEMS = I_QKV + I_O + I_GLU + 2 * I_UP + 2 * I_DN;
    for (int it = gw; it < NITEMS; it += NGW) {
        int r = it;
        if (r < I_QKV) { const int kb = r / 192, nb = r % 192; transpose_item(P.wqkv, DM, 3 * DM, Wqkv_t, 64 * kb, 64 * nb, 64 * nb, scr, lane); continue; } r -= I_QKV;
        if (r < I_O) { const int kb = r / 64, nb = r % 64; transpose_item(P.wo, DM, DM, Wo_t, 64 * kb, 64 * nb, 64 * nb, scr, lane); continue; } r -= I_O;
        if (r < I_GLU) { const int kb = r / 128, nb = r % 128, n0 = 64 * nb, hf = n0 / DM, f0 = n0 % DM; transpose_item(P.wglu, DM, 2 * DM, Wglu_t, 64 * kb, n0, 256 * (f0 / 128) + 128 * hf + (f0 % 128), scr, lane); continue; } r -= I_GLU;
        if (r < 2 * I_UP) { const int l = r / I_UP; r -= l * I_UP; const int kb = r / 256, nb = r % 256; transpose_item(P.wup + (size_t)l * DM * FF, DM, FF, Wup_t + (size_t)l * DM * FF, 64 * kb, 64 * nb, 64 * nb, scr, lane, P.g_mlp + (size_t)l * DM); continue; } r -= 2 * I_UP;
        { const int l = r / I_DN; r -= l * I_DN; const int kb = r / 64, nb = r % 64; transpose_item(P.wdn + (size_t)l * DM * FF, FF, DM, Wdn_t + (size_t)l * DM * FF, 64 * kb, 64 * nb, 64 * nb, scr, lane); }
    }
    bf16* H = (bf16*)(P.ws + WS_H); bf16* HN = (bf16*)(P.ws + WS_HN);
    for (int m = gw; m < MP; m += NGW) {
        if (m < MX) rms_row<false>(P.x + (size_t)m * DM, P.g_mix, HN + (size_t)m * DM, nullptr, lane);
        else if (m < MX + NMETA) { rms_row<false>(P.meta + (size_t)(m - MX) * DM, P.g_mix, HN + (size_t)m * DM, nullptr, lane);
            const f32x4* ms = (const f32x4*)(P.meta + (size_t)(m - MX) * DM) + lane; u32x2* hd = (u32x2*)(H + (size_t)m * DM) + lane;
            for (int j = 0; j < 16; ++j) { const f32x4 t4 = ms[64 * j]; hd[64 * j] = (u32x2){pk2(t4.x, t4.y), pk2(t4.z, t4.w)}; } }
        else zero_row(HN + (size_t)m * DM, nullptr, lane);
    }
    for (int it = gw; it < 3 * 64 * (SKVP - LPOS); it += NGW) { const int t = it / (64 * (SKVP - LPOS)), r2 = it % (64 * (SKVP - LPOS)), bh = r2 / (SKVP - LPOS), pp = LPOS + r2 % (SKVP - LPOS);
        bf16* base = (bf16*)(P.ws + WS_Q + (size_t)t * QKV_T_BYTES) + ((size_t)bh * SKVP + pp) * DH; ((unsigned*)base)[lane] = 0u; }
}

template <class Epi> __device__ __forceinline__ void skinny16(LAS unsigned char* lds, const bf16* __restrict__ A  , const bf16* __restrict__ Bt  , int ld, int N, int kparts, int vcu, int G, int tid, const Epi& E) {
    const int wave = __builtin_amdgcn_readfirstlane(tid >> 6), lane = tid & 63, fr = lane & 15, fq = lane >> 4;
    const int kpart = vcu % kparts, slot = vcu / kparts, nslots = G / kparts;
    LAS f32x4* red = (LAS f32x4*)lds;
    const bf16* ap = A + (size_t)fr * ld + kpart * 4096 + wave * 512 + 16 * fq;
    bf16x8 a[16];
#pragma unroll
    for (int i = 0; i < 8; ++i) { a[2 * i] = *(const bf16x8*)(ap + 64 * i); a[2 * i + 1] = *(const bf16x8*)(ap + 64 * i + 8); }
    for (int task = slot; task < (N >> 4); task += nslots) {
        const int n0 = task * 16;
        const bf16* bp = Bt + (size_t)(n0 + fr) * ld + kpart * 4096 + wave * 512 + 16 * fq;
        bf16x8 b[16];
#pragma unroll
        for (int i = 0; i < 8; ++i) { b[2 * i] = *(const bf16x8*)(bp + 64 * i); b[2 * i + 1] = *(const bf16x8*)(bp + 64 * i + 8); }
        f32x4 acc = (f32x4){0.f, 0.f, 0.f, 0.f};
#pragma unroll
        for (int i = 0; i < 16; ++i) acc = __builtin_amdgcn_mfma_f32_16x16x32_bf16(b[i], a[i], acc, 0, 0, 0);
        __syncthreads();
        red[wave * 64 + lane] = acc;
        __syncthreads();
        if (wave == 0) { f32x4 s = red[lane];
#pragma unroll
            for (int w = 1; w < 8; ++w) s += red[w * 64 + lane];
            E(s, n0 + 4 * fq, fr, kpart); }
    }
    __syncthreads();
}
struct SkQKV { bf16* Q; __device__ __forceinline__ void operator()(f32x4 v, int n, int row, int) const {
    const int sec = n / DM, hid = (n % DM) / DH, d = n % DH; bf16* dst = Q + (size_t)sec * (QKV_T_BYTES / 2) + ((size_t)hid * SKVP + row) * DH + d;
    const u32x2 w = (u32x2){pk2(v.x, v.y), pk2(v.z, v.w)}; *(u32x2*)dst = w; *(u32x2*)(dst + (size_t)NSH * SKVP * DH) = w; } };
struct SkRes { bf16* H; __device__ __forceinline__ void operator()(f32x4 v, int n, int row, int) const { u32x2* p = (u32x2*)(H + (size_t)(MX + row) * DM + n); const u32x2 w = *p;
    *p = (u32x2){pk2(bflo(w.x) + v.x, bfhi(w.x) + v.y), pk2(bflo(w.y) + v.z, bfhi(w.y) + v.w)}; } };
struct SkPart { float* part; __device__ __forceinline__ void operator()(f32x4 v, int n, int row, int kpart) const { *(f32x4*)(part + ((size_t)kpart * NMETA + row) * DM + n) = v; } };
struct SkRelu2 { bf16* MID; const float* rstd; __device__ __forceinline__ void operator()(f32x4 v, int n, int row, int) const { const float rs = rstd[MX + row], q = rs * rs;
    const float a = fmaxf(v.x, 0.f), b = fmaxf(v.y, 0.f), c = fmaxf(v.z, 0.f), d = fmaxf(v.w, 0.f); *(u32x2*)(MID + (size_t)(MX + row) * FF + n) = (u32x2){pk2(a * a * q, b * b * q), pk2(c * c * q, d * d * q)}; } };

__device__ __forceinline__ void norm_phase(const bf16* H, const float* g, bf16* HN, int nrows, int gw, int NGW, int lane) {
    for (int m = gw; m < nrows; m += NGW) rms_row_bf(H + (size_t)m * DM, g, HN + (size_t)m * DM, lane);
}

__device__ __forceinline__ void rstd_phase(const float* part, int npart  , float* rstd, const bf16* H, bool with_meta, int gw, int NGW, int lane) {
    for (int m = gw; m < MX; m += NGW) { const float* pr = part + (size_t)m * 128; float s = pr[lane]; if (npart > 64) s += pr[64 + lane];
        s = wave_sum(s); if (lane == 0) rstd[m] = 1.0f / sqrtf(s * (1.0f / DM) + EPS); }
    if (with_meta) for (int m = MX + gw; m < MX + NMETA; m += NGW) { const u32x4* s4 = (const u32x4*)(H + (size_t)m * DM) + lane; float ss = 0.f;
#pragma unroll
        for (int j = 0; j < 8; ++j) { const u32x4 v = s4[64 * j];
#pragma unroll
            for (int q = 0; q < 4; ++q) { const float a = bflo(v[q]), b = bfhi(v[q]); ss += a * a + b * b; } }
        ss = wave_sum(ss); if (lane == 0) rstd[m] = 1.0f / sqrtf(ss * (1.0f / DM) + EPS); }
}
__device__ __forceinline__ void qk_rope_phase(bf16* Q, bf16* K, const float* qg, const float* kg, int gw, int NGW, int lane) {
    const int j16 = lane & 15, rr = lane >> 4;
    float inv[4];
#pragma unroll
    for (int t = 0; t < 4; ++t) inv[t] = exp2f(-(float)(2 * (4 * j16 + t)) * (13.287712379549449f / 128.0f));
    for (int item = gw; item < NB * LPOS; item += NGW) {
        const int b = item / LPOS, p = item % LPOS;
        float cs[4], sn[4];
#pragma unroll
        for (int t = 0; t < 4; ++t) { const float ang = (float)p * inv[t]; cs[t] = cosf(ang); sn[t] = sinf(ang); }
#pragma unroll 1
        for (int ten = 0; ten < 2; ++ten) {
            bf16* T = ten ? K : Q; const float* g = ten ? kg : qg;
            const f32x4 g1 = *(const f32x4*)(g + 4 * j16), g2 = *(const f32x4*)(g + 64 + 4 * j16);
            bf16* row0 = T + ((size_t)(b * NSH + rr) * SKVP + p) * DH;
            u32x2 a[8], c[8];
#pragma unroll
            for (int ps = 0; ps < 8; ++ps) { const bf16* row = row0 + (size_t)(4 * ps) * SKVP * DH; a[ps] = *(const u32x2*)(row + 4 * j16); c[ps] = *(const u32x2*)(row + 64 + 4 * j16); }
#pragma unroll
            for (int ps = 0; ps < 8; ++ps) {
                bf16* row = row0 + (size_t)(4 * ps) * SKVP * DH;
                float x1[4] = {bflo(a[ps].x), bfhi(a[ps].x), bflo(a[ps].y), bfhi(a[ps].y)}, x2[4] = {bflo(c[ps].x), bfhi(c[ps].x), bflo(c[ps].y), bfhi(c[ps].y)};
                float ss = 0.f;
#pragma unroll
                for (int t = 0; t < 4; ++t) ss += x1[t] * x1[t] + x2[t] * x2[t];
                ss += __shfl_xor(ss, 1); ss += __shfl_xor(ss, 2); ss += __shfl_xor(ss, 4); ss += __shfl_xor(ss, 8);
                const float rstd = 1.0f / sqrtf(ss * (1.0f / DH) + EPS);
                float o1[4], o2[4];
#pragma unroll
                for (int t = 0; t < 4; ++t) { const float y1 = x1[t] * rstd * g1[t], y2 = x2[t] * rstd * g2[t]; o1[t] = y1 * cs[t] - y2 * sn[t]; o2[t] = y2 * cs[t] + y1 * sn[t]; }
                *(u32x2*)(row + 4 * j16) = (u32x2){pk2(o1[0], o1[1]), pk2(o1[2], o1[3])};
                *(u32x2*)(row + 64 + 4 * j16) = (u32x2){pk2(o2[0], o2[1]), pk2(o2[2], o2[3])};
            }
        }
    }
}

typedef ab::BlockRef<ab::bf16, ab::bf16> ARef;
__device__ __forceinline__ ARef attn_ref(int L, int pass, const bf16* Q, const bf16* K, const bf16* V, bf16* O) {
    const int inst = L >> 4, x = L & 15, qb = pass ? 31 - x : x;
    const int b = inst >> 6, h = (inst >> 2) & 15, c = (inst >> 1) & 1, vh = inst & 1;
    ARef r;
    r.Q = Q + ((size_t)(b * NSH + 2 * h + c) * SKVP + NMETA + 256 * qb) * DH;
    r.K = K + (size_t)(b * NSH + 2 * h + c) * SKVP * DH;
    r.V = V + (size_t)(b * NSH + 2 * h + vh) * SKVP * DH;
    r.O = O + ((size_t)inst * SEQ + 256 * qb) * DH;
    r.P0 = NMETA + 256 * qb;
    return r;
}
__device__ __forceinline__ void attn_phase(char* lds, const bf16* Q, const bf16* K, const bf16* V, bf16* O, int vcu, int G) {
    constexpr int TOTAL = 128 * 16, W = 1 << 30;
    int L = vcu; if (L >= TOTAL) return;
    int pass = 0;
    ARef cur = attn_ref(L, 0, Q, K, V, O);
    ab::Seam<ab::bf16> S;
    ab::causal_swa_prime<ab::bf16, ab::bf16>(cur, W, lds, S);
    for (;;) {
        const bool more_pass = pass == 0, more_item = L + G < TOTAL, last = !more_pass && !more_item;
        int passn = pass + 1, Ln = L;
        if (!more_pass) { passn = 0; Ln = more_item ? L + G : L; }
        const ARef nxt = last ? cur : attn_ref(Ln, passn, Q, K, V, O);
        ab::causal_swa_block<ab::bf16, ab::bf16>(cur, nxt, SKVP, W, lds, S);
        if (last) break;
        cur = nxt; pass = passn; L = Ln;
    }
}

__device__ __forceinline__ void combine_phase(const Ptrs& P, int gw, int NGW, int lane) {
    const bf16* Ob = (const bf16*)(P.ws + WS_O); bf16* ATTO = (bf16*)(P.ws + WS_ATTO);
    const bf16* Qb = (const bf16*)(P.ws + WS_Q); const bf16* Kb = (const bf16*)(P.ws + WS_K); const bf16* Vb = (const bf16*)(P.ws + WS_V);
    float lam; { const float s1 = wave_sum(P.lamv[lane] * P.lamv[128 + lane] + P.lamv[64 + lane] * P.lamv[192 + lane]);
                 const float s2 = wave_sum(P.lamv[256 + lane] * P.lamv[384 + lane] + P.lamv[320 + lane] * P.lamv[448 + lane]); lam = expf(s1) - expf(s2) + 0.2f; }
    const f32x4 sgv = *(const f32x4*)(P.sg + 4 * lane);
    const int vh = lane >> 5, d = (lane & 31) * 4;
    for (int r = gw; r < MX; r += NGW) {
        const int b = r >> 13, i = r & (SEQ - 1);
#pragma unroll 4
        for (int h = 0; h < NH; ++h) {
            const int inst0 = ((b * NH + h) * 2 + 0) * 2 + vh;
            const u32x2 a = *(const u32x2*)(Ob + ((size_t)inst0 * SEQ + i) * DH + d), c = *(const u32x2*)(Ob + ((size_t)(inst0 + 2) * SEQ + i) * DH + d);
            float v[4] = {bflo(a.x) - lam * bflo(c.x), bfhi(a.x) - lam * bfhi(c.x), bflo(a.y) - lam * bflo(c.y), bfhi(a.y) - lam * bfhi(c.y)};
            const float ss = wave_sum((v[0] * v[0] + v[1] * v[1]) + (v[2] * v[2] + v[3] * v[3]));
            const float rs = 0.8f / sqrtf(ss * (1.0f / 256.0f) + EPS);
            *(u32x2*)(ATTO + (size_t)r * DM + h * 256 + 4 * lane) = (u32x2){pk2(v[0] * rs * sgv.x, v[1] * rs * sgv.y), pk2(v[2] * rs * sgv.z, v[3] * rs * sgv.w)};
        }
    }
    for (int t = gw; t < NMETA * NH; t += NGW) {
        const int qi = t >> 4, h = t & 15, j = lane & 15, part = lane >> 4;
        float am = 0.f;
#pragma unroll
        for (int c = 0; c < 2; ++c) {
            const bf16* qrow = Qb + ((size_t)(2 * h + c) * SKVP + qi) * DH + part * 32; const bf16* krow = Kb + ((size_t)(2 * h + c) * SKVP + j) * DH + part * 32;
            float s = 0.f;
#pragma unroll
            for (int e = 0; e < 4; ++e) { const u32x4 qv = *(const u32x4*)(qrow + 8 * e), kv = *(const u32x4*)(krow + 8 * e);
                s += bflo(qv.x) * bflo(kv.x) + bfhi(qv.x) * bfhi(kv.x) + bflo(qv.y) * bflo(kv.y) + bfhi(qv.y) * bfhi(kv.y) + bflo(qv.z) * bflo(kv.z) + bfhi(qv.z) * bfhi(kv.z) + bflo(qv.w) * bflo(kv.w) + bfhi(qv.w) * bfhi(kv.w); }
            s += __shfl_xor(s, 16); s += __shfl_xor(s, 32);
            s = (j <= qi) ? s * 0.08838834764831845f : -__builtin_inff();
            float mx = s; mx = fmaxf(mx, __shfl_xor(mx, 1)); mx = fmaxf(mx, __shfl_xor(mx, 2)); mx = fmaxf(mx, __shfl_xor(mx, 4)); mx = fmaxf(mx, __shfl_xor(mx, 8));
            const float e_ = expf(s - mx); float sm = e_; sm += __shfl_xor(sm, 1); sm += __shfl_xor(sm, 2); sm += __shfl_xor(sm, 4); sm += __shfl_xor(sm, 8);
            const float p_ = e_ / sm; am = c == 0 ? p_ : am - lam * p_;
        }
        float o[4] = {0.f, 0.f, 0.f, 0.f};
        for (int jj = 0; jj <= qi; ++jj) { const float aj = __shfl(am, jj); const u32x2 vv = *(const u32x2*)(Vb + ((size_t)(2 * h + vh) * SKVP + jj) * DH + d);
            o[0] += aj * bflo(vv.x); o[1] += aj * bfhi(vv.x); o[2] += aj * bflo(vv.y); o[3] += aj * bfhi(vv.y); }
        const float ss = wave_sum((o[0] * o[0] + o[1] * o[1]) + (o[2] * o[2] + o[3] * o[3]));
        const float rs = 0.8f / sqrtf(ss * (1.0f / 256.0f) + EPS);
        *(u32x2*)(ATTO + (size_t)(MX + qi) * DM + h * 256 + 4 * lane) = (u32x2){pk2(o[0] * rs * sgv.x, o[1] * rs * sgv.y), pk2(o[2] * rs * sgv.z, o[3] * rs * sgv.w)};
    }
    for (int m = MX + NMETA + gw; m < MP; m += NGW) zero_row(ATTO + (size_t)m * DM, nullptr, lane);
}

__device__ __forceinline__ f32x2 cpowf2(float dar, float dai, int tau) { const float m = expf((float)tau * dar), a = (float)tau * dai; return (f32x2){m * cosf(a), m * sinf(a)}; }
template <int CTRL, bool BC> __device__ __forceinline__ float dppf(float x) { return __builtin_bit_cast(float, __builtin_amdgcn_update_dpp(0, __builtin_bit_cast(int, x), CTRL, 0xF, 0xF, BC)); }
__device__ __forceinline__ f32x4 cmul_add2(f32x4 w, f32x4 v, f32x4 acc) {
    acc.x += w.x * v.x - w.y * v.y; acc.y += w.x * v.y + w.y * v.x; acc.z += w.z * v.z - w.w * v.w; acc.w += w.z * v.w + w.w * v.z; return acc; }
template <int CTRL, bool BC> __device__ __forceinline__ f32x4 dpp4(f32x4 v) { return (f32x4){dppf<CTRL, BC>(v.x), dppf<CTRL, BC>(v.y), dppf<CTRL, BC>(v.z), dppf<CTRL, BC>(v.w)}; }

__device__ __forceinline__ void s5_load_u(bf16x8 (&uf)[8], const bf16* rowbase  , int fq) {
#pragma unroll
    for (int kt = 0; kt < 8; ++kt) uf[kt] = *(const bf16x8*)(rowbase + (size_t)(2 * kt + (fq >> 1)) * DM + 8 * (fq & 1));
}
__device__ __forceinline__ void s5_bmat(f32x4 (&Lc)[8], const bf16x8 (&uf)[8], LAS unsigned char* bfr  ) {
#pragma unroll
    for (int mt = 0; mt < 8; ++mt) Lc[mt] = (f32x4){0.f, 0.f, 0.f, 0.f};
#pragma unroll
    for (int ks = 0; ks < 8; ++ks) { asm volatile("" ::: "memory");
#pragma unroll
        for (int mt = 0; mt < 8; ++mt) Lc[mt] = __builtin_amdgcn_mfma_f32_16x16x32_bf16(*(const LAS bf16x8*)(bfr + (mt * 8 + ks) * 1024), uf[ks], Lc[mt], 0, 0, 0); }
}
__device__ __forceinline__ void s5_scan(f32x4 (&Lc)[8], const LAS f32x4* wp  ) {
    asm volatile("" ::: "memory");
#pragma unroll
    for (int mt = 0; mt < 8; ++mt) { Lc[mt] = cmul_add2(wp[0 * 32 + mt * 4], dpp4<0x111, true>(Lc[mt]), Lc[mt]); }
    asm volatile("" ::: "memory");
#pragma unroll
    for (int mt = 0; mt < 8; ++mt) { Lc[mt] = cmul_add2(wp[1 * 32 + mt * 4], dpp4<0x112, true>(Lc[mt]), Lc[mt]); }
    asm volatile("" ::: "memory");
#pragma unroll
    for (int mt = 0; mt < 8; ++mt) { Lc[mt] = cmul_add2(wp[2 * 32 + mt * 4], dpp4<0x114, true>(Lc[mt]), Lc[mt]); }
    asm volatile("" ::: "memory");
#pragma unroll
    for (int mt = 0; mt < 8; ++mt) { Lc[mt] = cmul_add2(wp[3 * 32 + mt * 4], dpp4<0x118, true>(Lc[mt]), Lc[mt]); }
}

__device__ __forceinline__ void dbg4(float* dbg, int comp0, int fr, f32x4 v, bool dd) { if (dd) { float* p = dbg; asm volatile("" : "+v"(p)); p += comp0 * 16 + fr; p[0] = v.x; p[16] = v.y; p[32] = v.z; p[48] = v.w; } }
template <int DUMP> __device__ __forceinline__ void s5_tile(unsigned char* ws, const bf16* HN, bf16* Z, int b, int tl, int g, int fr, int fq, f32x4 (&carry)[8],
        LAS unsigned char* bfr, LAS unsigned char* cfr, LAS unsigned char* ktb, const LAS f32x4* wp, const LAS f32x4* cpw, const LAS f32x4* a256) {
                bf16x8 uf[8]; f32x4 Lc[8];
                const size_t row0 = (size_t)b * SEQ + (size_t)(16 * tl + fr) * 16;
                s5_load_u(uf, HN + row0 * DM + g * SGS, fq); s5_bmat(Lc, uf, bfr);
#if defined(CHK) && CHK
                float* dbg = (float*)(ws + WS_END + 8 * MiB); constexpr int dm = DUMP; const bool dd = (g == 37 && b == 0 && tl == 5);
                if constexpr ((dm & 1) != 0) {
_Pragma("unroll") for (int mt = 0; mt < 8; ++mt) dbg4(dbg, 0 * 128 + 16 * mt + 4 * fq, fr, Lc[mt], dd); }
#endif
                s5_scan(Lc, wp);
#if defined(CHK) && CHK
                if constexpr ((dm & 2) != 0) {
_Pragma("unroll") for (int mt = 0; mt < 8; ++mt) { dbg4(dbg, 1 * 128 + 16 * mt + 4 * fq, fr, Lc[mt], dd); dbg4(dbg, 3 * 128 + 16 * mt + 4 * fq, fr, carry[mt], dd); } }
#endif
                bf16x8 sf[4]; asm volatile("" ::: "memory");
#pragma unroll
                for (int ks = 0; ks < 4; ++ks) { f32x4 s0 = cmul_add2(cpw[(2 * ks) * 4], carry[2 * ks], dpp4<0x111, true>(Lc[2 * ks])), s1 = cmul_add2(cpw[(2 * ks + 1) * 4], carry[2 * ks + 1], dpp4<0x111, true>(Lc[2 * ks + 1]));
                    const u32x4 w = (u32x4){pk2(s0.x, s0.y), pk2(s0.z, s0.w), pk2(s1.x, s1.y), pk2(s1.z, s1.w)}; sf[ks] = __builtin_bit_cast(bf16x8, w);
#if defined(CHK) && CHK
                    if constexpr ((dm & 4) != 0) {
#if CHK_ALT == 1
                        const f32x4 d0 = dpp4<0x111, true>(Lc[2 * ks]), d1 = dpp4<0x111, true>(Lc[2 * ks + 1]);
#elif CHK_ALT == 2
                        const f32x4 d0 = s0 - dpp4<0x111, true>(Lc[2 * ks]), d1 = s1 - dpp4<0x111, true>(Lc[2 * ks + 1]);
#elif CHK_ALT == 3
                        const f32x4 d0 = carry[2 * ks], d1 = carry[2 * ks + 1];
#else
                        const f32x4 d0 = s0, d1 = s1;
#endif
                        dbg4(dbg, 2 * 128 + 16 * (2 * ks) + 4 * fq, fr, d0, dd); dbg4(dbg, 2 * 128 + 16 * (2 * ks + 1) + 4 * fq, fr, d1, dd); }
#endif
                }
                asm volatile("" ::: "memory");
#pragma unroll
                for (int mt = 0; mt < 8; ++mt) carry[mt] = cmul_add2(a256[mt * 4], carry[mt], dpp4<0x15F, false>(Lc[mt]));
                bf16* zrow = Z + row0 * DM + g * SGS + 4 * fq;
#pragma unroll
                for (int hf = 0; hf < 2; ++hf) {
                    f32x4 Y[8];
#pragma unroll
                    for (int m8 = 0; m8 < 8; ++m8) Y[m8] = (f32x4){0.f, 0.f, 0.f, 0.f};
#pragma unroll
                    for (int ks = 0; ks < 4; ++ks) { asm volatile("" ::: "memory");
#pragma unroll
                        for (int m8 = 0; m8 < 8; ++m8) Y[m8] = __builtin_amdgcn_mfma_f32_16x16x32_bf16(*(const LAS bf16x8*)(cfr + ((8 * hf + m8) * 4 + ks) * 1024), sf[ks], Y[m8], 0, 0, 0); }
#if defined(CHK) && CHK
                    if constexpr ((dm & 8) != 0) {
_Pragma("unroll") for (int m8 = 0; m8 < 8; ++m8) dbg4(dbg, 4 * 128 + 16 * (8 * hf + m8) + 4 * fq, fr, Y[m8], dd); }
#endif
#pragma unroll
                    for (int kt = 0; kt < 4 * hf + 4; ++kt) { asm volatile("" ::: "memory");
#pragma unroll
                        for (int m8 = 0; m8 < 8; ++m8) { const int mt = 8 * hf + m8; if (mt < 2 * kt) continue;
                            bf16x8 a = *(const LAS bf16x8*)(ktb + (mt - 2 * kt) * 512);
                            if (mt == 2 * kt && fq >= 2) a = (bf16x8){0, 0, 0, 0, 0, 0, 0, 0};
                            Y[m8] = __builtin_amdgcn_mfma_f32_16x16x32_bf16(a, uf[kt], Y[m8], 0, 0, 0); } }
#if defined(CHK) && CHK
                    if constexpr ((dm & 16) != 0) {
_Pragma("unroll") for (int m8 = 0; m8 < 8; ++m8) dbg4(dbg, 6 * 128 + 16 * (8 * hf + m8) + 4 * fq, fr, Y[m8], dd); }
#endif
#pragma unroll
                    for (int m8 = 0; m8 < 8; ++m8) { float o[4];
#pragma unroll
                        for (int i = 0; i < 4; ++i) { const float y = Y[m8][i]; o[i] = y * __builtin_amdgcn_rcpf(1.0f + __builtin_amdgcn_exp2f(-2.3022082f * (y + 0.044715f * y * y * y))); }
                        *(u32x2*)(zrow + (size_t)(8 * hf + m8) * DM) = (u32x2){pk2(o[0], o[1]), pk2(o[2], o[3])}; }
                }
}
template <int DMASK> __device__ __forceinline__ void s5_phase(const Ptrs& P, LAS unsigned char* lds, int vcu, int G, int tid, bool tables_only = false) {
    const int wave = __builtin_amdgcn_readfirstlane(tid >> 6), lane = tid & 63, fr = lane & 15, fq = lane >> 4;
    const bf16* HN = (const bf16*)(P.ws + WS_HN); bf16* Z = (bf16*)(P.ws + WS_ATTO);
    for (int g = vcu; g < SG; g += G) {
        __syncthreads();
        const float dt = expf(P.log_dt[g]);
        LAS f32x2* Apow = (LAS f32x2*)(lds + S5_F);
        LAS f32x2* Bbar = (LAS f32x2*)(lds + S5_CFRAG);
        for (int e = tid; e < 17 * 64; e += 512) { const int tau = e >> 6, p = e & 63; Apow[e] = cpowf2(dt * P.a_re[g * SP + p], dt * P.a_im[g * SP + p], tau); }
        for (int e = tid; e < SP * SGS; e += 512) { const int p = e >> 4;
            const float ar = P.a_re[g * SP + p], ai = P.a_im[g * SP + p]; const f32x2 ab_ = cpowf2(dt * ar, dt * ai, 1);
            const float nr = ab_.x - 1.0f, ni = ab_.y, den = ar * ar + ai * ai, fre = (nr * ar + ni * ai) / den, fim = (ni * ar - nr * ai) / den;
            const float br = P.b_re[(size_t)g * SP * SGS + e], bi = P.b_im[(size_t)g * SP * SGS + e];
            Bbar[e] = (f32x2){fre * br - fim * bi, fre * bi + fim * br}; }
        __syncthreads();
        for (int f = tid; f < 4096; f += 512) {
            const int l2 = f & 63, ks = (f >> 6) & 7, mt = f >> 9, comp = 16 * mt + (l2 & 15), p = comp >> 1, ri = comp & 1; float v[8];
#pragma unroll
            for (int j = 0; j < 8; ++j) { const int k = 32 * ks + 8 * (l2 >> 4) + j, s = k >> 4, hh = k & 15; const f32x2 pw = Apow[(15 - s) * 64 + p], bb = Bbar[p * 16 + hh];
                v[j] = ri ? (pw.x * bb.y + pw.y * bb.x) : (pw.x * bb.x - pw.y * bb.y); }
            *(LAS u32x4*)(lds + S5_BFRAG + f * 16) = (u32x4){pk2(v[0], v[1]), pk2(v[2], v[3]), pk2(v[4], v[5]), pk2(v[6], v[7])}; }
        for (int e = tid; e < 4096; e += 512) {
            const int hp = e & 15, h = (e >> 4) & 15, tau = e >> 8; float acc = 0.f;
            const float* cr = P.c_re + ((size_t)g * SGS + h) * SP; const float* ci = P.c_im + ((size_t)g * SGS + h) * SP;
            for (int p = 0; p < SP; ++p) { const f32x2 pw = Apow[tau * 64 + p], bb = Bbar[p * 16 + hp]; const float wr_ = pw.x * bb.x - pw.y * bb.y, wi_ = pw.x * bb.y + pw.y * bb.x; acc += cr[p] * wr_ - ci[p] * wi_; }
            if (tau == 0 && h == hp) acc += P.dsk[g * SGS + h];
            ((LAS bf16*)(lds + S5_KTAB))[e] = (bf16)(pk2(acc, 0.f) & 0xffffu); }
        for (int e = tid; e < 16 * 64 + 4 * 64 + 64 + 64; e += 512) {
            int tau, off; const int p = e & 63;
            if (e < 1024) { tau = 16 * (e >> 6); off = S5_CPOW + e * 8; } else if (e < 1280) { tau = 16 << ((e - 1024) >> 6); off = S5_WPOW + (e - 1024) * 8; }
            else if (e < 1344) { tau = 256; off = S5_A256 + p * 8; } else { tau = 1024; off = S5_A1024 + p * 8; }
            *(LAS f32x2*)(lds + off) = cpowf2(dt * P.a_re[g * SP + p], dt * P.a_im[g * SP + p], tau); }
        __syncthreads();
        for (int f = tid; f < 4096; f += 512) {
            const int l2 = f & 63, ks = (f >> 6) & 3, mt = f >> 8, h = l2 & 15; float v[8];
            const float* cr = P.c_re + ((size_t)g * SGS + h) * SP; const float* ci = P.c_im + ((size_t)g * SGS + h) * SP;
#pragma unroll
            for (int j = 0; j < 8; ++j) { const int comp = 16 * (2 * ks + (j >> 2)) + 4 * (l2 >> 4) + (j & 3), p = comp >> 1, ri = comp & 1; const f32x2 pw = Apow[(mt + 1) * 64 + p];
                v[j] = ri ? (-cr[p] * pw.y - ci[p] * pw.x) : (cr[p] * pw.x - ci[p] * pw.y); }
            *(LAS u32x4*)(lds + S5_CFRAG + f * 16) = (u32x4){pk2(v[0], v[1]), pk2(v[2], v[3]), pk2(v[4], v[5]), pk2(v[6], v[7])}; }
        __syncthreads();
        if (tables_only) continue;
        LAS unsigned char* bfr = lds + S5_BFRAG + lane * 16; LAS unsigned char* cfr = lds + S5_CFRAG + lane * 16;
        LAS unsigned char* ktb = lds + S5_KTAB + ((fr * 16 + 8 * (fq & 1)) * 2) - (fq >> 1) * 512;
        const LAS f32x4* wp = (const LAS f32x4*)(lds + S5_WPOW) + fq;
        const LAS f32x4* cpw = (const LAS f32x4*)(lds + S5_CPOW) + fr * 32 + fq;
        const LAS f32x4* a256 = (const LAS f32x4*)(lds + S5_A256) + fq; const LAS f32x4* a1024 = (const LAS f32x4*)(lds + S5_A1024) + fq;
        LAS f32x4* Fw = (LAS f32x4*)(lds + S5_F); LAS f32x4* Em = (LAS f32x4*)(lds + S5_EMETA);
        bf16x8 uf[8]; f32x4 Lc[8];
        if (wave == 0) {
            s5_load_u(uf, HN + (size_t)MX * DM + g * SGS, fq); s5_bmat(Lc, uf, bfr);
            if (fr == 0) {
#pragma unroll
                for (int mt = 0; mt < 8; ++mt) Em[mt * 4 + fq] = Lc[mt]; }
        }
#pragma unroll 1
        for (int b = 0; b < NB; ++b) {
            f32x4 seg[8];
#pragma unroll
            for (int mt = 0; mt < 8; ++mt) seg[mt] = (f32x4){0.f, 0.f, 0.f, 0.f};
#pragma unroll 1
            for (int tl = 4 * wave; tl < 4 * wave + 4; ++tl) {
                s5_load_u(uf, HN + ((size_t)b * SEQ + (size_t)(16 * tl + fr) * 16) * DM + g * SGS, fq); s5_bmat(Lc, uf, bfr); s5_scan(Lc, wp);
                asm volatile("" ::: "memory");
#pragma unroll
                for (int mt = 0; mt < 8; ++mt) seg[mt] = cmul_add2(a256[mt * 4], seg[mt], dpp4<0x15F, false>(Lc[mt]));
            }
            if (fr == 0) {
#pragma unroll
                for (int mt = 0; mt < 8; ++mt) Fw[(b * 8 + wave) * 32 + mt * 4 + fq] = seg[mt]; }
            __syncthreads();
            f32x4 carry[8];
#pragma unroll
            for (int mt = 0; mt < 8; ++mt) carry[mt] = Em[mt * 4 + fq];
            for (int w2 = 0; w2 < wave; ++w2) {
#pragma unroll
                for (int mt = 0; mt < 8; ++mt) carry[mt] = cmul_add2(a1024[mt * 4], carry[mt], Fw[(b * 8 + w2) * 32 + mt * 4 + fq]); }
#pragma unroll 1
            for (int tl = 4 * wave; tl < 4 * wave + 4; ++tl) {
                                s5_tile<DMASK>(P.ws, HN, Z, b, tl, g, fr, fq, carry, bfr, cfr, ktb, wp, cpw, a256);
            }
        }
    }
}

#ifndef PH_ALL
#define PH_ALL 1
#endif
#ifndef PH_P0
#define PH_P0 PH_ALL
#endif
#ifndef PH_QKV
#define PH_QKV PH_ALL
#endif
#ifndef PH_ROPE
#define PH_ROPE PH_ALL
#endif
#ifndef PH_ATTN
#define PH_ATTN PH_ALL
#endif
#ifndef PH_COMB
#define PH_COMB PH_ALL
#endif
#ifndef PH_WO
#define PH_WO PH_ALL
#endif
#ifndef PH_NORM
#define PH_NORM PH_ALL
#endif
#ifndef PH_UP
#define PH_UP PH_ALL
#endif
#ifndef PH_DN
#define PH_DN PH_ALL
#endif
#ifndef PH_S5
#define PH_S5 PH_ALL
#endif
#ifndef PH_GLU
#define PH_GLU PH_ALL
#endif
struct Args { const float* in[22]; float* out; unsigned char* ws; int ph_lo, ph_hi; };
__device__ __forceinline__ Ptrs load_ptrs() {
    const __attribute__((address_space(4))) Args* ap = (const __attribute__((address_space(4))) Args*)__builtin_amdgcn_kernarg_segment_ptr();
    asm volatile("" : "+s"(ap));
    Ptrs P;
    P.x = ap->in[0]; P.meta = ap->in[1]; P.g_mix = ap->in[2]; P.g_mlp = ap->in[3]; P.wqkv = ap->in[4]; P.qg = ap->in[5]; P.kg = ap->in[6]; P.lamv = ap->in[7]; P.sg = ap->in[8]; P.wo = ap->in[9];
    P.a_re = ap->in[10]; P.a_im = ap->in[11]; P.log_dt = ap->in[12]; P.b_re = ap->in[13]; P.b_im = ap->in[14]; P.c_re = ap->in[15]; P.c_im = ap->in[16]; P.dsk = ap->in[17]; P.wglu = ap->in[18]; P.bglu = ap->in[19];
    P.wup = ap->in[20]; P.wdn = ap->in[21]; P.out = ap->out; P.ws = ap->ws;
    return P;
}
#if defined(HV_DEBUG)
#define HV_DBG(ok) do { if (!(ok) && blockIdx.x == 0 && threadIdx.x == 0) { const unsigned long long t0_ = __builtin_amdgcn_s_memrealtime(); while (__builtin_amdgcn_s_memrealtime() - t0_ < 20000ull) __builtin_amdgcn_s_sleep(8); } } while (0)
#else
#define HV_DBG(ok) do {} while (0)
#endif
#define PHASE_VARS() const Ptrs P = load_ptrs(); int tid = tid_fresh(); const int lane = tid & 63, wave = __builtin_amdgcn_readfirstlane(tid >> 6); \
    const int G = gridDim.x, bx = blockIdx.x, vcu = (G % 8 == 0) ? (bx % 8) * (G / 8) + bx / 8 : bx; const int gw = vcu * 8 + wave, NGW = G * 8; (void)lane; (void)gw; (void)NGW; (void)vcu; \
    int hvcu = vcu; { const volatile LAS unsigned* M_ = (const volatile LAS unsigned*)(lds + MISC_OFF); bool ok_ = (G == 256); const unsigned* xr_ = (const unsigned*)(P.ws + WS_CTL) + CW_XRANK; \
      for (int j_ = 0; j_ < 8; ++j_) ok_ = ok_ && (__hip_atomic_load(xr_ + 64 * j_, __ATOMIC_RELAXED, __HIP_MEMORY_SCOPE_AGENT) == 32u); if (ok_) hvcu = (int)(M_[16] * 32u + M_[17]); hvcu = __builtin_amdgcn_readfirstlane(hvcu); HV_DBG(ok_); } (void)hvcu; const int hbx = (G == 256) ? (hvcu & 31) * 8 + (hvcu >> 5) : bx; (void)hbx; \
    bf16* H = (bf16*)(P.ws + WS_H); bf16* HN = (bf16*)(P.ws + WS_HN); bf16* ATTO = (bf16*)(P.ws + WS_ATTO); bf16* MID = (bf16*)(P.ws + WS_MID); \
    bf16* Qb = (bf16*)(P.ws + WS_Q); bf16* Kb = (bf16*)(P.ws + WS_K); bf16* Vb = (bf16*)(P.ws + WS_V); bf16* Ob = (bf16*)(P.ws + WS_O); \
    const bf16* Wqkv_t = (const bf16*)(P.ws + WS_WQKV); const bf16* Wo_t = (const bf16*)(P.ws + WS_WO); const bf16* Wglu_t = (const bf16*)(P.ws + WS_WGLU); \
    const bf16* Wup_t = (const bf16*)(P.ws + WS_WUP); const bf16* Wdn_t = (const bf16*)(P.ws + WS_WDN); \
    (void)H; (void)HN; (void)ATTO; (void)MID; (void)Qb; (void)Kb; (void)Vb; (void)Ob; (void)Wqkv_t; (void)Wo_t; (void)Wglu_t; (void)Wup_t; (void)Wdn_t;

__global__ void __launch_bounds__(512, 2) fwd_kernel(Args args) {
    extern __shared__ __attribute__((aligned(16))) unsigned char lds_raw[];
    LAS unsigned char* lds = (LAS unsigned char*)lds_raw;
    (void)args;
    int ph_lo_, ph_hi_; { const __attribute__((address_space(4))) Args* ap = (const __attribute__((address_space(4))) Args*)__builtin_amdgcn_kernarg_segment_ptr(); ph_lo_ = ap->ph_lo; ph_hi_ = ap->ph_hi; }
#define RUN(k) (ph_lo_ <= (k) && (k) < ph_hi_)
#if defined(PROBE_W)
#define STAMP(k) do { if (blockIdx.x == 0 && threadIdx.x == 0) { const Ptrs Ps = load_ptrs(); ((volatile unsigned long long*)(Ps.ws + WS_CTL + 65536))[k] = __builtin_amdgcn_s_memrealtime(); } } while (0)
#else
#define STAMP(k) do {} while (0)
#endif
    STAMP(0);
    XcdBarrier bar;
    { PHASE_VARS();
      volatile LAS unsigned* MISC = (volatile LAS unsigned*)(lds + MISC_OFF);
      if (tid < 32) MISC[tid] = 0u;
      __syncthreads();
      bar = xcd_barrier_post((unsigned*)(P.ws + WS_CTL) + CW_BAR, MISC + 8);
      if (tid == 0) { const unsigned xcc = xb_xcc_id() & 7u; MISC[16] = xcc; MISC[17] = __hip_atomic_fetch_add((unsigned*)(P.ws + WS_CTL) + CW_XRANK + 64 * xcc, 1u, __ATOMIC_RELAXED, __HIP_MEMORY_SCOPE_AGENT); }
      __syncthreads(); }

#if PH_P0
    if (RUN(0)) {
    { PHASE_VARS(); p0_prologue(P, lds, gw, NGW, wave, lane); }
    }
#endif
    if (RUN(0) && RUN(1)) xcd_barrier(bar);
    STAMP(1);
#if PH_QKV
    if (RUN(1)) {
    { PHASE_VARS(); pg8::Gemm g{HN, Wqkv_t, MX, 3 * DM, DM}; pg8::StaticOrder S; S.init(MX, 3 * DM, G, hbx); pg8::EpiQKV E{Qb, QKV_T_BYTES / 2};
      pg8::gemm_phase<pg8::EpiQKV, pg8::StaticOrder, true, GEMM_SP2>(lds, g, S, E);
      skinny16(lds, HN + (size_t)MX * DM, Wqkv_t, DM, 3 * DM, 1, vcu, G, tid, SkQKV{Qb}); }
    }
#endif
    if (RUN(1) && RUN(2)) xcd_barrier(bar);
    STAMP(2);
#if PH_ROPE
    if (RUN(2)) {
    { PHASE_VARS(); qk_rope_phase(Qb, Kb, P.qg, P.kg, gw, NGW, lane); }
    }
#endif
    if (RUN(2) && RUN(3)) xcd_barrier(bar);
    STAMP(3);
#if PH_ATTN
    if (RUN(3)) {
    { PHASE_VARS();
      ab::da_phase((char*)lds_raw, Qb, Kb, Vb, Ob, hvcu, G, SKVP, SEQ, NMETA); }
    }
#endif
    if (RUN(3) && RUN(4)) xcd_barrier(bar);
    STAMP(4);
#if PH_COMB
    if (RUN(4)) {
    { PHASE_VARS();
#if defined(DA_TESTRUN)
      ab::da_phase((char*)lds_raw, Qb, Kb, Vb, Ob, hvcu, G, SKVP, SEQ, NMETA, DA_TESTRUN); __syncthreads();
#endif
      combine_phase(P, gw, NGW, lane); }
    }
#endif
    if (RUN(4) && RUN(5)) xcd_barrier(bar);
    STAMP(5);
#if PH_WO
    if (RUN(5)) {
    { PHASE_VARS(); pg8::Gemm g{ATTO, Wo_t, MX, DM, DM}; pg8::StaticOrder S; S.init(MX, DM, G, hbx); pg8::EpiRes<true, false, true> E{P.x, H, (float*)(P.ws + WS_PART)};
      pg8::gemm_phase<pg8::EpiRes<true, false, true>, pg8::StaticOrder, true, GEMM_SP2>(lds, g, S, E);
      skinny16(lds, ATTO + (size_t)MX * DM, Wo_t, DM, DM, 1, vcu, G, tid, SkRes{H}); }
    }
#endif
    if (RUN(5) && RUN(6)) xcd_barrier(bar);
    STAMP(6);
#if PH_NORM
    if (RUN(6)) {
    { PHASE_VARS(); rstd_phase((const float*)(P.ws + WS_PART), 64, (float*)(P.ws + WS_RSTD), H, true, gw, NGW, lane); }
    }
#endif
    if (RUN(6) && RUN(7)) xcd_barrier(bar);
    STAMP(7);
#if PH_UP
    if (RUN(7)) {
    { PHASE_VARS(); pg8::Gemm g{H, Wup_t, MX, FF, DM}; pg8::StaticOrder S; S.init(MX, FF, G, hbx); pg8::EpiRelu2 E{MID, FF, (const float*)(P.ws + WS_RSTD)};
      pg8::gemm_phase<pg8::EpiRelu2, pg8::StaticOrder, true, GEMM_SP2>(lds, g, S, E);
      skinny16(lds, H + (size_t)MX * DM, Wup_t, DM, FF, 1, vcu, G, tid, SkRelu2{MID, (const float*)(P.ws + WS_RSTD)}); }
    }
#endif
    if (RUN(7) && RUN(8)) xcd_barrier(bar);
    STAMP(8);
#if PH_DN
    if (RUN(8)) {
    { PHASE_VARS(); pg8::Gemm g{MID, Wdn_t, MX, DM, FF}; pg8::StaticOrder S; S.init(MX, DM, G, hbx); pg8::EpiRes<false, false> E{H, H, nullptr};
      pg8::gemm_phase<pg8::EpiRes<false, false>, pg8::StaticOrder, true, GEMM_SP2>(lds, g, S, E);
      skinny16(lds, MID + (size_t)MX * FF, Wdn_t, FF, DM, 4, vcu, G, tid, SkPart{(float*)(P.ws + WS_MPART)}); }
    }
#endif
    if (RUN(8) && RUN(9)) xcd_barrier(bar);
    STAMP(9);
#if PH_NORM
    if (RUN(9)) {
    { PHASE_VARS();
      if (gw < NMETA) {
          bf16* hr = H + (size_t)(MX + gw) * DM; const float* pp = (const float*)(P.ws + WS_MPART) + (size_t)gw * DM;
#pragma unroll 4
          for (int j = 0; j < 16; ++j) { const int o = 4 * (lane + 64 * j); const u32x2 w = *(const u32x2*)(hr + o); f32x4 v = (f32x4){bflo(w.x), bfhi(w.x), bflo(w.y), bfhi(w.y)};
              v += *(const f32x4*)(pp + o); v += *(const f32x4*)(pp + (size_t)NMETA * DM + o); v += *(const f32x4*)(pp + (size_t)2 * NMETA * DM + o); v += *(const f32x4*)(pp + (size_t)3 * NMETA * DM + o);
              *(u32x2*)(hr + o) = (u32x2){pk2(v.x, v.y), pk2(v.z, v.w)}; }
          asm volatile("s_waitcnt vmcnt(0)" ::: "memory"); }
      norm_phase(H, P.g_mix + DM, HN, MX + NMETA, gw, NGW, lane); }
    }
#endif
    if (RUN(9) && RUN(10)) xcd_barrier(bar);
    STAMP(10);
#if PH_S5
    if (RUN(10)) {
    { PHASE_VARS();
#if defined(S5_TESTRUN)
      s5_phase<0>(P, lds, vcu, G, tid, true); __syncthreads();
#endif
      s5_phase<0>(P, lds, vcu, G, tid); }
    }
#endif
    if (RUN(10) && RUN(11)) xcd_barrier(bar);
    STAMP(11);
#if PH_GLU
    if (RUN(11)) {
    { PHASE_VARS(); pg8::Gemm g{ATTO, Wglu_t, MX, 2 * DM, DM}; pg8::StaticOrder S; S.init(MX, 2 * DM, G, hbx); pg8::EpiGlu E{H, P.bglu, (float*)(P.ws + WS_PART)};
      pg8::gemm_phase<pg8::EpiGlu, pg8::StaticOrder, true, GEMM_SP2>(lds, g, S, E); }
    }
#endif
    if (RUN(11) && RUN(12)) xcd_barrier(bar);
    STAMP(12);
#if PH_NORM
    if (RUN(12)) {
    { PHASE_VARS(); rstd_phase((const float*)(P.ws + WS_PART), 128, (float*)(P.ws + WS_RSTD), H, false, gw, NGW, lane); }
    }
#endif
    if (RUN(12) && RUN(13)) xcd_barrier(bar);
    STAMP(13);
#if PH_UP
    if (RUN(13)) {
    { PHASE_VARS(); pg8::Gemm g{H, Wup_t + (size_t)DM * FF, MX, FF, DM}; pg8::StaticOrder S; S.init(MX, FF, G, hbx); pg8::EpiRelu2 E{MID, FF, (const float*)(P.ws + WS_RSTD)};
      pg8::gemm_phase<pg8::EpiRelu2, pg8::StaticOrder, true, GEMM_SP2>(lds, g, S, E); }
    }
#endif
    if (RUN(13) && RUN(14)) xcd_barrier(bar);
    STAMP(14);
#if PH_DN
    if (RUN(14)) {
    { PHASE_VARS(); pg8::Gemm g{MID, Wdn_t + (size_t)DM * FF, MX, DM, FF}; pg8::StaticOrder S; S.init(MX, DM, G, hbx); pg8::EpiRes<false, true> E{H, P.out, nullptr};
      pg8::gemm_phase<pg8::EpiRes<false, true>, pg8::StaticOrder, true, GEMM_SP2>(lds, g, S, E); }
    }
#endif
#if defined(PROBE_W)
    STAMP(15);
    if (blockIdx.x == 0 && threadIdx.x == 0) { const Ptrs Ps = load_ptrs(); volatile unsigned long long* st = (volatile unsigned long long*)(Ps.ws + WS_CTL + 65536); const int w[15] = PROBE_W; unsigned long long dur = 0;
#pragma unroll
        for (int k = 0; k < 15; ++k) dur += (unsigned long long)w[k] * (st[k + 1] - st[k]);
        const unsigned long long t0 = __builtin_amdgcn_s_memrealtime(); while (__builtin_amdgcn_s_memrealtime() - t0 < dur) __builtin_amdgcn_s_sleep(8); }
#endif
}

#undef STAMP
#undef RUN
#if defined(CHK) && CHK && defined(CHK_DUMP)
__global__ void __launch_bounds__(512, 2) s5_dbg_kernel(Args args) {
    extern __shared__ __attribute__((aligned(16))) unsigned char lds_raw[];
    LAS unsigned char* lds = (LAS unsigned char*)lds_raw; (void)args;
    PHASE_VARS(); s5_phase<CHK_DUMP>(P, lds, vcu, G, tid);
}
#endif
extern "C" void kernel_launch(void* const* d_in, const int* in_sizes, int n_in, void* d_out, int out_size, void* d_ws, size_t ws_size, hipStream_t stream) {
    static int grid = 0;
    if (grid == 0) {
        if (n_in != 22 || in_sizes[0] != MX * DM || out_size != MX * DM || ws_size < WS_END + 16 * MiB) {
            fprintf(stderr, "kernel_launch: built for 22 inputs, x/out of %d floats, >= %zu bytes of workspace; got n_in %d, in0 %d, out %d, ws %zu; nothing launched\n", MX * DM, (size_t)WS_END, n_in, n_in > 0 ? in_sizes[0] : -1, out_size, ws_size); grid = -1; return; }
        int dev = 0, cus = 0, per_cu = 0;
        if (hipGetDevice(&dev) != hipSuccess || hipDeviceGetAttribute(&cus, hipDeviceAttributeMultiprocessorCount, dev) != hipSuccess) { fprintf(stderr, "kernel_launch: device query failed\n"); grid = -1; return; }
        if (hipFuncSetAttribute((const void*)fwd_kernel, hipFuncAttributeMaxDynamicSharedMemorySize, LDS_BYTES) != hipSuccess) { fprintf(stderr, "kernel_launch: hipFuncSetAttribute(%d B LDS) failed\n", LDS_BYTES); grid = -1; return; }
        if (hipOccupancyMaxActiveBlocksPerMultiprocessor(&per_cu, (const void*)fwd_kernel, 512, LDS_BYTES) != hipSuccess || per_cu < 1)
            fprintf(stderr, "kernel_launch: note: occupancy query reports %d workgroups per CU; launching one per CU anyway (%d B LDS)\n", per_cu, LDS_BYTES);
        (void)hipGetLastError();
        grid = cus;
    }
    if (grid < 0) return;
    if (hipMemsetAsync((char*)d_ws + WS_CTL, 0, CTL_ZERO_BYTES, stream) != hipSuccess) { fprintf(stderr, "kernel_launch: memset failed\n"); return; }
    Args a{};
    for (int i = 0; i < 22; ++i) a.in[i] = (const float*)d_in[i];
    a.out = (float*)d_out; a.ws = (unsigned char*)d_ws;
#if defined(CHK) && CHK
    (void)hipMemsetAsync((char*)d_ws + WS_RES, 0, 1024, stream);
    for (int k = 0; k < 15; ++k) {
        if (k == 8 || k == 11) hipLaunchKernelGGL(chk_snap, dim3(64), dim3(256), 0, stream, (const float*)((char*)d_ws + WS_H), (float*)((char*)d_ws + WS_SNAP));
        a.ph_lo = k; a.ph_hi = k + 1;
        hipLaunchKernelGGL(fwd_kernel, dim3(grid), dim3(512), LDS_BYTES, stream, a);
        if (k == 3) hipLaunchKernelGGL(chk_attn, dim3(48), dim3(128), 0, stream, a);
        else if (k == 10) { hipLaunchKernelGGL(chk_s5, dim3(12), dim3(64), 0, stream, a);
#if defined(CHK_DUMP)
            (void)hipFuncSetAttribute((const void*)s5_dbg_kernel, hipFuncAttributeMaxDynamicSharedMemorySize, LDS_BYTES);
            hipLaunchKernelGGL(s5_dbg_kernel, dim3(grid), dim3(512), LDS_BYTES, stream, a);
            hipLaunchKernelGGL(chk_s5_int, dim3(1), dim3(64), 0, stream, a);
#endif
        }
        else hipLaunchKernelGGL(chk_kernel, dim3(64), dim3(64), 0, stream, a, k);
    }
    hipLaunchKernelGGL(chk_report, dim3(1), dim3(1), 0, stream, a);
#else
    a.ph_lo = 0; a.ph_hi = 15;
    hipLaunchKernelGGL(fwd_kernel, dim3(grid), dim3(512), LDS_BYTES, stream, a);
#endif
    const hipError_t le = hipPeekAtLastError();
    if (le != hipSuccess) fprintf(stderr, "kernel_launch: launch failed: %s\n", hipGetErrorName(le));
}
```

```cpp
#include <hip/hip_runtime.h>
#include <cstdio>
#include <cstdint>
__device__ __forceinline__ int tid_fresh() { int t = threadIdx.x; asm volatile("" : "+v"(t)); return t; }
namespace pg8 {
#define PG8_LAS __attribute__((address_space(3)))
typedef unsigned short bf16_t;
typedef short bf16x8 __attribute__((ext_vector_type(8)));
typedef float f32x4 __attribute__((ext_vector_type(4)));
typedef unsigned u32x4 __attribute__((ext_vector_type(4)));
constexpr int BM = 256, BK = 64, HALF = 128, HTB = HALF * BK * 2  , STAGE_BYTES = 8 * HTB, NXCD = 8, WGM = 8;

__host__ __device__ __forceinline__ int lds_byte(int r, int c) { const int st = (r >> 4) * 2 + (c >> 5), rr = r & 15, cc = c & 31, ob = rr * 64 + cc * 2; return st * 1024 + (ob ^ (((ob >> 9) & 1) << 5)); }
__host__ __device__ __forceinline__ void stage_rc(int b, int& R, int& C) { const int st = b / 1024, sb = b % 1024, swz = sb ^ (((sb >> 9) & 1) << 5); R = (st >> 1) * 16 + swz / 64; C = (st & 1) * 32 + (swz % 64) / 2; }
__host__ __device__ __forceinline__ int perm32(int rho) { const int n = rho >> 4, i = rho & 15; return 8 * (i >> 2) + 4 * n + (i & 3); }

struct Unit { int pm, pn; };
struct Gemm { const bf16_t* A; const bf16_t* Bt; int M, N, K; };

struct StaticOrder {
    int nM, nN, nwg, G, c;
    __host__ __device__ void init(int M, int N, int G_, int c_) { nM = M / BM; nN = N / BM; nwg = nM * nN; G = G_; c = c_; }
    __host__ __device__ bool next(int i, Unit& u) const {
        const long L = (long)i * G + c; if (L >= nwg) return false;
        int wgid = (int)L; { const int q = nwg / NXCD, r = nwg % NXCD, xcd = wgid % NXCD, off = wgid / NXCD; wgid = (xcd < r ? xcd * (q + 1) : r * (q + 1) + (xcd - r) * q) + off; }
        const int nig = WGM * nN, gid = wgid / nig, fm = gid * WGM, gsz = (nM - fm) < WGM ? (nM - fm) : WGM;
        u.pm = fm + ((wgid % nig) % gsz); u.pn = (wgid % nig) / gsz; return true;
    }
    __device__ __forceinline__ void a_ready(const Unit&) const {}
    __device__ __forceinline__ void done(const Unit&) const {}
};
typedef unsigned u32x2v __attribute__((ext_vector_type(2)));
__device__ __forceinline__ unsigned cvt_pk_bf16(float lo, float hi) { unsigned r; asm volatile("v_cvt_pk_bf16_f32 %0, %1, %2" : "=v"(r) : "v"(lo), "v"(hi)); return r; }
constexpr int E_SKVP = 8256, E_NMETA = 16, E_MXP = 64  ;
struct EpiQKV {
    static constexpr bool PERM = true, AFTER_DRAIN = false;
    bf16_t* Q; size_t sec_stride;
    __device__ __forceinline__ void operator()(const f32x4 (&acc)[2][2][4][2], const Unit& u, int wr, int wc, int fr, int fq) const {
        const int sec = u.pn >> 4; bf16_t* base = Q + (size_t)sec * sec_stride;
        const int hid0 = (u.pn & 15) * 2, d0 = wc * 32 + 8 * fq;
        const bool meta = u.pm >= E_MXP; const int b = meta ? 0 : (u.pm >> 5), pos0 = meta ? 0 : E_NMETA + (u.pm & 31) * 256;
#pragma unroll
        for (int ai = 0; ai < 2; ++ai)
#pragma unroll
            for (int m = 0; m < 4; ++m) { const int r = ai * HALF + wr * 64 + m * 16 + fr;
                if (meta && r >= E_NMETA) continue;
#pragma unroll
                for (int bj = 0; bj < 2; ++bj) { const f32x4 v0 = acc[ai][bj][m][0], v1 = acc[ai][bj][m][1];
                    u32x4 w; w.x = cvt_pk_bf16(v0[0], v0[1]); w.y = cvt_pk_bf16(v0[2], v0[3]); w.z = cvt_pk_bf16(v1[0], v1[1]); w.w = cvt_pk_bf16(v1[2], v1[3]);
                    bf16_t* dst = base + ((size_t)(b * 32 + hid0 + bj) * E_SKVP + pos0 + r) * 128 + d0;
                    *(u32x4*)dst = w;
                    if (meta) *(u32x4*)(dst + (size_t)32 * E_SKVP * 128) = w; } }
    }
};
__device__ __forceinline__ f32x4 bf4_to_f32(u32x2v w) { return (f32x4){__builtin_bit_cast(float, w.x << 16), __builtin_bit_cast(float, w.x & 0xffff0000u), __builtin_bit_cast(float, w.y << 16), __builtin_bit_cast(float, w.y & 0xffff0000u)}; }
template <bool BASE_F32, bool OUT_F32, bool STATS = false> struct EpiRes {
    static constexpr bool PERM = false, AFTER_DRAIN = false;
    const void* base; void* out; float* part;
    __device__ __forceinline__ void operator()(const f32x4 (&acc)[2][2][4][2], const Unit& u, int wr, int wc, int fr, int fq) const {
        const int row0 = u.pm * BM + wr * 64 + fr, col0 = u.pn * BM + wc * 32 + 4 * fq;
#pragma unroll
        for (int ai = 0; ai < 2; ++ai)
#pragma unroll
            for (int m = 0; m < 4; ++m) { const size_t off = (size_t)(row0 + ai * HALF + m * 16) * 4096 + col0; float ssq = 0.f;
#pragma unroll
                for (int bj = 0; bj < 2; ++bj)
#pragma unroll
                    for (int n = 0; n < 2; ++n) { const size_t o2 = off + bj * HALF + n * 16;
                        f32x4 bs; if (BASE_F32) bs = *(const f32x4*)((const float*)base + o2); else bs = bf4_to_f32(*(const u32x2v*)((const bf16_t*)base + o2));
                        const f32x4 r = bs + acc[ai][bj][m][n];
                        if (STATS) ssq += (r[0] * r[0] + r[1] * r[1]) + (r[2] * r[2] + r[3] * r[3]);
                        if (OUT_F32) *(f32x4*)((float*)out + o2) = r; else *(u32x2v*)((bf16_t*)out + o2) = (u32x2v){cvt_pk_bf16(r[0], r[1]), cvt_pk_bf16(r[2], r[3])}; }
                if (STATS) { ssq += __shfl_xor(ssq, 16); ssq += __shfl_xor(ssq, 32); if (fq == 0) part[(size_t)(row0 + ai * HALF + m * 16) * 128 + 4 * u.pn + wc] = ssq; }
                if (m & 1) asm volatile("" ::: "memory"); }
    }
};
struct EpiRelu2 {
    static constexpr bool PERM = true, AFTER_DRAIN = false;
    bf16_t* O; int ldc; const float* rstd;
    __device__ __forceinline__ void operator()(const f32x4 (&acc)[2][2][4][2], const Unit& u, int wr, int wc, int fr, int fq) const {
        const int row0 = u.pm * BM + wr * 64 + fr, col0 = u.pn * BM + wc * 32 + 8 * fq;
#pragma unroll
        for (int ai = 0; ai < 2; ++ai)
#pragma unroll
            for (int m = 0; m < 4; ++m) { bf16_t* rowp = O + (size_t)(row0 + ai * HALF + m * 16) * ldc + col0; float rs2 = 1.0f; if (rstd) { const float rs = rstd[row0 + ai * HALF + m * 16]; rs2 = rs * rs; }
#pragma unroll
                for (int bj = 0; bj < 2; ++bj) { f32x4 v0 = acc[ai][bj][m][0], v1 = acc[ai][bj][m][1];
#pragma unroll
                    for (int j = 0; j < 4; ++j) { const float a = fmaxf(v0[j], 0.f), b = fmaxf(v1[j], 0.f); v0[j] = a * a * rs2; v1[j] = b * b * rs2; }
                    u32x4 w; w.x = cvt_pk_bf16(v0[0], v0[1]); w.y = cvt_pk_bf16(v0[2], v0[3]); w.z = cvt_pk_bf16(v1[0], v1[1]); w.w = cvt_pk_bf16(v1[2], v1[3]);
                    *(u32x4*)(rowp + bj * HALF) = w; } }
    }
};
struct EpiGlu {
    static constexpr bool PERM = false, AFTER_DRAIN = false;
    bf16_t* h; const float* bias; float* part;
    __device__ __forceinline__ void operator()(const f32x4 (&acc)[2][2][4][2], const Unit& u, int wr, int wc, int fr, int fq) const {
        const int row0 = u.pm * BM + wr * 64 + fr, f0 = u.pn * HALF + wc * 32 + 4 * fq;
        f32x4 bv[2], bg[2];
#pragma unroll
        for (int n = 0; n < 2; ++n) { bv[n] = *(const f32x4*)(bias + f0 + n * 16); bg[n] = *(const f32x4*)(bias + 4096 + f0 + n * 16); }
#pragma unroll
        for (int ai = 0; ai < 2; ++ai)
#pragma unroll
            for (int m = 0; m < 4; ++m) { bf16_t* rowp = h + (size_t)(row0 + ai * HALF + m * 16) * 4096 + f0;
                float ssq = 0.f;
#pragma unroll
                for (int n = 0; n < 2; ++n) { const f32x4 val = acc[ai][0][m][n] + bv[n], gt = acc[ai][1][m][n] + bg[n]; f32x4 o = bf4_to_f32(*(const u32x2v*)(rowp + n * 16));
#pragma unroll
                    for (int j = 0; j < 4; ++j) o[j] += val[j] * __builtin_amdgcn_rcpf(1.0f + __builtin_amdgcn_exp2f(-1.4426950408889634f * gt[j]));
                    ssq += (o[0] * o[0] + o[1] * o[1]) + (o[2] * o[2] + o[3] * o[3]);
                    *(u32x2v*)(rowp + n * 16) = (u32x2v){cvt_pk_bf16(o[0], o[1]), cvt_pk_bf16(o[2], o[3])}; }
                ssq += __shfl_xor(ssq, 16); ssq += __shfl_xor(ssq, 32); if (fq == 0) part[(size_t)(row0 + ai * HALF + m * 16) * 128 + 4 * u.pn + wc] = ssq;
                if (m & 1) asm volatile("" ::: "memory"); }
    }
};
template <class Epi, class Sched, bool ALIGN_EPI = false, bool SP2 = false>
__device__ __forceinline__ void gemm_phase(PG8_LAS unsigned char* lds, const Gemm g, const Sched& S, const Epi& E) {
    const int tid = tid_fresh(), wid = __builtin_amdgcn_readfirstlane(tid >> 6), lane = tid & 63, wr = wid >> 2, wc = wid & 3, fr = lane & 15, fq = lane >> 4;
    const int K = g.K, nt = K / BK;
    unsigned voffA[2], voffB[2];
#pragma unroll
    for (int i = 0; i < 2; ++i) { int R, C; stage_rc(tid * 16 + i * 8192, R, C); const int Rb = Epi::PERM ? ((R & ~31) + perm32(R & 31)) : R;
        voffA[i] = (unsigned)(R * K + C) * 2u; voffB[i] = (unsigned)(Rb * K + C) * 2u; }
    const size_t kstep = (size_t)(BK * 2);
    const size_t hstep = (size_t)HALF * K * 2;
    const size_t tstep = 2 * hstep;
    const unsigned ldsw = (unsigned)wid * 1024u;
    const int aoff = lds_byte(wr * 64 + fr, fq * 8), boff = lds_byte(wc * 32 + fr, fq * 8);
#define PG8_SA(b, h) (((b) * 2 + (h)) * HTB)
#define PG8_SB(b, h) ((4 + (b) * 2 + (h)) * HTB)
#define PG8_STAGE(bufoff, gbase, voff) do { _Pragma("unroll") for (int _i = 0; _i < 2; ++_i) \
        __builtin_amdgcn_global_load_lds((const unsigned*)((const char*)(gbase) + (voff)[_i]), (PG8_LAS unsigned*)(lds + (bufoff) + ldsw + _i * 8192), 16, 0, 0); } while (0)
#define PG8_LDA(dst, b, h) do { _Pragma("unroll") for (int m = 0; m < 4; ++m) _Pragma("unroll") for (int k = 0; k < 2; ++k) dst[m][k] = *(const PG8_LAS bf16x8*)(lds + PG8_SA(b, h) + aoff + m * 2048 + k * 1024); } while (0)
#define PG8_LDB(dst, b, h) do { _Pragma("unroll") for (int n = 0; n < 2; ++n) _Pragma("unroll") for (int k = 0; k < 2; ++k) dst[n][k] = *(const PG8_LAS bf16x8*)(lds + PG8_SB(b, h) + boff + n * 2048 + k * 1024); } while (0)
#define PG8_MMA(ai, bj, At, Bt) do { __builtin_amdgcn_s_setprio(1); _Pragma("unroll") for (int m = 0; m < 4; ++m) _Pragma("unroll") for (int n = 0; n < 2; ++n) _Pragma("unroll") for (int k = 0; k < 2; ++k) \
        acc[ai][bj][m][n] = __builtin_amdgcn_mfma_f32_16x16x32_bf16(Bt[n][k], At[m][k], acc[ai][bj][m][n], 0, 0, 0); __builtin_amdgcn_s_setprio(0); } while (0)
#define PG8_WAIT_V(n) asm volatile("s_waitcnt vmcnt(" #n ")" ::: "memory")
#define PG8_WAIT_L(n) asm volatile("s_waitcnt lgkmcnt(" #n ")" ::: "memory")
#define PG8_BAR __builtin_amdgcn_s_barrier()
#define PG8_SCHED __builtin_amdgcn_sched_barrier(0)
    Unit cur, nxt; int ui = 0;
    if (!S.next(0, cur)) return;
    f32x4 acc[2][2][4][2];
#pragma unroll
    for (int a = 0; a < 2; ++a)
#pragma unroll
        for (int b = 0; b < 2; ++b)
#pragma unroll
            for (int m = 0; m < 4; ++m)
#pragma unroll
                for (int n = 0; n < 2; ++n) acc[a][b][m][n] = (f32x4){0.f, 0.f, 0.f, 0.f};
    bf16x8 At[4][2], B0[2][2], B1[2][2];
    const char* cA = (const char*)g.A + (size_t)cur.pm * tstep; const char* cB = (const char*)g.Bt + (size_t)cur.pn * tstep;
    S.a_ready(cur);
    if constexpr (SP2) {
        PG8_STAGE(PG8_SB(0, 0), cB, voffB); PG8_STAGE(PG8_SB(0, 1), cB + hstep, voffB); PG8_STAGE(PG8_SA(0, 0), cA, voffA); PG8_STAGE(PG8_SA(0, 1), cA + hstep, voffA);
        if (wr == 1) PG8_BAR;
        PG8_WAIT_V(2); PG8_BAR;
        PG8_STAGE(PG8_SB(1, 0), cB + kstep, voffB); PG8_STAGE(PG8_SA(1, 0), cA + kstep, voffA); PG8_STAGE(PG8_SB(1, 1), cB + hstep + kstep, voffB);
        PG8_WAIT_V(6); PG8_BAR;
    } else {
        PG8_STAGE(PG8_SB(0, 0), cB, voffB); PG8_STAGE(PG8_SA(0, 0), cA, voffA); PG8_STAGE(PG8_SB(0, 1), cB + hstep, voffB); PG8_STAGE(PG8_SA(0, 1), cA + hstep, voffA);
        if (wr == 1) PG8_BAR;
        PG8_WAIT_V(4); PG8_BAR;
        PG8_STAGE(PG8_SB(1, 0), cB + kstep, voffB); PG8_STAGE(PG8_SA(1, 0), cA + kstep, voffA); PG8_STAGE(PG8_SB(1, 1), cB + hstep + kstep, voffB);
        PG8_WAIT_V(6); PG8_BAR;
    }
    for (;;) {
        const bool has_next = S.next(ui + 1, nxt);
        const char* nA = has_next ? (const char*)g.A + (size_t)nxt.pm * tstep : cA; const char* nB = has_next ? (const char*)g.Bt + (size_t)nxt.pn * tstep : cB;
        for (int t = 0; t < nt; t += 2) {
            const bool last = (t == nt - 2);
            const char* a1 = cA + (size_t)(t + 1) * kstep;
            const char* a2 = last ? nA : cA + (size_t)(t + 2) * kstep; const char* b2 = last ? nB : cB + (size_t)(t + 2) * kstep;
            const char* a3 = a2 + kstep; const char* b3 = b2 + kstep;
            if (last && has_next) S.a_ready(nxt);
            if constexpr (SP2) {
            PG8_LDB(B0, 0, 0); PG8_LDB(B1, 0, 1); PG8_SCHED; PG8_LDA(At, 0, 0); PG8_STAGE(PG8_SA(1, 1), a1 + hstep, voffA);
            PG8_WAIT_V(8); PG8_WAIT_L(0); PG8_BAR; PG8_MMA(0, 0, At, B0); PG8_MMA(0, 1, At, B1); PG8_BAR; PG8_SCHED;
            PG8_LDA(At, 0, 1); PG8_STAGE(PG8_SB(0, 0), b2, voffB); PG8_STAGE(PG8_SB(0, 1), b2 + hstep, voffB); PG8_STAGE(PG8_SA(0, 0), a2, voffA);
            PG8_WAIT_V(8); PG8_WAIT_L(0); PG8_BAR; PG8_MMA(1, 0, At, B0); PG8_MMA(1, 1, At, B1); PG8_BAR; PG8_SCHED;
            PG8_LDB(B0, 1, 0); PG8_LDB(B1, 1, 1); PG8_SCHED; PG8_LDA(At, 1, 0); PG8_STAGE(PG8_SA(0, 1), a2 + hstep, voffA);
            PG8_WAIT_V(8); PG8_WAIT_L(0); PG8_BAR; PG8_MMA(0, 0, At, B0); PG8_MMA(0, 1, At, B1); PG8_BAR; PG8_SCHED;
            PG8_LDA(At, 1, 1); PG8_STAGE(PG8_SB(1, 0), b3, voffB); PG8_STAGE(PG8_SB(1, 1), b3 + hstep, voffB); PG8_STAGE(PG8_SA(1, 0), a3, voffA);
            PG8_WAIT_V(8); PG8_WAIT_L(0); PG8_BAR; PG8_MMA(1, 0, At, B0); PG8_MMA(1, 1, At, B1); PG8_BAR; PG8_SCHED;
            } else {
            PG8_LDB(B0, 0, 0); PG8_SCHED; PG8_LDA(At, 0, 0); PG8_STAGE(PG8_SA(1, 1), a1 + hstep, voffA);
            PG8_WAIT_L(8); PG8_BAR; PG8_WAIT_L(0); PG8_MMA(0, 0, At, B0); PG8_BAR; PG8_SCHED;
            PG8_LDB(B1, 0, 1); PG8_STAGE(PG8_SB(0, 0), b2, voffB);
            PG8_BAR; PG8_WAIT_L(0); PG8_MMA(0, 1, At, B1); PG8_BAR;
            PG8_LDA(At, 0, 1); PG8_STAGE(PG8_SA(0, 0), a2, voffA);
            PG8_BAR; PG8_WAIT_L(0); PG8_MMA(1, 0, At, B0); PG8_BAR; PG8_SCHED;
            PG8_STAGE(PG8_SB(0, 1), b2 + hstep, voffB);
            PG8_WAIT_V(6); PG8_BAR; PG8_MMA(1, 1, At, B1); PG8_BAR;
            PG8_LDB(B0, 1, 0); PG8_SCHED; PG8_LDA(At, 1, 0); PG8_STAGE(PG8_SA(0, 1), a2 + hstep, voffA);
            PG8_WAIT_L(8); PG8_BAR; PG8_WAIT_L(0); PG8_MMA(0, 0, At, B0); PG8_BAR; PG8_SCHED;
            PG8_LDB(B1, 1, 1); PG8_STAGE(PG8_SB(1, 0), b3, voffB);
            PG8_BAR; PG8_WAIT_L(0); PG8_MMA(0, 1, At, B1); PG8_BAR;
            PG8_LDA(At, 1, 1); PG8_STAGE(PG8_SA(1, 0), a3, voffA);
            PG8_BAR; PG8_WAIT_L(0); PG8_MMA(1, 0, At, B0); PG8_BAR; PG8_SCHED;
            PG8_STAGE(PG8_SB(1, 1), b3 + hstep, voffB);
            PG8_WAIT_V(6); PG8_BAR; PG8_MMA(1, 1, At, B1); PG8_BAR;
            }
        }
        if constexpr (ALIGN_EPI) { if (wr == 0) PG8_BAR; }
        if constexpr (!Epi::AFTER_DRAIN) { E(acc, cur, wr, wc, fr, fq); S.done(cur); }
        if (!has_next) break;
#pragma unroll
        for (int a = 0; a < 2; ++a)
#pragma unroll
            for (int b = 0; b < 2; ++b)
#pragma unroll
                for (int m = 0; m < 4; ++m)
#pragma unroll
                    for (int n = 0; n < 2; ++n) acc[a][b][m][n] = (f32x4){0.f, 0.f, 0.f, 0.f};
        cur = nxt; cA = nA; cB = nB; ++ui;
        if constexpr (ALIGN_EPI) { if (wr == 1) PG8_BAR; }
    }
    PG8_WAIT_V(0);
    if constexpr (!ALIGN_EPI) { if (wr == 0) PG8_BAR; }
    PG8_BAR;
    if constexpr (Epi::AFTER_DRAIN) { E.fused(acc, cur, wr, wc, fr, fq, lds, wid, lane); S.done(cur); }
#undef PG8_SA
#undef PG8_SB
#undef PG8_STAGE
#undef PG8_LDA
#undef PG8_LDB
#undef PG8_MMA
#undef PG8_WAIT_V
#undef PG8_WAIT_L
#undef PG8_BAR
#undef PG8_SCHED
}
}
namespace ab {
constexpr int D = 128;
constexpr float THR = 8.f;
constexpr bool WSKIP = false;
constexpr float SCALE = 0.08838834764831845f;
constexpr int NW = 8, QBLK = 32, KVBLK = 64, QB = NW * QBLK;
constexpr int SHM_V = KVBLK * D * 2, SHM_K = KVBLK * D * 2;
constexpr int LDS_BYTES = 2 * SHM_V + 2 * SHM_K + NW * 64 * 4;
typedef unsigned short bf16;
typedef short bf16x8 __attribute__((ext_vector_type(8)));
typedef short s16x4 __attribute__((ext_vector_type(4)));
typedef float f32x16 __attribute__((ext_vector_type(16)));
typedef float f32x4 __attribute__((ext_vector_type(4)));
typedef unsigned u32x4 __attribute__((ext_vector_type(4)));
template <class A, class Bt> struct same_t { static constexpr bool v = false; };
template <class A> struct same_t<A, A> { static constexpr bool v = true; };

#define KSWZ(row, colB) ((row) * 256 + ((colB) ^ (((row) & 7) << 4)))
#define SBAR() __builtin_amdgcn_sched_barrier(0)
__device__ __forceinline__ int v_st(int k, int c) { const int kk = (k & ~0xC) | ((k & 4) << 1) | ((k & 8) >> 1); return ((kk >> 3) * 4 + (c >> 5)) * 512 + ((kk & 7) * 32 + (c & 31)) * 2; }
__device__ __forceinline__ int v_rd_base(int lane) { return ((lane & 3) << 3) | (((lane >> 2) & 3) << 6) | (((lane >> 4) & 1) << 5) | (((lane >> 5) & 1) << 8); }
constexpr int v_rd_off(int d0, int ks, int half) { return d0 * 512 + ks * 4096 + half * 2048; }
__device__ __forceinline__ int crow(int r, int hi) { return (r & 3) + 8 * (r >> 2) + 4 * hi; }
__device__ __forceinline__ unsigned cvtpk(float lo, float hi) {
    unsigned r; asm volatile("v_cvt_pk_bf16_f32 %0, %1, %2" : "=v"(r) : "v"(lo), "v"(hi)); return r;
}
__device__ __forceinline__ bf16x8 pack8(f32x4 a, f32x4 b) {
    u32x4 w = {cvtpk(a[0], a[1]), cvtpk(a[2], a[3]), cvtpk(b[0], b[1]), cvtpk(b[2], b[3])};
    return *reinterpret_cast<bf16x8*>(&w);
}
template <class T> __device__ __forceinline__ bf16x8 load8(const T* p) {
    if constexpr (same_t<T, float>::v) { return pack8(*(const f32x4*)p, *(const f32x4*)(p + 4)); }
    else { return *reinterpret_cast<const bf16x8*>(p); }
}
__device__ __forceinline__ void mask_tile(f32x16& p0, f32x16& p1, int dq, unsigned W) {
    const float NEG = -__builtin_inff();
#pragma unroll
    for (int r = 0; r < 16; ++r) {
        const int c = (r & 3) + 8 * (r >> 2);
        if ((unsigned)(dq - c) >= W) p0[r] = NEG;
        if ((unsigned)(dq - c - 32) >= W) p1[r] = NEG;
    }
}
__device__ __forceinline__ void partialSM(f32x16& p0, f32x16& p1, float& m_reg, float& mn, float& alpha) {
    float pmax = p0[0]; for (int r = 1; r < 16; ++r) pmax = fmaxf(pmax, p0[r]); for (int r = 0; r < 16; ++r) pmax = fmaxf(pmax, p1[r]);
    { auto rr = __builtin_amdgcn_permlane32_swap(__float_as_uint(pmax), __float_as_uint(pmax), false, false);
      pmax = fmaxf(__uint_as_float(rr[0]), __uint_as_float(rr[1])); }
    constexpr float C2 = 1.4426950408889634f * SCALE;
    if (__builtin_expect(__all((pmax - m_reg) * SCALE <= THR), 1)) { mn = m_reg; alpha = 1.f; }
    else { mn = fmaxf(m_reg, pmax); alpha = __builtin_amdgcn_exp2f((m_reg - mn) * C2); m_reg = mn; }
    const float mnL = -mn * C2;
    for (int r = 0; r < 16; ++r) p0[r] = fmaf(p0[r], C2, mnL); for (int r = 0; r < 16; ++r) p1[r] = fmaf(p1[r], C2, mnL);
    for (int r = 0; r < 16; ++r) p0[r] = __builtin_amdgcn_exp2f(p0[r]);
}
__device__ __forceinline__ void finishSM(f32x16& p0, f32x16& p1, float alpha, float& l_reg, bf16x8& pa0, bf16x8& pa1, bf16x8& pa2, bf16x8& pa3) {
    for (int r = 0; r < 16; ++r) p1[r] = __builtin_amdgcn_exp2f(p1[r]);
    float ps = 0; for (int r = 0; r < 16; ++r) ps += p0[r]; for (int r = 0; r < 16; ++r) ps += p1[r];
    { auto rr = __builtin_amdgcn_permlane32_swap(__float_as_uint(ps), __float_as_uint(ps), false, false);
      ps = __uint_as_float(rr[0]) + __uint_as_float(rr[1]); }
    l_reg = l_reg * alpha + ps;
#define PK4(P, B_, OUT) do { unsigned a0 = cvtpk(P[B_+0], P[B_+1]), a1 = cvtpk(P[B_+2], P[B_+3]);                          \
        unsigned b0 = cvtpk(P[B_+4], P[B_+5]), b1 = cvtpk(P[B_+6], P[B_+7]);                                             \
        auto r0 = __builtin_amdgcn_permlane32_swap(a0, b0, false, false); auto r1 = __builtin_amdgcn_permlane32_swap(a1, b1, false, false); \
        u32x4 w = {r0[0], r1[0], r0[1], r1[1]}; OUT = *reinterpret_cast<bf16x8*>(&w); } while (0)
    PK4(p0, 0, pa0); PK4(p0, 8, pa1); PK4(p1, 0, pa2); PK4(p1, 8, pa3);
#undef PK4
}
template <int KB, bool SK>
__device__ __forceinline__ void qkt(f32x16& p0, f32x16& p1, const char* K_lds, int r32, int hi, const bf16x8* qr, bool act) {
    if (SK && !act) { const float NEG = -__builtin_inff();
#pragma unroll
        for (int r = 0; r < 16; ++r) { p0[r] = NEG; p1[r] = NEG; } return; }
    p0 = f32x16{}; p1 = f32x16{};
    const char* kb[4];
#pragma unroll
    for (int dd = 0; dd < 4; ++dd) kb[dd] = K_lds + KB * SHM_K + KSWZ(r32, (dd * 16 + hi * 8) * 2);
#pragma unroll
    for (int d0 = 0; d0 < 8; ++d0) { const char* a = kb[d0 & 3] + (d0 >> 2) * 128;
        bf16x8 b0 = *reinterpret_cast<const bf16x8*>(a);
        bf16x8 b1 = *reinterpret_cast<const bf16x8*>(a + 32 * 256);
        p0 = __builtin_amdgcn_mfma_f32_32x32x16_bf16(b0, qr[d0], p0, 0, 0, 0);
        p1 = __builtin_amdgcn_mfma_f32_32x32x16_bf16(b1, qr[d0], p1, 0, 0, 0); }
}
template <int VB, bool SK>
__device__ __forceinline__ void pv_tile(f32x16* o, int vb0, bf16x8 pa0, bf16x8 pa1, bf16x8 pa2, bf16x8 pa3, bool act) {
    if (SK && !act) return;
#define TRRD(dst, off) asm volatile("ds_read_b64_tr_b16 %0, %1 offset:%2" : "=&v"(dst) : "v"(vb0), "i"(off) : "memory")
#define PV_D0(d0) do { s16x4 l0, l1, l2, l3, h0, h1, h2, h3; constexpr int b_ = VB * SHM_V + v_rd_off(d0, 0, 0);     \
        TRRD(l0, b_); TRRD(h0, b_ + 2048); TRRD(l1, b_ + 4096); TRRD(h1, b_ + 6144); TRRD(l2, b_ + 8192); TRRD(h2, b_ + 10240); TRRD(l3, b_ + 12288); TRRD(h3, b_ + 14336); \
        asm volatile("s_waitcnt lgkmcnt(0)" ::: "memory"); SBAR();                 \
        o[d0] = __builtin_amdgcn_mfma_f32_32x32x16_bf16(pa0, (bf16x8){l0[0], l0[1], l0[2], l0[3], h0[0], h0[1], h0[2], h0[3]}, o[d0], 0, 0, 0);   \
        o[d0] = __builtin_amdgcn_mfma_f32_32x32x16_bf16(pa1, (bf16x8){l1[0], l1[1], l1[2], l1[3], h1[0], h1[1], h1[2], h1[3]}, o[d0], 0, 0, 0);   \
        o[d0] = __builtin_amdgcn_mfma_f32_32x32x16_bf16(pa2, (bf16x8){l2[0], l2[1], l2[2], l2[3], h2[0], h2[1], h2[2], h2[3]}, o[d0], 0, 0, 0);   \
        o[d0] = __builtin_amdgcn_mfma_f32_32x32x16_bf16(pa3, (bf16x8){l3[0], l3[1], l3[2], l3[3], h3[0], h3[1], h3[2], h3[3]}, o[d0], 0, 0, 0); } while (0)
    PV_D0(0); PV_D0(1); PV_D0(2); PV_D0(3);
#undef PV_D0
#undef TRRD
}

template <class TIn, class TOut> struct BlockRef { const TIn* Q; const TIn* K; const TIn* V; TOut* O; int P0; };
template <class TIn> struct Seam {
    bf16x8 qr[8];
    bf16x8 st_v0, st_v1, st_k0, st_k1; f32x4 sf0, sf1, sf2, sf3;
    f32x4 tq[16];
};
__device__ __forceinline__ int swa_jlo(int P0, int W) { const int lowk = P0 - W + 1; return lowk > 0 ? lowk / KVBLK : 0; }
#define ROW(p, k0, rr) ((p) + (size_t)((k0) + (rr)) * D + sc)
#define VMW() asm volatile("s_waitcnt vmcnt(0)" ::: "memory")
#define VMWN(n) asm volatile("s_waitcnt vmcnt(%0)" :: "i"(n) : "memory")
#define SLOAD_H(Kp, Vp, k0) do { S.st_v0 = load8<TIn>(ROW(Vp, k0, sr)); S.st_v1 = load8<TIn>(ROW(Vp, k0, 32 + sr));              \
                         S.st_k0 = load8<TIn>(ROW(Kp, k0, sr)); S.st_k1 = load8<TIn>(ROW(Kp, k0, 32 + sr)); } while (0)
#define SWRITE_HK(bf) do { *(bf16x8*)(K_lds + (bf) * SHM_K + kws) = S.st_k0; *(bf16x8*)(K_lds + (bf) * SHM_K + kws + 32 * 256) = S.st_k1; } while (0)
#define SWRITE_HV(bf) do { *(bf16x8*)(V_lds + (bf) * SHM_V + vst0) = S.st_v0; *(bf16x8*)(V_lds + (bf) * SHM_V + vst1) = S.st_v1; } while (0)
#define SWRITE_H(bf) do { SWRITE_HV(bf); SWRITE_HK(bf); } while (0)
#define SLOAD_F(p, k0) do { S.sf0 = *(const f32x4*)ROW(p, k0, sr); S.sf1 = *(const f32x4*)(ROW(p, k0, sr) + 4);                \
                            S.sf2 = *(const f32x4*)ROW(p, k0, 32 + sr); S.sf3 = *(const f32x4*)(ROW(p, k0, 32 + sr) + 4); } while (0)
#define SWRITE_KF(bf) do { *(bf16x8*)(K_lds + (bf) * SHM_K + kws) = pack8(S.sf0, S.sf1); *(bf16x8*)(K_lds + (bf) * SHM_K + kws + 32 * 256) = pack8(S.sf2, S.sf3); } while (0)
#define SWRITE_VF(bf) do { *(bf16x8*)(V_lds + (bf) * SHM_V + vst0) = pack8(S.sf0, S.sf1); *(bf16x8*)(V_lds + (bf) * SHM_V + vst1) = pack8(S.sf2, S.sf3); } while (0)
template <class TIn, class TOut>
__device__ __forceinline__ void causal_swa_prime(const BlockRef<TIn, TOut>& cur, int W, char* lds, Seam<TIn>& S) {
    constexpr bool F32 = same_t<TIn, float>::v;
    const int tid = tid_fresh(), wid = __builtin_amdgcn_readfirstlane(tid >> 6), lane = tid & 63, r32 = lane & 31, hi = lane >> 5;
    const int sr = tid >> 4, sc = (tid & 15) * 8, kws = KSWZ(sr, sc * 2); char* K_lds = lds + 2 * SHM_V;
    const int kb0 = swa_jlo(cur.P0, W) * KVBLK;
    for (int d0 = 0; d0 < 8; ++d0) S.qr[d0] = load8<TIn>(cur.Q + (size_t)(wid * QBLK + r32) * D + d0 * 16 + hi * 8);
    if constexpr (F32) { SLOAD_F((const float*)cur.K, kb0); VMW(); SWRITE_KF(0); SBAR(); SLOAD_F((const float*)cur.V, kb0); }
    else { SLOAD_H(cur.K, cur.V, kb0); VMW(); SWRITE_HK(0); }
    __syncthreads();
}
template <class TIn, class TOut>
__device__ __forceinline__ void causal_swa_block(const BlockRef<TIn, TOut>& cur, const BlockRef<TIn, TOut>& nxt, int skv, int W, char* lds, Seam<TIn>& S) {
    constexpr bool F32 = same_t<TIn, float>::v;
    const int tid = tid_fresh(), wid = __builtin_amdgcn_readfirstlane(tid >> 6), lane = tid & 63, r32 = lane & 31, hi = lane >> 5;
    const int j_lo = swa_jlo(cur.P0, W);
    int j_hi = (cur.P0 + QB - 1) / KVBLK + 1; if (j_hi > skv / KVBLK) j_hi = skv / KVBLK;
    const int NT = j_hi - j_lo;
    const int kbn = swa_jlo(nxt.P0, W) * KVBLK;
    const int qlo = cur.P0 + wid * QBLK, qm = qlo + r32 - 4 * hi;
    char* V_lds = lds; char* K_lds = lds + 2 * SHM_V;
    float* ws = (float*)(lds + 2 * SHM_V + 2 * SHM_K) + wid * 64; float* li_l = ws, * al_l = ws + 32;
    float m_reg = -1e30f, l_reg = 0; f32x16 o[4] = {};
    const int sr = tid >> 4, sc = (tid & 15) * 8, vst0 = v_st(sr, sc), vst1 = v_st(32 + sr, sc), kws = KSWZ(sr, sc * 2);
    const int vb0 = (int)(uintptr_t)V_lds + v_rd_base(lane);
    const TIn* Kh = cur.K; const TIn* Vh = cur.V;
#define RESC(a) do { if (__any((a) < 1.f)) { if (hi == 0) al_l[r32] = (a); asm volatile("s_waitcnt lgkmcnt(0)" ::: "memory");              \
                     for (int d_ = 0; d_ < 4; ++d_) for (int r = 0; r < 16; ++r) o[d_][r] *= al_l[crow(r, hi)]; } } while (0)
#define KBASE(t) ((j_lo + (t)) * KVBLK)
#define ACT(t) (KBASE(t) <= qlo + QBLK - 1 && KBASE(t) + KVBLK - 1 >= qlo - W + 1)
#define MASKT(P0_, P1_, t) do { const int kb_ = KBASE(t); if ((!SK || ACT(t)) && (kb_ + KVBLK - 1 > qlo || kb_ <= qlo + QBLK - 1 - W)) mask_tile(P0_, P1_, qm - kb_, (unsigned)W); } while (0)
    constexpr int NQL = F32 ? 16 : 8;
    constexpr bool SK = WSKIP && !F32;
#define SEAM_K0() do { VMWN(NQL); if constexpr (F32) { SWRITE_KF(0); SBAR(); SLOAD_F((const float*)nxt.V, kbn); } else { SWRITE_HK(0); } SBAR(); } while (0)
    f32x16 pA0, pA1, pB0, pB1; float mnA, mnB, alA, alB; bf16x8 pa0, pa1, pa2, pa3;
    if constexpr (F32) { VMW(); SWRITE_VF(0); SBAR(); } else { SWRITE_HV(0); SBAR(); }
    if (NT > 1) { if constexpr (F32) SLOAD_F((const float*)Kh, KBASE(1)); else SLOAD_H(Kh, Vh, KBASE(1)); }
    SBAR(); qkt<0, SK>(pA0, pA1, K_lds, r32, hi, S.qr, ACT(0));
    if constexpr (F32) { if (NT > 1) { VMW(); SWRITE_KF(1); SBAR(); SLOAD_F((const float*)Vh, KBASE(1)); } }
    MASKT(pA0, pA1, 0); partialSM(pA0, pA1, m_reg, mnA, alA);
    if (NT > 1) { VMW(); if constexpr (F32) { SWRITE_VF(1); SBAR(); if (NT > 2) SLOAD_F((const float*)Kh, KBASE(2)); } else SWRITE_H(1); }
    __syncthreads();
#define HALF_STEP(PX0, PX1, mnX, alX, PY0, PY1, alY, t, KB, VB, SB) do {                                                      \
        SBAR(); qkt<KB, SK>(PX0, PX1, K_lds, r32, hi, S.qr, ACT(t));                                             \
        finishSM(PY0, PY1, alY, l_reg, pa0, pa1, pa2, pa3); SBAR();                                                           \
        if ((t) + 1 < NT) { if constexpr (F32) { VMW(); SWRITE_KF(SB); SBAR(); SLOAD_F((const float*)Vh, KBASE((t) + 1)); }  \
                            else { SLOAD_H(Kh, Vh, KBASE((t) + 1)); } SBAR(); }                                               \
        pv_tile<VB, SK>(o, vb0, pa0, pa1, pa2, pa3, ACT((t) - 1)); MASKT(PX0, PX1, (t)); partialSM(PX0, PX1, m_reg, mnX, alX);                                        \
        __syncthreads();                                                                                                      \
        if ((t) + 1 < NT) { VMW(); if constexpr (F32) { SWRITE_VF(SB); SBAR(); if ((t) + 2 < NT) SLOAD_F((const float*)Kh, KBASE((t) + 2)); } \
                            else { SWRITE_H(SB); } }                                                                          \
        RESC(alX); __syncthreads(); } while (0)
    for (int t = 1; t + 1 < NT; t += 2) {
        HALF_STEP(pB0, pB1, mnB, alB, pA0, pA1, alA, t, 1, 0, 0);
        HALF_STEP(pA0, pA1, mnA, alA, pB0, pB1, alB, t + 1, 0, 1, 1);
    }
    const bool even = (NT & 1) == 0;
    if (even) { SBAR(); qkt<1, SK>(pB0, pB1, K_lds, r32, hi, S.qr, ACT(NT - 1)); SBAR(); }
#define QROW(e) (nxt.Q + (size_t)(wid * QBLK + r32) * D + ((e) >> 1) * 16 + hi * 8 + ((e) & 1) * 4)
    if constexpr (F32) { SLOAD_F((const float*)nxt.K, kbn); SBAR();
#pragma unroll
        for (int e = 0; e < 8; ++e) S.tq[e] = *(const f32x4*)QROW(e); }
    else { SLOAD_H(nxt.K, nxt.V, kbn); SBAR();
#pragma unroll
        for (int d0 = 0; d0 < 8; ++d0) S.qr[d0] = load8<TIn>(nxt.Q + (size_t)(wid * QBLK + r32) * D + d0 * 16 + hi * 8); }
    SBAR();
    finishSM(pA0, pA1, alA, l_reg, pa0, pa1, pa2, pa3); SBAR();
    if constexpr (F32) {
#pragma unroll
        for (int e = 8; e < 16; ++e) S.tq[e] = *(const f32x4*)QROW(e); SBAR(); }
#undef QROW
    pv_tile<0, SK>(o, vb0, pa0, pa1, pa2, pa3, ACT(even ? NT - 2 : NT - 1));
    if (even) { MASKT(pB0, pB1, NT - 1); partialSM(pB0, pB1, m_reg, mnB, alB); __syncthreads(); RESC(alB);
        finishSM(pB0, pB1, alB, l_reg, pa0, pa1, pa2, pa3); SBAR(); pv_tile<1, SK>(o, vb0, pa0, pa1, pa2, pa3, ACT(NT - 1)); }
    SBAR(); SEAM_K0();
    if (hi == 0) li_l[r32] = l_reg; asm volatile("s_waitcnt lgkmcnt(0)" ::: "memory");
    float rli[16];
#pragma unroll
    for (int r = 0; r < 16; ++r) rli[r] = __builtin_amdgcn_rcpf(li_l[crow(r, hi)]);
    TOut* Ow = cur.O + (size_t)(wid * QBLK) * D;
#pragma unroll
    for (int r = 0; r < 16; ++r) { const int orow = crow(r, hi);
#pragma unroll
        for (int d0 = 0; d0 < 4; ++d0) { const float v = o[d0][r] * rli[r];
            if constexpr (same_t<TOut, float>::v) { Ow[(size_t)orow * D + d0 * 32 + r32] = v; }
            else { const float vn = __shfl_xor(v, 1);
                   if ((r32 & 1) == 0) *(unsigned*)(Ow + (size_t)orow * D + d0 * 32 + r32) = cvtpk(v, vn); } } }
    if constexpr (F32) {
#pragma unroll
        for (int d0 = 0; d0 < 8; ++d0) S.qr[d0] = pack8(S.tq[2 * d0], S.tq[2 * d0 + 1]); }
    __syncthreads();
#undef RESC
#undef KBASE
#undef ACT
#undef MASKT
#undef SEAM_K0
#undef HALF_STEP
}
#undef ROW
#undef VMW
#undef VMWN
#undef SLOAD_H
#undef SWRITE_HK
#undef SWRITE_HV
#undef SWRITE_H
#undef SLOAD_F
#undef SWRITE_KF
#undef SWRITE_VF
constexpr int DA_K = 0, DA_V = 32768, DA_PX = 98304, DA_AL = 131072, DA_FL = DA_AL + 1024, DA_LL = DA_FL + 64, DA_OSC = DA_LL + 512  , DA_LDS = DA_OSC + 16384;
struct DaBlk { const bf16* Q; const bf16* K; const bf16* V0; const bf16* V1; bf16* O0; bf16* O1; int P0, nt; };
#if defined(DA_TESTRUN)
#define DA_TESTV(g) ((g).test)
#else
#define DA_TESTV(g) 0
#endif
struct DaGeom { const bf16* Qb; const bf16* Kb; const bf16* Vb; bf16* Ob; int vcu, G, nblk, skvp, seq, nmeta, test; };
template <int TEST = 0> __device__ __forceinline__ DaBlk da_blk_t(const DaGeom& g, int j) {
    const int item = g.vcu + g.G * (j >> 1), head = (DA_TESTV(g) == 1) ? 0 : ((DA_TESTV(g) == 2) ? ((item >> 5) & 7) : (item >> 5)), x = item & 31, qb = (j & 1) ? x : 63 - x;
    const int b = head >> 5, h = (head >> 1) & 15, c = head & 1;
    DaBlk B; const size_t hs = (size_t)g.skvp * D;
    B.Q = g.Qb + (size_t)(b * 32 + 2 * h + c) * hs + (size_t)(g.nmeta + 128 * qb) * D; B.K = g.Kb + (size_t)(b * 32 + 2 * h + c) * hs;
    B.V0 = g.Vb + (size_t)(b * 32 + 2 * h) * hs; B.V1 = B.V0 + hs;
    B.O0 = g.Ob + ((size_t)(head * 2) * g.seq + 128 * qb) * D; B.O1 = B.O0 + (size_t)g.seq * D;
    B.P0 = g.nmeta + 128 * qb; B.nt = (B.P0 + 127) / KVBLK + 1;
    return B;
}
__device__ __forceinline__ DaBlk da_blk(const DaGeom& g, int j) { return da_blk_t<0>(g, j); }
struct DaCur { int j, t, nt; };
__device__ __forceinline__ int da_tile(const DaCur& c) { return (c.j & 1) ? c.nt - 1 - c.t : c.t; }
__device__ __forceinline__ void da_adv(const DaGeom& g, DaCur& c) { if (c.t + 1 < c.nt) { ++c.t; } else if (c.j + 1 < g.nblk) { ++c.j; c.t = 0; c.nt = da_blk(g, c.j).nt; } }

template <int CTRL, bool BC> __device__ __forceinline__ float dppf(float x) { return __builtin_bit_cast(float, __builtin_amdgcn_update_dpp(0, __builtin_bit_cast(int, x), CTRL, 0xF, 0xF, BC)); }
template <int VB, class HOOK> __device__ __forceinline__ void da_pv2(f32x16* o, int vb0, bf16x8 pa0, bf16x8 pa1, bf16x8 pa2, bf16x8 pa3, bf16x8 pb0, bf16x8 pb1, bf16x8 pb2, bf16x8 pb3, HOOK&& hook) {
#define DA_TR(dst, off) asm volatile("ds_read_b64_tr_b16 %0, %1 offset:%2" : "=&v"(dst) : "v"(vb0), "i"(off) : "memory")
#define DA_TR8(S, d0) do { constexpr int b_ = VB * SHM_V + v_rd_off(d0, 0, 0); \
        DA_TR(S##l0, b_); DA_TR(S##h0, b_ + 2048); DA_TR(S##l1, b_ + 4096); DA_TR(S##h1, b_ + 6144); DA_TR(S##l2, b_ + 8192); DA_TR(S##h2, b_ + 10240); DA_TR(S##l3, b_ + 12288); DA_TR(S##h3, b_ + 14336); } while (0)
#define DA_VF(S, k) (bf16x8){S##l##k[0], S##l##k[1], S##l##k[2], S##l##k[3], S##h##k[0], S##h##k[1], S##h##k[2], S##h##k[3]}
#define DA_HK(h) do { if ((h) >= 0 && (h) < 0) { SBAR(); hook(h); SBAR(); } } while (0)
#define DA_MM(S, d0, H) do { \
        o[d0] = __builtin_amdgcn_mfma_f32_32x32x16_bf16(pa0, DA_VF(S, 0), o[d0], 0, 0, 0); DA_HK(H); o[4 + d0] = __builtin_amdgcn_mfma_f32_32x32x16_bf16(pb0, DA_VF(S, 0), o[4 + d0], 0, 0, 0); DA_HK(H + 1); \
        o[d0] = __builtin_amdgcn_mfma_f32_32x32x16_bf16(pa1, DA_VF(S, 1), o[d0], 0, 0, 0); DA_HK(H + 2); o[4 + d0] = __builtin_amdgcn_mfma_f32_32x32x16_bf16(pb1, DA_VF(S, 1), o[4 + d0], 0, 0, 0); DA_HK(H + 3); \
        o[d0] = __builtin_amdgcn_mfma_f32_32x32x16_bf16(pa2, DA_VF(S, 2), o[d0], 0, 0, 0); DA_HK(H + 4); o[4 + d0] = __builtin_amdgcn_mfma_f32_32x32x16_bf16(pb2, DA_VF(S, 2), o[4 + d0], 0, 0, 0); DA_HK(H + 5); \
        o[d0] = __builtin_amdgcn_mfma_f32_32x32x16_bf16(pa3, DA_VF(S, 3), o[d0], 0, 0, 0); DA_HK(H + 6); o[4 + d0] = __builtin_amdgcn_mfma_f32_32x32x16_bf16(pb3, DA_VF(S, 3), o[4 + d0], 0, 0, 0); DA_HK(H + 7); } while (0)
    s16x4 Al0, Al1, Al2, Al3, Ah0, Ah1, Ah2, Ah3, Bl0, Bl1, Bl2, Bl3, Bh0, Bh1, Bh2, Bh3;
    DA_TR8(A, 0);
    DA_TR8(B, 1); asm volatile("s_waitcnt lgkmcnt(8)" ::: "memory"); SBAR(); DA_MM(A, 0, 0); SBAR();
    DA_TR8(A, 2); asm volatile("s_waitcnt lgkmcnt(8)" ::: "memory"); SBAR(); DA_MM(B, 1, 8); SBAR();
    DA_TR8(B, 3); asm volatile("s_waitcnt lgkmcnt(8)" ::: "memory"); SBAR(); DA_MM(A, 2, -100); SBAR();
    asm volatile("s_waitcnt lgkmcnt(0)" ::: "memory"); SBAR(); DA_MM(B, 3, -100); SBAR();
#undef DA_TR
#undef DA_TR8
#undef DA_VF
#undef DA_MM
#undef DA_HK
}
#define DA_KSWZ(row, colB) ((row) * 256 + ((colB) ^ (((row) & 15) << 4)))
template <int KB> __device__ __forceinline__ void da_qkt(f32x16& p0, f32x16& p1, const char* K_lds, int r32, int hi, const bf16x8* qr) {
    const char* kb[4];
#pragma unroll
    for (int dd = 0; dd < 4; ++dd) kb[dd] = K_lds + KB * SHM_K + DA_KSWZ(r32, (dd * 16 + hi * 8) * 2);
    bf16x8 f0[8], f1[8];
#pragma unroll
    for (int d0 = 0; d0 < 8; ++d0) { const char* a = (d0 >> 2) ? K_lds + KB * SHM_K + DA_KSWZ(r32, ((d0 & 3) * 16 + hi * 8) * 2 + 128) : kb[d0 & 3]; f0[d0] = *reinterpret_cast<const bf16x8*>(a); f1[d0] = *reinterpret_cast<const bf16x8*>(a + 32 * 256); }
    SBAR();
    p0 = f32x16{}; p1 = f32x16{};
    __builtin_amdgcn_s_setprio(3);
#pragma unroll
    for (int d0 = 0; d0 < 8; ++d0) { p0 = __builtin_amdgcn_mfma_f32_32x32x16_bf16(f0[d0], qr[d0], p0, 0, 0, 0); p1 = __builtin_amdgcn_mfma_f32_32x32x16_bf16(f1[d0], qr[d0], p1, 0, 0, 0); }
    __builtin_amdgcn_s_setprio(0);
    SBAR();
}
typedef const __attribute__((address_space(1))) char* da_gptr;
__device__ __forceinline__ da_gptr da_uni(const char* p) { const unsigned long long v = (unsigned long long)p;
    const unsigned lo = __builtin_amdgcn_readfirstlane((unsigned)v), hi = __builtin_amdgcn_readfirstlane((unsigned)(v >> 32)); return (da_gptr)(((unsigned long long)hi << 32) | lo); }
__device__ __forceinline__ bool da_adv2(const DaGeom& g, DaCur& c) { if (c.t + 1 < c.nt) { ++c.t; return false; } if (c.j + 1 < g.nblk) { ++c.j; c.t = 0; c.nt = da_blk(g, c.j).nt; return true; } return false; }
__device__ __forceinline__ void da_phase(char* lds, const bf16* Qb, const bf16* Kb, const bf16* Vb, bf16* Ob, int vcu, int G, int skvp, int seq, int nmeta, int test = 0) {
    const int tid = tid_fresh(), wid = __builtin_amdgcn_readfirstlane(tid >> 6), lane = tid & 63, r32 = lane & 31, hi = lane >> 5;
    const bool prod = wid < 4; const int pw = wid & 3;
    DaGeom g{Qb, Kb, Vb, Ob, vcu, G, 0, skvp, seq, nmeta, test};
    { const int nitems = (2048 - vcu + G - 1) / G; g.nblk = vcu < 2048 ? 2 * nitems : 0; }
    if (g.nblk == 0) return;
    int nsteps = 1; for (int j = 0; j < g.nblk; ++j) nsteps += da_blk(g, j).nt;
    char* K_lds = lds + DA_K; char* V_lds = lds + DA_V;
    const int vb0 = (int)(uintptr_t)V_lds + v_rd_base(lane);
    float* al_w = (float*)(lds + DA_AL); unsigned* fl_w = (unsigned*)(lds + DA_FL); float* ll_w = (float*)(lds + DA_LL);
    const DaCur cstart{0, 0, da_blk(g, 0).nt};
    unsigned voffK[4], voffV[4];
#pragma unroll
    for (int j = 0; j < 4; ++j) { const int row = 16 * pw + 4 * j + (lane >> 4), chunk = (lane & 15) ^ (row & 15); voffK[j] = (unsigned)(row * 256 + chunk * 16);
        const int key = (pw << 4) | (((lane >> 4) & 1) << 3) | ((j >> 1) << 2) | ((lane >> 2) & 3), col = ((2 * (j & 1) + (lane >> 5)) << 5) | ((lane & 3) * 8); voffV[j] = (unsigned)(key * 256 + col * 2); }
    const unsigned dmaw = (unsigned)pw * 4096u;
#define DA_GLDS(src, ldsoff) __builtin_amdgcn_global_load_lds((const __attribute__((address_space(1))) unsigned*)(src), (__attribute__((address_space(3))) unsigned*)(lds + (ldsoff)), 16, 0, 0)
    DaCur ck = cstart, cv = cstart; const DaBlk Bkv = da_blk(g, 0);
    const char* kbase = (const char*)Bkv.K; const char* v0base = (const char*)Bkv.V0; const char* v1base = (const char*)Bkv.V1;
#define DA_ADVK() do { if (da_adv2(g, ck)) kbase = (const char*)da_blk(g, ck.j).K; } while (0)
#define DA_ADVV() do { if (da_adv2(g, cv)) { const DaBlk Bn_ = da_blk(g, cv.j); v0base = (const char*)Bn_.V0; v1base = (const char*)Bn_.V1; } } while (0)
#define DA_BAR() do { asm volatile("s_waitcnt lgkmcnt(0)" ::: "memory"); __builtin_amdgcn_s_barrier(); asm volatile("" ::: "memory"); } while (0)
#define DA_DMA1(PAR, i) do { const int j_ = (i) / 2, k_ = (i) % 2; unsigned vo_ = voffV[j_]; asm volatile("" : "+v"(vo_));     \
        if (k_ == 0) DA_GLDS(p0_ + vo_, DA_V + (2 * PAR) * SHM_V + dmaw + j_ * 1024); else DA_GLDS(p1_ + vo_, DA_V + (2 * PAR + 1) * SHM_V + dmaw + j_ * 1024); } while (0)
#define DA_DMAK(PAR) do { DA_ADVK(); const da_gptr kp = da_uni(kbase + (size_t)da_tile(ck) * 16384u); \
        _Pragma("unroll") for (int j_ = 0; j_ < 4; ++j_) { unsigned vo_ = voffK[j_]; asm volatile("" : "+v"(vo_)); DA_GLDS(kp + vo_, DA_K + (1 - PAR) * SHM_K + dmaw + j_ * 1024); } } while (0)
    if (prod) {
#pragma unroll
        for (int j = 0; j < 4; ++j) DA_GLDS(da_uni(kbase) + voffK[j], DA_K + dmaw + j * 1024);
    }
    if (prod) {
        bf16x8 qr[8]; float m_reg = -1e30f, l_reg = 0.f; DaCur cp = cstart; DaBlk Bp = da_blk(g, 0);
        bf16x8 qn[8];
#pragma unroll
        for (int d0 = 0; d0 < 8; ++d0) qn[d0] = bf16x8{};
#pragma unroll
        for (int d0 = 0; d0 < 8; ++d0) qr[d0] = load8<bf16>(Bp.Q + (size_t)(pw * QBLK + r32) * D + d0 * 16 + hi * 8);
        asm volatile("s_waitcnt vmcnt(0)" ::: "memory");
        DA_BAR();
#define DA_PSTEP(PAR, S, s_) do { bool qpf = false; \
            if ((s_) < nsteps - 1) { \
                f32x16 p0 = f32x16{}, p1 = f32x16{}; float mn, al = 1.f; bf16x8 pa0 = qr[0], pa1 = qr[1], pa2 = qr[2], pa3 = qr[3]; \
                { da_qkt<PAR>(p0, p1, K_lds, r32, hi, qr); DA_DMAK(PAR); SBAR();     \
                { const int qlo = Bp.P0 + pw * QBLK, kb_ = da_tile(cp) * KVBLK; if (kb_ + KVBLK - 1 > qlo) mask_tile(p0, p1, qlo + r32 - 4 * hi - kb_, 1u << 30); } \
                partialSM(p0, p1, m_reg, mn, al); finishSM(p0, p1, al, l_reg, pa0, pa1, pa2, pa3); } \
                char* px = lds + DA_PX + PAR * 16384 + pw * 4096 + lane * 16; \
                *(bf16x8*)(px) = pa0; *(bf16x8*)(px + 1024) = pa1; *(bf16x8*)(px + 2048) = pa2; *(bf16x8*)(px + 3072) = pa3; \
                if (hi == 0) al_w[PAR * 128 + pw * 32 + r32] = al; \
                const bool anyr = __any(al < 1.f); if (lane == 0) fl_w[PAR * 4 + pw] = anyr ? 1u : 0u; \
                if (cp.t == cp.nt - 2 && cp.j + 1 < g.nblk) { const DaBlk Bn = da_blk(g, cp.j + 1); qpf = true;     \
                    _Pragma("unroll") for (int d0 = 0; d0 < 8; ++d0) qn[d0] = load8<bf16>(Bn.Q + (size_t)(pw * QBLK + r32) * D + d0 * 16 + hi * 8); } \
                if (cp.t == cp.nt - 1) {                                     \
                    if (hi == 0) ll_w[pw * 32 + r32] = l_reg; m_reg = -1e30f; l_reg = 0.f; \
                    _Pragma("unroll") for (int d0 = 0; d0 < 8; ++d0) qr[d0] = qn[d0]; } \
                if (da_adv2(g, cp)) Bp = da_blk(g, cp.j); \
            } \
            if (qpf) asm volatile("s_waitcnt vmcnt(8)" ::: "memory"); else asm volatile("s_waitcnt vmcnt(0)" ::: "memory");     \
            DA_BAR(); } while (0)
        for (int s = 0; s < nsteps; s += 2) { DA_PSTEP(0, 0, s); if (s + 1 < nsteps) DA_PSTEP(1, 0, s + 1); }
#undef DA_PSTEP
    } else {
        f32x16 o[8]; DaCur cc = cstart; DaBlk Bc = da_blk(g, 0);
        const int rh = pw >> 1, ch = pw & 1, vb0c = vb0 + ch * SHM_V;
        bool stored = false;
#pragma unroll
        for (int d = 0; d < 8; ++d) o[d] = f32x16{};
        asm volatile("s_waitcnt vmcnt(0)" ::: "memory");
        DA_BAR();
        {
            const da_gptr p0_ = da_uni(v0base + (size_t)da_tile(cv) * 16384u), p1_ = da_uni(v1base + (size_t)da_tile(cv) * 16384u); DA_ADVV();
#pragma unroll
            for (int i_ = 0; i_ < 8; ++i_) DA_DMA1(0, i_);
            asm volatile("s_waitcnt vmcnt(0)" ::: "memory");
            DA_BAR();
        }
#define DA_CSTEP(PAR, S, s_) do { stored = false; \
            const da_gptr p0_ = da_uni(v0base + (size_t)da_tile(cv) * 16384u), p1_ = da_uni(v1base + (size_t)da_tile(cv) * 16384u); DA_ADVV(); \
            { \
                const char* px = lds + DA_PX + (1 - PAR) * 16384 + rh * 8192 + lane * 16; \
                const bf16x8 pa0 = *(const bf16x8*)(px), pa1 = *(const bf16x8*)(px + 1024), pa2 = *(const bf16x8*)(px + 2048), pa3 = *(const bf16x8*)(px + 3072); \
                const bf16x8 pb0 = *(const bf16x8*)(px + 4096), pb1 = *(const bf16x8*)(px + 5120), pb2 = *(const bf16x8*)(px + 6144), pb3 = *(const bf16x8*)(px + 7168); \
                SBAR(); _Pragma("unroll") for (int i_ = 0; i_ < 8; ++i_) DA_DMA1(PAR, i_); SBAR();     \
                _Pragma("unroll") for (int rb = 0; rb < 2; ++rb) { \
                    if (fl_w[(1 - PAR) * 4 + 2 * rh + rb] != 0u) { const float* alp = al_w + (1 - PAR) * 128 + (2 * rh + rb) * 32; \
                        _Pragma("unroll") for (int r = 0; r < 16; ++r) { const float a_ = alp[crow(r, hi)]; _Pragma("unroll") for (int d_ = 0; d_ < 4; ++d_) o[4 * rb + d_][r] *= a_; } } } \
                asm volatile("s_waitcnt lgkmcnt(0)" ::: "memory"); SBAR(); \
                da_pv2<2 * (1 - PAR)>(o, vb0c, pa0, pa1, pa2, pa3, pb0, pb1, pb2, pb3, [&](int i_) { DA_DMA1(PAR, i_); });     \
                if (cc.t == cc.nt - 1) {                                     \
                    char* osc = lds + DA_OSC + pw * 4096; const bool odd = (r32 & 1) != 0; bf16* Oh = ch ? Bc.O1 : Bc.O0; \
                    _Pragma("unroll") for (int rb = 0; rb < 2; ++rb) { \
                        float rli[16]; _Pragma("unroll") for (int r = 0; r < 16; ++r) rli[r] = __builtin_amdgcn_rcpf(ll_w[(2 * rh + rb) * 32 + crow(r, hi)]); \
                        _Pragma("unroll") for (int k = 0; k < 2; ++k) { \
                            _Pragma("unroll") for (int dd = 0; dd < 2; ++dd) _Pragma("unroll") for (int rp = 0; rp < 8; ++rp) { \
                                const float v0 = o[4 * rb + 2 * k + dd][2 * rp] * rli[2 * rp], v1 = o[4 * rb + 2 * k + dd][2 * rp + 1] * rli[2 * rp + 1]; \
                                const float snd = odd ? v0 : v1, rcv = dppf<0xB1, false>(snd);         \
                                const unsigned w = odd ? cvtpk(rcv, v1) : cvtpk(v0, rcv);                \
                                *(unsigned*)(osc + crow(odd ? 2 * rp + 1 : 2 * rp, hi) * 128 + (dd * 32 + (r32 & ~1)) * 2) = w; } \
                            asm volatile("s_waitcnt lgkmcnt(0)" ::: "memory"); \
                            bf16* Og = Oh + (size_t)((2 * rh + rb) * QBLK) * D + k * 64 + (lane & 7) * 8; \
                            _Pragma("unroll") for (int i = 0; i < 4; ++i) { const int row = (lane >> 3) + 8 * i; const bf16x8 vv = *(const bf16x8*)(osc + row * 128 + (lane & 7) * 16); \
                                if (DA_TESTV(g) == 0) __builtin_nontemporal_store(vv, (bf16x8*)(Og + (size_t)row * D)); } \
                            asm volatile("s_waitcnt lgkmcnt(0)" ::: "memory"); } } \
                    stored = true; _Pragma("unroll") for (int d0 = 0; d0 < 8; ++d0) o[d0] = f32x16{}; } \
                if (da_adv2(g, cc)) Bc = da_blk(g, cc.j); \
            } \
            if (stored) asm volatile("s_waitcnt vmcnt(16)" ::: "memory"); else asm volatile("s_waitcnt vmcnt(0)" ::: "memory");     \
            DA_BAR(); } while (0)
        for (int s = 1; s < nsteps; s += 2) { DA_CSTEP(1, 0, s); if (s + 1 < nsteps) DA_CSTEP(0, 0, s + 1); }
#undef DA_CSTEP
    }
#undef DA_DMA1
#undef DA_DMAK
#undef DA_GLDS
#undef DA_ADVK
#undef DA_ADVV
#undef DA_BAR
}
}
#define GAS __attribute__((address_space(1)))
#define LAS __attribute__((address_space(3)))
typedef unsigned short bf16;
typedef unsigned u32x4 __attribute__((ext_vector_type(4)));
typedef unsigned u32x2 __attribute__((ext_vector_type(2)));
typedef float f32x4 __attribute__((ext_vector_type(4)));
typedef float f32x2 __attribute__((ext_vector_type(2)));
typedef short bf16x8 __attribute__((ext_vector_type(8)));

#ifndef GEMM_SP2
#define GEMM_SP2 true
#endif
constexpr int DM = 4096, NB = 2, SEQ = 8192, NMETA = 16, FF = 16384, NH = 16, DH = 128, NSH = 32;
constexpr int MX = NB * SEQ;
constexpr int MP = MX + 256;
constexpr int SKVP = 8256, LPOS = 8208;
constexpr int SG = 256, SP = 64, SGS = 16;
constexpr float EPS = 1e-6f;
static_assert(SKVP == pg8::E_SKVP && NMETA == pg8::E_NMETA && MX / 256 == pg8::E_MXP, "epilogue constants");

constexpr size_t MiB = 1u << 20;
constexpr size_t WS_CTL = 0, CTL_ZERO_BYTES = 256 * 1024;
constexpr size_t WS_WQKV = 1 * MiB;
constexpr size_t WS_WO   = WS_WQKV + 96 * MiB;
constexpr size_t WS_WGLU = WS_WO + 32 * MiB;
constexpr size_t WS_WUP  = WS_WGLU + 64 * MiB;
constexpr size_t WS_WDN  = WS_WUP + 256 * MiB;
constexpr size_t WS_H    = WS_WDN + 256 * MiB;
constexpr size_t WS_PART = WS_H + 130 * MiB;
constexpr size_t WS_RSTD = WS_PART + 16 * MiB;
constexpr size_t WS_HN   = WS_H + 260 * MiB;
constexpr size_t WS_ATTO = WS_HN + 130 * MiB;
constexpr size_t WS_R    = WS_ATTO + 130 * MiB;
constexpr size_t QKV_T_BYTES = (size_t)NB * NSH * SKVP * DH * 2;
constexpr size_t WS_Q = WS_R, WS_K = WS_Q + QKV_T_BYTES, WS_V = WS_K + QKV_T_BYTES, WS_O = WS_V + QKV_T_BYTES;
constexpr size_t O_BYTES = (size_t)128 * SEQ * DH * 2;
constexpr size_t WS_MID = WS_R;
constexpr size_t WS_END = WS_O + O_BYTES;
static_assert((size_t)MP * DM * 4 == 260 * MiB && (size_t)MP * DM * 2 == 130 * MiB && QKV_T_BYTES == 129 * MiB && (size_t)MP * FF * 2 <= WS_END - WS_R, "ws map");
constexpr size_t WS_MPART = WS_END + 14 * MiB;
constexpr int CW_XRANK = 8192;
constexpr int CW_BAR = 4096;

constexpr int RING_BYTES = 131072;
constexpr int S5_BFRAG = 0, S5_CFRAG = 65536, S5_KTAB = 131072, S5_CPOW = 139264, S5_WPOW = 147456, S5_A256 = 149504, S5_A1024 = 150016, S5_F = 150528  , S5_EMETA = S5_F + 8192  ;
constexpr int MISC_OFF = 159232, LDS_BYTES = 159744;
static_assert(S5_EMETA + 512 == MISC_OFF && ab::LDS_BYTES <= RING_BYTES && 17 * 64 * 8 <= 8704, "LDS map");

#define LDS_WAIT() asm volatile("s_waitcnt lgkmcnt(0)" ::: "memory")
__device__ __forceinline__ unsigned pk2(float lo, float hi) { unsigned r; asm volatile("v_cvt_pk_bf16_f32 %0, %1, %2" : "=v"(r) : "v"(lo), "v"(hi)); return r; }
__device__ __forceinline__ float bflo(unsigned w) { return __builtin_bit_cast(float, w << 16); }
__device__ __forceinline__ float bfhi(unsigned w) { return __builtin_bit_cast(float, w & 0xffff0000u); }
__device__ __forceinline__ float wave_sum(float v) {
#pragma unroll
    for (int o = 1; o < 64; o <<= 1) v += __shfl_xor(v, o);
    return v;
}

#define XB_TMO      128
#define XB_XCNT(j)  (256  + 64 * (j))
#define XB_XSUB(j)  (1280 + 64 * (j))
#define XB_XGEN(j)  (2304 + 64 * (j))
#define XB_TOP      3328
#define XB_TOPGEN   3392
#define XCD_BAR_WORDS 3456
#define XB_SPIN_CAP (1u << 18)

__device__ __forceinline__ unsigned xb_ld(unsigned* p)              { return __hip_atomic_load(p, __ATOMIC_RELAXED, __HIP_MEMORY_SCOPE_AGENT); }
__device__ __forceinline__ unsigned xb_add(unsigned* p, unsigned v) { return __hip_atomic_fetch_add(p, v, __ATOMIC_RELAXED, __HIP_MEMORY_SCOPE_AGENT); }
__device__ __forceinline__ unsigned xb_xcc_id() { return (unsigned)__builtin_amdgcn_s_getreg((3 << 11) | 20) & 0xFu; }
#define XB_SPIN(cond, bar) do { unsigned _sp = 0; while (cond) { __builtin_amdgcn_s_sleep(1); \
    if ((++_sp & 255u) == 0u) { if (xb_ld(&(bar)[XB_TMO])) break; if (_sp > XB_SPIN_CAP) { atomicAdd(&(bar)[XB_TMO], 1u); break; } } } } while (0)

struct XcdBarrier {
    unsigned* bar; unsigned x;
    volatile LAS unsigned* st;
};

__device__ __forceinline__ XcdBarrier xcd_barrier_post(unsigned* bar, volatile LAS unsigned* st) {
    XcdBarrier b; b.bar = bar; b.x = xb_xcc_id(); b.st = st;
    if (threadIdx.x == 0) (void)xb_add(&bar[XB_XCNT(b.x)], 1u);
    return b;
}
__device__ __forceinline__ void xcd_barrier_complete(unsigned* bar, unsigned x, unsigned& nloc, unsigned& nx) {
    const unsigned G = gridDim.x * gridDim.y * gridDim.z;
    unsigned sum, cnt, mine, sp = 0u;
    for (;;) {
        sum = 0u; cnt = 0u; mine = 0u;
#pragma unroll
        for (unsigned j = 0; j < 16; ++j) { const unsigned c = xb_ld(&bar[XB_XCNT(j)]); sum += c; cnt += (c > 0u) ? 1u : 0u; mine = (j == x) ? c : mine; }
        if (sum == G) break;
        __builtin_amdgcn_s_sleep(1);
        if ((++sp & 255u) == 0u) { if (xb_ld(&bar[XB_TMO])) break; if (sp > XB_SPIN_CAP) { atomicAdd(&bar[XB_TMO], 1u); break; } }
    }
    nloc = mine > 0u ? mine : 1u; nx = cnt > 0u ? cnt : 1u;
}

__device__ __forceinline__ void xcd_barrier(const XcdBarrier& b) {
    asm volatile("s_waitcnt vmcnt(0)" ::: "memory");
    __syncthreads();
    if (threadIdx.x == 0) {
        unsigned* bar = b.bar;
        __builtin_amdgcn_s_waitcnt(0);
        unsigned nloc = b.st[0], nx = b.st[1];
        if (nloc == 0u) { xcd_barrier_complete(bar, b.x, nloc, nx); b.st[0] = nloc; b.st[1] = nx; }
        const unsigned old = xb_add(&bar[XB_XSUB(b.x)], 1u);
        const unsigned gen = old / nloc;
        if (old + 1u == (gen + 1u) * nloc) {
            __builtin_amdgcn_fence(__ATOMIC_RELEASE, "agent");
            asm volatile("s_waitcnt vmcnt(0)" ::: "memory");
            const unsigned og = xb_add(&bar[XB_TOP], 1u);
            const unsigned tg = og / nx;
            if (og + 1u == (tg + 1u) * nx) xb_add(&bar[XB_TOPGEN], 1u);
            else XB_SPIN(xb_ld(&bar[XB_TOPGEN]) == tg, bar);
            __builtin_amdgcn_fence(__ATOMIC_ACQUIRE, "agent");
            xb_add(&bar[XB_XGEN(b.x)], 1u);
            asm volatile("s_waitcnt vmcnt(0)" ::: "memory");
        } else {
            XB_SPIN(xb_ld(&bar[XB_XGEN(b.x)]) == gen, bar);
            __builtin_amdgcn_fence(__ATOMIC_ACQUIRE, "agent");
            asm volatile("s_waitcnt vmcnt(0)" ::: "memory");
        }
    }
    __syncthreads();
}

__device__ __forceinline__ void transpose_item(const float* __restrict__ W, int K, int N, bf16* __restrict__ WT, int k0, int n0, int drow0, LAS float* scr, int lane, const float* __restrict__ gk = nullptr) {
    const int kk0 = lane >> 4, nq = lane & 15;
#pragma unroll
    for (int half = 0; half < 2; ++half) {
        f32x4 v[8];
#pragma unroll
        for (int i = 0; i < 8; ++i) v[i] = *(const f32x4*)(W + (size_t)(k0 + (half * 8 + i) * 4 + kk0) * N + n0 + 4 * nq);
#pragma unroll
        for (int i = 0; i < 8; ++i) { LAS float* s = scr + ((half * 8 + i) * 4 + kk0) * 65 + 4 * nq; const float gs = gk ? gk[k0 + (half * 8 + i) * 4 + kk0] : 1.0f; s[0] = v[i].x * gs; s[1] = v[i].y * gs; s[2] = v[i].z * gs; s[3] = v[i].w * gs; }
    }
    LDS_WAIT(); asm volatile("" ::: "memory");
    const int c = lane & 7;
#pragma unroll
    for (int j = 0; j < 8; ++j) { const int n = (lane >> 3) + 8 * j; const LAS float* s = scr + (8 * c) * 65 + n;
        u32x4 o; o.x = pk2(s[0 * 65], s[1 * 65]); o.y = pk2(s[2 * 65], s[3 * 65]); o.z = pk2(s[4 * 65], s[5 * 65]); o.w = pk2(s[6 * 65], s[7 * 65]);
        *(u32x4*)(WT + (size_t)(drow0 + n) * K + k0 + 8 * c) = o; }
    LDS_WAIT(); asm volatile("" ::: "memory");
}
template <bool COPY> __device__ __forceinline__ void rms_row(const float* __restrict__ src, const float* __restrict__ g, bf16* __restrict__ dst, float* __restrict__ cp, int lane) {
    const f32x4* s4 = (const f32x4*)src + lane; f32x4 v[16]; float ss = 0.f;
#pragma unroll
    for (int j = 0; j < 16; ++j) { v[j] = s4[64 * j]; ss += (v[j].x * v[j].x + v[j].y * v[j].y) + (v[j].z * v[j].z + v[j].w * v[j].w); }
    if (COPY) {
#pragma unroll
        for (int j = 0; j < 16; ++j) ((f32x4*)cp + lane)[64 * j] = v[j]; }
    ss = wave_sum(ss); const float rstd = 1.0f / sqrtf(ss * (1.0f / DM) + EPS);
    const f32x4* g4 = (const f32x4*)g + lane; u32x2* d2 = (u32x2*)dst + lane;
#pragma unroll
    for (int j = 0; j < 16; ++j) { const f32x4 gv = g4[64 * j]; u32x2 o; o.x = pk2(v[j].x * rstd * gv.x, v[j].y * rstd * gv.y); o.y = pk2(v[j].z * rstd * gv.z, v[j].w * rstd * gv.w); d2[64 * j] = o; }
}
__device__ __forceinline__ void rms_row_bf(const bf16* __restrict__ src, const float* __restrict__ g, bf16* __restrict__ dst, int lane) {
    const u32x4* s4 = (const u32x4*)src + lane; u32x4 v[8]; float ss = 0.f;
#pragma unroll
    for (int j = 0; j < 8; ++j) { v[j] = s4[64 * j];
#pragma unroll
        for (int q = 0; q < 4; ++q) { const float a = bflo(v[j][q]), b = bfhi(v[j][q]); ss += a * a + b * b; } }
    ss = wave_sum(ss); const float rstd = 1.0f / sqrtf(ss * (1.0f / DM) + EPS);
    u32x4* d4 = (u32x4*)dst + lane;
#pragma unroll
    for (int j = 0; j < 8; ++j) { const f32x4 g0 = *(const f32x4*)(g + 8 * (lane + 64 * j)), g1 = *(const f32x4*)(g + 8 * (lane + 64 * j) + 4); u32x4 o;
        o.x = pk2(bflo(v[j].x) * rstd * g0.x, bfhi(v[j].x) * rstd * g0.y); o.y = pk2(bflo(v[j].y) * rstd * g0.z, bfhi(v[j].y) * rstd * g0.w);
        o.z = pk2(bflo(v[j].z) * rstd * g1.x, bfhi(v[j].z) * rstd * g1.y); o.w = pk2(bflo(v[j].w) * rstd * g1.z, bfhi(v[j].w) * rstd * g1.w); d4[64 * j] = o; }
}
__device__ __forceinline__ void zero_row(bf16* dst, float* cp, int lane) {
    u32x2* d2 = (u32x2*)dst + lane;
#pragma unroll
    for (int j = 0; j < 16; ++j) { d2[64 * j] = (u32x2){0u, 0u}; if (cp) ((f32x4*)cp + lane)[64 * j] = (f32x4){0.f, 0.f, 0.f, 0.f}; }
}

struct Ptrs {
    const float *x, *meta, *g_mix, *g_mlp, *wqkv, *qg, *kg, *lamv, *sg, *wo, *a_re, *a_im, *log_dt, *b_re, *b_im, *c_re, *c_im, *dsk, *wglu, *bglu, *wup, *wdn;
    float* out; unsigned char* ws;
};

__device__ __forceinline__ void p0_prologue(const Ptrs& P, LAS unsigned char* lds, int gw, int NGW, int wave, int lane) {
    LAS float* scr = (LAS float*)(lds + wave * 16640);
    bf16* Wqkv_t = (bf16*)(P.ws + WS_WQKV); bf16* Wo_t = (bf16*)(P.ws + WS_WO); bf16* Wglu_t = (bf16*)(P.ws + WS_WGLU); bf16* Wup_t = (bf16*)(P.ws + WS_WUP); bf16* Wdn_t = (bf16*)(P.ws + WS_WDN);
    constexpr int I_QKV = 64 * 192, I_O = 64 * 64, I_GLU = 64 * 128, I_UP = 64 * 256, I_DN = 256 * 64;
    constexpr int NITEMS = I_QKV + I_O + I_GLU + 2 * I_UP + 2 * I_DN;
    for (int it = gw; it < NITEMS; it += NGW) {
        int r = it;
        if (r < I_QKV) { const int kb = r / 192, nb = r % 192; transpose_item(P.wqkv, DM, 3 * DM, Wqkv_t, 64 * kb, 64 * nb, 64 * nb, scr, lane); continue; } r -= I_QKV;
        if (r < I_O) { const int kb = r / 64, nb = r % 64; transpose_item(P.wo, DM, DM, Wo_t, 64 * kb, 64 * nb, 64 * nb, scr, lane); continue; } r -= I_O;
        if (r < I_GLU) { const int kb = r / 128, nb = r % 128, n0 = 64 * nb, hf = n0 / DM, f0 = n0 % DM; transpose_item(P.wglu, DM, 2 * DM, Wglu_t, 64 * kb, n0, 256 * (f0 / 128) + 128 * hf + (f0 % 128), scr, lane); continue; } r -= I_GLU;
        if (r < 2 * I_UP) { const int l = r / I_UP; r -= l * I_UP; const int kb = r / 256, nb = r % 256; transpose_item(P.wup + (size_t)l * DM * FF, DM, FF, Wup_t + (size_t)l * DM * FF, 64 * kb, 64 * nb, 64 * nb, scr, lane, P.g_mlp + (size_t)l * DM); continue; } r -= 2 * I_UP;
        { const int l = r / I_DN; r -= l * I_DN; const int kb = r / 64, nb = r % 64; transpose_item(P.wdn + (size_t)l * DM * FF, FF, DM, Wdn_t + (size_t)l * DM * FF, 64 * kb, 64 * nb, 64 * nb, scr, lane); }
    }
    bf16* H = (bf16*)(P.ws + WS_H); bf16* HN = (bf16*)(P.ws + WS_HN);
    for (int m = gw; m < MP; m += NGW) {
        if (m < MX) rms_row<false>(P.x + (size_t)m * DM, P.g_mix, HN + (size_t)m * DM, nullptr, lane);
        else if (m < MX + NMETA) { rms_row<false>(P.meta + (size_t)(m - MX) * DM, P.g_mix, HN + (size_t)m * DM, nullptr, lane);
            const f32x4* ms = (const f32x4*)(P.meta + (size_t)(m - MX) * DM) + lane; u32x2* hd = (u32x2*)(H + (size_t)m * DM) + lane;
            for (int j = 0; j < 16; ++j) { const f32x4 t4 = ms[64 * j]; hd[64 * j] = (u32x2){pk2(t4.x, t4.y), pk2(t4.z, t4.w)}; } }
        else zero_row(HN + (size_t)m * DM, nullptr, lane);
    }
    for (int it = gw; it < 3 * 64 * (SKVP - LPOS); it += NGW) { const int t = it / (64 * (SKVP - LPOS)), r2 = it % (64 * (SKVP - LPOS)), bh = r2 / (SKVP - LPOS), pp = LPOS + r2 % (SKVP - LPOS);
        bf16* base = (bf16*)(P.ws + WS_Q + (size_t)t * QKV_T_BYTES) + ((size_t)bh * SKVP + pp) * DH; ((unsigned*)base)[lane] = 0u; }
}

template <class Epi> __device__ __forceinline__ void skinny16(LAS unsigned char* lds, const bf16* __restrict__ A  , const bf16* __restrict__ Bt  , int ld, int N, int kparts, int vcu, int G, int tid, const Epi& E) {
    const int wave = __builtin_amdgcn_readfirstlane(tid >> 6), lane = tid & 63, fr = lane & 15, fq = lane >> 4;
    const int kpart = vcu % kparts, slot = vcu / kparts, nslots = G / kparts;
    LAS f32x4* red = (LAS f32x4*)lds;
    const bf16* ap = A + (size_t)fr * ld + kpart * 4096 + wave * 512 + 16 * fq;
    bf16x8 a[16];
#pragma unroll
    for (int i = 0; i < 8; ++i) { a[2 * i] = *(const bf16x8*)(ap + 64 * i); a[2 * i + 1] = *(const bf16x8*)(ap + 64 * i + 8); }
    for (int task = slot; task < (N >> 4); task += nslots) {
        const int n0 = task * 16;
        const bf16* bp = Bt + (size_t)(n0 + fr) * ld + kpart * 4096 + wave * 512 + 16 * fq;
        bf16x8 b[16];
#pragma unroll
        for (int i = 0; i < 8; ++i) { b[2 * i] = *(const bf16x8*)(bp + 64 * i); b[2 * i + 1] = *(const bf16x8*)(bp + 64 * i + 8); }
        f32x4 acc = (f32x4){0.f, 0.f, 0.f, 0.f};
#pragma unroll
        for (int i = 0; i < 16; ++i) acc = __builtin_amdgcn_mfma_f32_16x16x32_bf16(b[i], a[i], acc, 0, 0, 0);
        __syncthreads();
        red[wave * 64 + lane] = acc;
        __syncthreads();
        if (wave == 0) { f32x4 s = red[lane];
#pragma unroll
            for (int w = 1; w < 8; ++w) s += red[w * 64 + lane];
            E(s, n0 + 4 * fq, fr, kpart); }
    }
    __syncthreads();
}
struct SkQKV { bf16* Q; __device__ __forceinline__ void operator()(f32x4 v, int n, int row, int) const {
    const int sec = n / DM, hid = (n % DM) / DH, d = n % DH; bf16* dst = Q + (size_t)sec * (QKV_T_BYTES / 2) + ((size_t)hid * SKVP + row) * DH + d;
    const u32x2 w = (u32x2){pk2(v.x, v.y), pk2(v.z, v.w)}; *(u32x2*)dst = w; *(u32x2*)(dst + (size_t)NSH * SKVP * DH) = w; } };
struct SkRes { bf16* H; __device__ __forceinline__ void operator()(f32x4 v, int n, int row, int) const { u32x2* p = (u32x2*)(H + (size_t)(MX + row) * DM + n); const u32x2 w = *p;
    *p = (u32x2){pk2(bflo(w.x) + v.x, bfhi(w.x) + v.y), pk2(bflo(w.y) + v.z, bfhi(w.y) + v.w)}; } };
struct SkPart { float* part; __device__ __forceinline__ void operator()(f32x4 v, int n, int row, int kpart) const { *(f32x4*)(part + ((size_t)kpart * NMETA + row) * DM + n) = v; } };
struct SkRelu2 { bf16* MID; const float* rstd; __device__ __forceinline__ void operator()(f32x4 v, int n, int row, int) const { const float rs = rstd[MX + row], q = rs * rs;
    const float a = fmaxf(v.x, 0.f), b = fmaxf(v.y, 0.f), c = fmaxf(v.z, 0.f), d = fmaxf(v.w, 0.f); *(u32x2*)(MID + (size_t)(MX + row) * FF + n) = (u32x2){pk2(a * a * q, b * b * q), pk2(c * c * q, d * d * q)}; } };

__device__ __forceinline__ void norm_phase(const bf16* H, const float* g, bf16* HN, int nrows, int gw, int NGW, int lane) {
    for (int m = gw; m < nrows; m += NGW) rms_row_bf(H + (size_t)m * DM, g, HN + (size_t)m * DM, lane);
}

__device__ __forceinline__ void rstd_phase(const float* part, int npart  , float* rstd, const bf16* H, bool with_meta, int gw, int NGW, int lane) {
    for (int m = gw; m < MX; m += NGW) { const float* pr = part + (size_t)m * 128; float s = pr[lane]; if (npart > 64) s += pr[64 + lane];
        s = wave_sum(s); if (lane == 0) rstd[m] = 1.0f / sqrtf(s * (1.0f / DM) + EPS); }
    if (with_meta) for (int m = MX + gw; m < MX + NMETA; m += NGW) { const u32x4* s4 = (const u32x4*)(H + (size_t)m * DM) + lane; float ss = 0.f;
#pragma unroll
        for (int j = 0; j < 8; ++j) { const u32x4 v = s4[64 * j];
#pragma unroll
            for (int q = 0; q < 4; ++q) { const float a = bflo(v[q]), b = bfhi(v[q]); ss += a * a + b * b; } }
        ss = wave_sum(ss); if (lane == 0) rstd[m] = 1.0f / sqrtf(ss * (1.0f / DM) + EPS); }
}
__device__ __forceinline__ void qk_rope_phase(bf16* Q, bf16* K, const float* qg, const float* kg, int gw, int NGW, int lane) {
    const int j16 = lane & 15, rr = lane >> 4;
    float inv[4];
#pragma unroll
    for (int t = 0; t < 4; ++t) inv[t] = exp2f(-(float)(2 * (4 * j16 + t)) * (13.287712379549449f / 128.0f));
    for (int item = gw; item < NB * LPOS; item += NGW) {
        const int b = item / LPOS, p = item % LPOS;
        float cs[4], sn[4];
#pragma unroll
        for (int t = 0; t < 4; ++t) { const float ang = (float)p * inv[t]; cs[t] = cosf(ang); sn[t] = sinf(ang); }
#pragma unroll 1
        for (int ten = 0; ten < 2; ++ten) {
            bf16* T = ten ? K : Q; const float* g = ten ? kg : qg;
            const f32x4 g1 = *(const f32x4*)(g + 4 * j16), g2 = *(const f32x4*)(g + 64 + 4 * j16);
            bf16* row0 = T + ((size_t)(b * NSH + rr) * SKVP + p) * DH;
            u32x2 a[8], c[8];
#pragma unroll
            for (int ps = 0; ps < 8; ++ps) { const bf16* row = row0 + (size_t)(4 * ps) * SKVP * DH; a[ps] = *(const u32x2*)(row + 4 * j16); c[ps] = *(const u32x2*)(row + 64 + 4 * j16); }
#pragma unroll
            for (int ps = 0; ps < 8; ++ps) {
                bf16* row = row0 + (size_t)(4 * ps) * SKVP * DH;
                float x1[4] = {bflo(a[ps].x), bfhi(a[ps].x), bflo(a[ps].y), bfhi(a[ps].y)}, x2[4] = {bflo(c[ps].x), bfhi(c[ps].x), bflo(c[ps].y), bfhi(c[ps].y)};
                float ss = 0.f;
#pragma unroll
                for (int t = 0; t < 4; ++t) ss += x1[t] * x1[t] + x2[t] * x2[t];
                ss += __shfl_xor(ss, 1); ss += __shfl_xor(ss, 2); ss += __shfl_xor(ss, 4); ss += __shfl_xor(ss, 8);
                const float rstd = 1.0f / sqrtf(ss * (1.0f / DH) + EPS);
                float o1[4], o2[4];
#pragma unroll
                for (int t = 0; t < 4; ++t) { const float y1 = x1[t] * rstd * g1[t], y2 = x2[t] * rstd * g2[t]; o1[t] = y1 * cs[t] - y2 * sn[t]; o2[t] = y2 * cs[t] + y1 * sn[t]; }
                *(u32x2*)(row + 4 * j16) = (u32x2){pk2(o1[0], o1[1]), pk2(o1[2], o1[3])};
                *(u32x2*)(row + 64 + 4 * j16) = (u32x2){pk2(o2[0], o2[1]), pk2(o2[2], o2[3])};
            }
        }
    }
}

typedef ab::BlockRef<ab::bf16, ab::bf16> ARef;
__device__ __forceinline__ ARef attn_ref(int L, int pass, const bf16* Q, const bf16* K, const bf16* V, bf16* O) {
    const int inst = L >> 4, x = L & 15, qb = pass ? 31 - x : x;
    const int b = inst >> 6, h = (inst >> 2) & 15, c = (inst >> 1) & 1, vh = inst & 1;
    ARef r;
    r.Q = Q + ((size_t)(b * NSH + 2 * h + c) * SKVP + NMETA + 256 * qb) * DH;
    r.K = K + (size_t)(b * NSH + 2 * h + c) * SKVP * DH;
    r.V = V + (size_t)(b * NSH + 2 * h + vh) * SKVP * DH;
    r.O = O + ((size_t)inst * SEQ + 256 * qb) * DH;
    r.P0 = NMETA + 256 * qb;
    return r;
}
__device__ __forceinline__ void attn_phase(char* lds, const bf16* Q, const bf16* K, const bf16* V, bf16* O, int vcu, int G) {
    constexpr int TOTAL = 128 * 16, W = 1 << 30;
    int L = vcu; if (L >= TOTAL) return;
    int pass = 0;
    ARef cur = attn_ref(L, 0, Q, K, V, O);
    ab::Seam<ab::bf16> S;
    ab::causal_swa_prime<ab::bf16, ab::bf16>(cur, W, lds, S);
    for (;;) {
        const bool more_pass = pass == 0, more_item = L + G < TOTAL, last = !more_pass && !more_item;
        int passn = pass + 1, Ln = L;
        if (!more_pass) { passn = 0; Ln = more_item ? L + G : L; }
        const ARef nxt = last ? cur : attn_ref(Ln, passn, Q, K, V, O);
        ab::causal_swa_block<ab::bf16, ab::bf16>(cur, nxt, SKVP, W, lds, S);
        if (last) break;
        cur = nxt; pass = passn; L = Ln;
    }
}

__device__ __forceinline__ float wave_sum_dpp(float v) {
    v += ab::dppf<0xB1, false>(v); v += ab::dppf<0x4E, false>(v); v += ab::dppf<0x141, false>(v); v += ab::dppf<0x140, false>(v);
    return (__builtin_bit_cast(float, __builtin_amdgcn_readlane(__builtin_bit_cast(int, v), 0)) + __builtin_bit_cast(float, __builtin_amdgcn_readlane(__builtin_bit_cast(int, v), 16)))
         + (__builtin_bit_cast(float, __builtin_amdgcn_readlane(__builtin_bit_cast(int, v), 32)) + __builtin_bit_cast(float, __builtin_amdgcn_readlane(__builtin_bit_cast(int, v), 48)));
}
__device__ __forceinline__ void combine_phase(const Ptrs& P, int gw, int NGW, int lane) {
    const bf16* Ob = (const bf16*)(P.ws + WS_O); bf16* ATTO = (bf16*)(P.ws + WS_ATTO);
    const bf16* Qb = (const bf16*)(P.ws + WS_Q); const bf16* Kb = (const bf16*)(P.ws + WS_K); const bf16* Vb = (const bf16*)(P.ws + WS_V);
    float lam; { const float s1 = wave_sum(P.lamv[lane] * P.lamv[128 + lane] + P.lamv[64 + lane] * P.lamv[192 + lane]);
                 const float s2 = wave_sum(P.lamv[256 + lane] * P.lamv[384 + lane] + P.lamv[320 + lane] * P.lamv[448 + lane]); lam = expf(s1) - expf(s2) + 0.2f; }
    const f32x4 sgv = *(const f32x4*)(P.sg + 4 * lane);
    const int vh = lane >> 5, d = (lane & 31) * 4;
    for (int r = gw; r < MX; r += NGW) {
        const int b = r >> 13, i = r & (SEQ - 1);
        u32x2 av[NH], cv[NH];
#pragma unroll
        for (int h = 0; h < NH; ++h) { const int inst0 = ((b * NH + h) * 2 + 0) * 2 + vh;
            av[h] = *(const u32x2*)(Ob + ((size_t)inst0 * SEQ + i) * DH + d); cv[h] = *(const u32x2*)(Ob + ((size_t)(inst0 + 2) * SEQ + i) * DH + d); }
#pragma unroll
        for (int h = 0; h < NH; ++h) {
            const u32x2 a = av[h], c = cv[h];
            float v[4] = {bflo(a.x) - lam * bflo(c.x), bfhi(a.x) - lam * bfhi(c.x), bflo(a.y) - lam * bflo(c.y), bfhi(a.y) - lam * bfhi(c.y)};
            const float ss = wave_sum_dpp((v[0] * v[0] + v[1] * v[1]) + (v[2] * v[2] + v[3] * v[3]));
            const float rs = 0.8f / sqrtf(ss * (1.0f / 256.0f) + EPS);
            *(u32x2*)(ATTO + (size_t)r * DM + h * 256 + 4 * lane) = (u32x2){pk2(v[0] * rs * sgv.x, v[1] * rs * sgv.y), pk2(v[2] * rs * sgv.z, v[3] * rs * sgv.w)};
        }
    }
    for (int t = gw; t < NMETA * NH; t += NGW) {
        const int qi = t >> 4, h = t & 15, j = lane & 15, part = lane >> 4;
        float am = 0.f;
#pragma unroll
        for (int c = 0; c < 2; ++c) {
            const bf16* qrow = Qb + ((size_t)(2 * h + c) * SKVP + qi) * DH + part * 32; const bf16* krow = Kb + ((size_t)(2 * h + c) * SKVP + j) * DH + part * 32;
            float s = 0.f;
#pragma unroll
            for (int e = 0; e < 4; ++e) { const u32x4 qv = *(const u32x4*)(qrow + 8 * e), kv = *(const u32x4*)(krow + 8 * e);
                s += bflo(qv.x) * bflo(kv.x) + bfhi(qv.x) * bfhi(kv.x) + bflo(qv.y) * bflo(kv.y) + bfhi(qv.y) * bfhi(kv.y) + bflo(qv.z) * bflo(kv.z) + bfhi(qv.z) * bfhi(kv.z) + bflo(qv.w) * bflo(kv.w) + bfhi(qv.w) * bfhi(kv.w); }
            s += __shfl_xor(s, 16); s += __shfl_xor(s, 32);
            s = (j <= qi) ? s * 0.08838834764831845f : -__builtin_inff();
            float mx = s; mx = fmaxf(mx, __shfl_xor(mx, 1)); mx = fmaxf(mx, __shfl_xor(mx, 2)); mx = fmaxf(mx, __shfl_xor(mx, 4)); mx = fmaxf(mx, __shfl_xor(mx, 8));
            const float e_ = expf(s - mx); float sm = e_; sm += __shfl_xor(sm, 1); sm += __shfl_xor(sm, 2); sm += __shfl_xor(sm, 4); sm += __shfl_xor(sm, 8);
            const float p_ = e_ / sm; am = c == 0 ? p_ : am - lam * p_;
        }
        float o[4] = {0.f, 0.f, 0.f, 0.f};
        for (int jj = 0; jj <= qi; ++jj) { const float aj = __shfl(am, jj); const u32x2 vv = *(const u32x2*)(Vb + ((size_t)(2 * h + vh) * SKVP + jj) * DH + d);
            o[0] += aj * bflo(vv.x); o[1] += aj * bfhi(vv.x); o[2] += aj * bflo(vv.y); o[3] += aj * bfhi(vv.y); }
        const float ss = wave_sum((o[0] * o[0] + o[1] * o[1]) + (o[2] * o[2] + o[3] * o[3]));
        const float rs = 0.8f / sqrtf(ss * (1.0f / 256.0f) + EPS);
        *(u32x2*)(ATTO + (size_t)(MX + qi) * DM + h * 256 + 4 * lane) = (u32x2){pk2(o[0] * rs * sgv.x, o[1] * rs * sgv.y), pk2(o[2] * rs * sgv.z, o[3] * rs * sgv.w)};
    }
    for (int m = MX + NMETA + gw; m < MP; m += NGW) zero_row(ATTO + (size_t)m * DM, nullptr, lane);
}

__device__ __forceinline__ f32x2 cpowf2(float dar, float dai, int tau) { const float m = expf((float)tau * dar), a = (float)tau * dai; return (f32x2){m * cosf(a), m * sinf(a)}; }
template <int CTRL, bool BC> __device__ __forceinline__ float dppf(float x) { return __builtin_bit_cast(float, __builtin_amdgcn_update_dpp(0, __builtin_bit_cast(int, x), CTRL, 0xF, 0xF, BC)); }
__device__ __forceinline__ f32x4 cmul_add2(f32x4 w, f32x4 v, f32x4 acc) {
    acc.x += w.x * v.x - w.y * v.y; acc.y += w.x * v.y + w.y * v.x; acc.z += w.z * v.z - w.w * v.w; acc.w += w.z * v.w + w.w * v.z; return acc; }
template <int CTRL, bool BC> __device__ __forceinline__ f32x4 dpp4(f32x4 v) { return (f32x4){dppf<CTRL, BC>(v.x), dppf<CTRL, BC>(v.y), dppf<CTRL, BC>(v.z), dppf<CTRL, BC>(v.w)}; }

__device__ __forceinline__ void s5_load_u(bf16x8 (&uf)[8], const bf16* rowbase  , int fq) {
#pragma unroll
    for (int kt = 0; kt < 8; ++kt) uf[kt] = *(const bf16x8*)(rowbase + (size_t)(2 * kt + (fq >> 1)) * DM + 8 * (fq & 1));
}
__device__ __forceinline__ void s5_bmat(f32x4 (&Lc)[8], const bf16x8 (&uf)[8], LAS unsigned char* bfr  ) {
#pragma unroll
    for (int mt = 0; mt < 8; ++mt) Lc[mt] = (f32x4){0.f, 0.f, 0.f, 0.f};
#pragma unroll
    for (int ks = 0; ks < 8; ++ks) { asm volatile("" ::: "memory");
#pragma unroll
        for (int mt = 0; mt < 8; ++mt) Lc[mt] = __builtin_amdgcn_mfma_f32_16x16x32_bf16(*(const LAS bf16x8*)(bfr + (mt * 8 + ks) * 1024), uf[ks], Lc[mt], 0, 0, 0); }
}
__device__ __forceinline__ void s5_scan(f32x4 (&Lc)[8], const LAS f32x4* wp  ) {
    asm volatile("" ::: "memory");
#pragma unroll
    for (int mt = 0; mt < 8; ++mt) { Lc[mt] = cmul_add2(wp[0 * 32 + mt * 4], dpp4<0x111, true>(Lc[mt]), Lc[mt]); }
    asm volatile("" ::: "memory");
#pragma unroll
    for (int mt = 0; mt < 8; ++mt) { Lc[mt] = cmul_add2(wp[1 * 32 + mt * 4], dpp4<0x112, true>(Lc[mt]), Lc[mt]); }
    asm volatile("" ::: "memory");
#pragma unroll
    for (int mt = 0; mt < 8; ++mt) { Lc[mt] = cmul_add2(wp[2 * 32 + mt * 4], dpp4<0x114, true>(Lc[mt]), Lc[mt]); }
    asm volatile("" ::: "memory");
#pragma unroll
    for (int mt = 0; mt < 8; ++mt) { Lc[mt] = cmul_add2(wp[3 * 32 + mt * 4], dpp4<0x118, true>(Lc[mt]), Lc[mt]); }
}

__device__ __forceinline__ void dbg4(float* dbg, int comp0, int fr, f32x4 v, bool dd) { if (dd) { float* p = dbg; asm volatile("" : "+v"(p)); p += comp0 * 16 + fr; p[0] = v.x; p[16] = v.y; p[32] = v.z; p[48] = v.w; } }
template <int DUMP> __device__ __forceinline__ void s5_tile(unsigned char* ws, const bf16* HN, bf16* Z, int b, int tl, int g, int fr, int fq, f32x4 (&carry)[8],
        LAS unsigned char* bfr, LAS unsigned char* cfr, LAS unsigned char* ktb, const LAS f32x4* wp, const LAS f32x4* cpw, const LAS f32x4* a256) {
                bf16x8 uf[8]; f32x4 Lc[8];
                const size_t row0 = (size_t)b * SEQ + (size_t)(16 * tl + fr) * 16;
                s5_load_u(uf, HN + row0 * DM + g * SGS, fq); s5_bmat(Lc, uf, bfr);
#if defined(CHK) && CHK
                float* dbg = (float*)(ws + WS_END + 8 * MiB); constexpr int dm = DUMP; const bool dd = (g == 37 && b == 0 && tl == 5);
                if constexpr ((dm & 1) != 0) {
_Pragma("unroll") for (int mt = 0; mt < 8; ++mt) dbg4(dbg, 0 * 128 + 16 * mt + 4 * fq, fr, Lc[mt], dd); }
#endif
                s5_scan(Lc, wp);
#if defined(CHK) && CHK
                if constexpr ((dm & 2) != 0) {
_Pragma("unroll") for (int mt = 0; mt < 8; ++mt) { dbg4(dbg, 1 * 128 + 16 * mt + 4 * fq, fr, Lc[mt], dd); dbg4(dbg, 3 * 128 + 16 * mt + 4 * fq, fr, carry[mt], dd); } }
#endif
                bf16x8 sf[4]; asm volatile("" ::: "memory");
#pragma unroll
                for (int ks = 0; ks < 4; ++ks) { f32x4 s0 = cmul_add2(cpw[(2 * ks) * 4], carry[2 * ks], dpp4<0x111, true>(Lc[2 * ks])), s1 = cmul_add2(cpw[(2 * ks + 1) * 4], carry[2 * ks + 1], dpp4<0x111, true>(Lc[2 * ks + 1]));
                    const u32x4 w = (u32x4){pk2(s0.x, s0.y), pk2(s0.z, s0.w), pk2(s1.x, s1.y), pk2(s1.z, s1.w)}; sf[ks] = __builtin_bit_cast(bf16x8, w);
#if defined(CHK) && CHK
                    if constexpr ((dm & 4) != 0) {
#if CHK_ALT == 1
                        const f32x4 d0 = dpp4<0x111, true>(Lc[2 * ks]), d1 = dpp4<0x111, true>(Lc[2 * ks + 1]);
#elif CHK_ALT == 2
                        const f32x4 d0 = s0 - dpp4<0x111, true>(Lc[2 * ks]), d1 = s1 - dpp4<0x111, true>(Lc[2 * ks + 1]);
#elif CHK_ALT == 3
                        const f32x4 d0 = carry[2 * ks], d1 = carry[2 * ks + 1];
#else
                        const f32x4 d0 = s0, d1 = s1;
#endif
                        dbg4(dbg, 2 * 128 + 16 * (2 * ks) + 4 * fq, fr, d0, dd); dbg4(dbg, 2 * 128 + 16 * (2 * ks + 1) + 4 * fq, fr, d1, dd); }
#endif
                }
                asm volatile("" ::: "memory");
#pragma unroll
                for (int mt = 0; mt < 8; ++mt) carry[mt] = cmul_add2(a256[mt * 4], carry[mt], dpp4<0x15F, false>(Lc[mt]));
                bf16* zrow = Z + row0 * DM + g * SGS + 4 * fq;
#pragma unroll
                for (int hf = 0; hf < 2; ++hf) {
                    f32x4 Y[8];
#pragma unroll
                    for (int m8 = 0; m8 < 8; ++m8) Y[m8] = (f32x4){0.f, 0.f, 0.f, 0.f};
#pragma unroll
                    for (int ks = 0; ks < 4; ++ks) { asm volatile("" ::: "memory");
#pragma unroll
                        for (int m8 = 0; m8 < 8; ++m8) Y[m8] = __builtin_amdgcn_mfma_f32_16x16x32_bf16(*(const LAS bf16x8*)(cfr + ((8 * hf + m8) * 4 + ks) * 1024), sf[ks], Y[m8], 0, 0, 0); }
#if defined(CHK) && CHK
                    if constexpr ((dm & 8) != 0) {
_Pragma("unroll") for (int m8 = 0; m8 < 8; ++m8) dbg4(dbg, 4 * 128 + 16 * (8 * hf + m8) + 4 * fq, fr, Y[m8], dd); }
#endif
#pragma unroll
                    for (int kt = 0; kt < 4 * hf + 4; ++kt) { asm volatile("" ::: "memory");
#pragma unroll
                        for (int m8 = 0; m8 < 8; ++m8) { const int mt = 8 * hf + m8; if (mt < 2 * kt) continue;
                            bf16x8 a = *(const LAS bf16x8*)(ktb + (mt - 2 * kt) * 512);
                            if (mt == 2 * kt && fq >= 2) a = (bf16x8){0, 0, 0, 0, 0, 0, 0, 0};
                            Y[m8] = __builtin_amdgcn_mfma_f32_16x16x32_bf16(a, uf[kt], Y[m8], 0, 0, 0); } }
#if defined(CHK) && CHK
                    if constexpr ((dm & 16) != 0) {
_Pragma("unroll") for (int m8 = 0; m8 < 8; ++m8) dbg4(dbg, 6 * 128 + 16 * (8 * hf + m8) + 4 * fq, fr, Y[m8], dd); }
#endif
#pragma unroll
                    for (int m8 = 0; m8 < 8; ++m8) { float o[4];
#pragma unroll
                        for (int i = 0; i < 4; ++i) { const float y = Y[m8][i]; o[i] = y * __builtin_amdgcn_rcpf(1.0f + __builtin_amdgcn_exp2f(-2.3022082f * (y + 0.044715f * y * y * y))); }
                        *(u32x2*)(zrow + (size_t)(8 * hf + m8) * DM) = (u32x2){pk2(o[0], o[1]), pk2(o[2], o[3])}; }
                }
}
template <int DMASK> __device__ __forceinline__ void s5_phase(const Ptrs& P, LAS unsigned char* lds, int vcu, int G, int tid, bool tables_only = false) {
    const int wave = __builtin_amdgcn_readfirstlane(tid >> 6), lane = tid & 63, fr = lane & 15, fq = lane >> 4;
    const bf16* HN = (const bf16*)(P.ws + WS_HN); bf16* Z = (bf16*)(P.ws + WS_ATTO);
    for (int g = vcu; g < SG; g += G) {
        __syncthreads();
        const float dt = expf(P.log_dt[g]);
        LAS f32x2* Apow = (LAS f32x2*)(lds + S5_F);
        LAS f32x2* Bbar = (LAS f32x2*)(lds + S5_CFRAG);
        for (int e = tid; e < 17 * 64; e += 512) { const int tau = e >> 6, p = e & 63; Apow[e] = cpowf2(dt * P.a_re[g * SP + p], dt * P.a_im[g * SP + p], tau); }
        for (int e = tid; e < SP * SGS; e += 512) { const int p = e >> 4;
            const float ar = P.a_re[g * SP + p], ai = P.a_im[g * SP + p]; const f32x2 ab_ = cpowf2(dt * ar, dt * ai, 1);
            const float nr = ab_.x - 1.0f, ni = ab_.y, den = ar * ar + ai * ai, fre = (nr * ar + ni * ai) / den, fim = (ni * ar - nr * ai) / den;
            const float br = P.b_re[(size_t)g * SP * SGS + e], bi = P.b_im[(size_t)g * SP * SGS + e];
            Bbar[e] = (f32x2){fre * br - fim * bi, fre * bi + fim * br}; }
        __syncthreads();
        for (int f = tid; f < 4096; f += 512) {
            const int l2 = f & 63, ks = (f >> 6) & 7, mt = f >> 9, comp = 16 * mt + (l2 & 15), p = comp >> 1, ri = comp & 1; float v[8];
#pragma unroll
            for (int j = 0; j < 8; ++j) { const int k = 32 * ks + 8 * (l2 >> 4) + j, s = k >> 4, hh = k & 15; const f32x2 pw = Apow[(15 - s) * 64 + p], bb = Bbar[p * 16 + hh];
                v[j] = ri ? (pw.x * bb.y + pw.y * bb.x) : (pw.x * bb.x - pw.y * bb.y); }
            *(LAS u32x4*)(lds + S5_BFRAG + f * 16) = (u32x4){pk2(v[0], v[1]), pk2(v[2], v[3]), pk2(v[4], v[5]), pk2(v[6], v[7])}; }
        for (int e = tid; e < 4096; e += 512) {
            const int hp = e & 15, h = (e >> 4) & 15, tau = e >> 8; float acc = 0.f;
            const float* cr = P.c_re + ((size_t)g * SGS + h) * SP; const float* ci = P.c_im + ((size_t)g * SGS + h) * SP;
            for (int p = 0; p < SP; ++p) { const f32x2 pw = Apow[tau * 64 + p], bb = Bbar[p * 16 + hp]; const float wr_ = pw.x * bb.x - pw.y * bb.y, wi_ = pw.x * bb.y + pw.y * bb.x; acc += cr[p] * wr_ - ci[p] * wi_; }
            if (tau == 0 && h == hp) acc += P.dsk[g * SGS + h];
            ((LAS bf16*)(lds + S5_KTAB))[e] = (bf16)(pk2(acc, 0.f) & 0xffffu); }
        for (int e = tid; e < 16 * 64 + 4 * 64 + 64 + 64; e += 512) {
            int tau, off; const int p = e & 63;
            if (e < 1024) { tau = 16 * (e >> 6); off = S5_CPOW + e * 8; } else if (e < 1280) { tau = 16 << ((e - 1024) >> 6); off = S5_WPOW + (e - 1024) * 8; }
            else if (e < 1344) { tau = 256; off = S5_A256 + p * 8; } else { tau = 1024; off = S5_A1024 + p * 8; }
            *(LAS f32x2*)(lds + off) = cpowf2(dt * P.a_re[g * SP + p], dt * P.a_im[g * SP + p], tau); }
        __syncthreads();
        for (int f = tid; f < 4096; f += 512) {
            const int l2 = f & 63, ks = (f >> 6) & 3, mt = f >> 8, h = l2 & 15; float v[8];
            const float* cr = P.c_re + ((size_t)g * SGS + h) * SP; const float* ci = P.c_im + ((size_t)g * SGS + h) * SP;
#pragma unroll
            for (int j = 0; j < 8; ++j) { const int comp = 16 * (2 * ks + (j >> 2)) + 4 * (l2 >> 4) + (j & 3), p = comp >> 1, ri = comp & 1; const f32x2 pw = Apow[(mt + 1) * 64 + p];
                v[j] = ri ? (-cr[p] * pw.y - ci[p] * pw.x) : (cr[p] * pw.x - ci[p] * pw.y); }
            *(LAS u32x4*)(lds + S5_CFRAG + f * 16) = (u32x4){pk2(v[0], v[1]), pk2(v[2], v[3]), pk2(v[4], v[5]), pk2(v[6], v[7])}; }
        __syncthreads();
        if (tables_only) continue;
        LAS unsigned char* bfr = lds + S5_BFRAG + lane * 16; LAS unsigned char* cfr = lds + S5_CFRAG + lane * 16;
        LAS unsigned char* ktb = lds + S5_KTAB + ((fr * 16 + 8 * (fq & 1)) * 2) - (fq >> 1) * 512;
        const LAS f32x4* wp = (const LAS f32x4*)(lds + S5_WPOW) + fq;
        const LAS f32x4* cpw = (const LAS f32x4*)(lds + S5_CPOW) + fr * 32 + fq;
        const LAS f32x4* a256 = (const LAS f32x4*)(lds + S5_A256) + fq; const LAS f32x4* a1024 = (const LAS f32x4*)(lds + S5_A1024) + fq;
        LAS f32x4* Fw = (LAS f32x4*)(lds + S5_F); LAS f32x4* Em = (LAS f32x4*)(lds + S5_EMETA);
        bf16x8 uf[8]; f32x4 Lc[8];
        if (wave == 0) {
            s5_load_u(uf, HN + (size_t)MX * DM + g * SGS, fq); s5_bmat(Lc, uf, bfr);
            if (fr == 0) {
#pragma unroll
                for (int mt = 0; mt < 8; ++mt) Em[mt * 4 + fq] = Lc[mt]; }
        }
#pragma unroll 1
        for (int b = 0; b < NB; ++b) {
            f32x4 seg[8];
#pragma unroll
            for (int mt = 0; mt < 8; ++mt) seg[mt] = (f32x4){0.f, 0.f, 0.f, 0.f};
#pragma unroll 1
            for (int tl = 4 * wave; tl < 4 * wave + 4; ++tl) {
                s5_load_u(uf, HN + ((size_t)b * SEQ + (size_t)(16 * tl + fr) * 16) * DM + g * SGS, fq); s5_bmat(Lc, uf, bfr); s5_scan(Lc, wp);
                asm volatile("" ::: "memory");
#pragma unroll
                for (int mt = 0; mt < 8; ++mt) seg[mt] = cmul_add2(a256[mt * 4], seg[mt], dpp4<0x15F, false>(Lc[mt]));
            }
            if (fr == 0) {
#pragma unroll
                for (int mt = 0; mt < 8; ++mt) Fw[(b * 8 + wave) * 32 + mt * 4 + fq] = seg[mt]; }
            __syncthreads();
            f32x4 carry[8];
#pragma unroll
            for (int mt = 0; mt < 8; ++mt) carry[mt] = Em[mt * 4 + fq];
            for (int w2 = 0; w2 < wave; ++w2) {
#pragma unroll
                for (int mt = 0; mt < 8; ++mt) carry[mt] = cmul_add2(a1024[mt * 4], carry[mt], Fw[(b * 8 + w2) * 32 + mt * 4 + fq]); }
#pragma unroll 1
            for (int tl = 4 * wave; tl < 4 * wave + 4; ++tl) {
                                s5_tile<DMASK>(P.ws, HN, Z, b, tl, g, fr, fq, carry, bfr, cfr, ktb, wp, cpw, a256);
            }
        }
    }
}

#ifndef PH_ALL
#define PH_ALL 1
#endif
#ifndef PH_P0
#define PH_P0 PH_ALL
#endif
#ifndef PH_QKV
#define PH_QKV PH_ALL
#endif
#ifndef PH_ROPE
#define PH_ROPE PH_ALL
#endif
#ifndef PH_ATTN
#define PH_ATTN PH_ALL
#endif
#ifndef PH_COMB
#define PH_COMB PH_ALL
#endif
#ifndef PH_WO
#define PH_WO PH_ALL
#endif
#ifndef PH_NORM
#define PH_NORM PH_ALL
#endif
#ifndef PH_UP
#define PH_UP PH_ALL
#endif
#ifndef PH_DN
#define PH_DN PH_ALL
#endif
#ifndef PH_S5
#define PH_S5 PH_ALL
#endif
#ifndef PH_GLU
#define PH_GLU PH_ALL
#endif
struct Args { const float* in[22]; float* out; unsigned char* ws; int ph_lo, ph_hi; };
__device__ __forceinline__ Ptrs load_ptrs() {
    const __attribute__((address_space(4))) Args* ap = (const __attribute__((address_space(4))) Args*)__builtin_amdgcn_kernarg_segment_ptr();
    asm volatile("" : "+s"(ap));
    Ptrs P;
    P.x = ap->in[0]; P.meta = ap->in[1]; P.g_mix = ap->in[2]; P.g_mlp = ap->in[3]; P.wqkv = ap->in[4]; P.qg = ap->in[5]; P.kg = ap->in[6]; P.lamv = ap->in[7]; P.sg = ap->in[8]; P.wo = ap->in[9];
    P.a_re = ap->in[10]; P.a_im = ap->in[11]; P.log_dt = ap->in[12]; P.b_re = ap->in[13]; P.b_im = ap->in[14]; P.c_re = ap->in[15]; P.c_im = ap->in[16]; P.dsk = ap->in[17]; P.wglu = ap->in[18]; P.bglu = ap->in[19];
    P.wup = ap->in[20]; P.wdn = ap->in[21]; P.out = ap->out; P.ws = ap->ws;
    return P;
}
#if defined(HV_DEBUG)
#define HV_DBG(ok) do { if (!(ok) && blockIdx.x == 0 && threadIdx.x == 0) { const unsigned long long t0_ = __builtin_amdgcn_s_memrealtime(); while (__builtin_amdgcn_s_memrealtime() - t0_ < 20000ull) __builtin_amdgcn_s_sleep(8); } } while (0)
#else
#define HV_DBG(ok) do {} while (0)
#endif
#define PHASE_VARS() const Ptrs P = load_ptrs(); int tid = tid_fresh(); const int lane = tid & 63, wave = __builtin_amdgcn_readfirstlane(tid >> 6); \
    const int G = gridDim.x, bx = blockIdx.x, vcu = (G % 8 == 0) ? (bx % 8) * (G / 8) + bx / 8 : bx; const int gw = vcu * 8 + wave, NGW = G * 8; (void)lane; (void)gw; (void)NGW; (void)vcu; \
    int hvcu = vcu; { const volatile LAS unsigned* M_ = (const volatile LAS unsigned*)(lds + MISC_OFF); bool ok_ = (G == 256); const unsigned* xr_ = (const unsigned*)(P.ws + WS_CTL) + CW_XRANK; \
      for (int j_ = 0; j_ < 8; ++j_) ok_ = ok_ && (__hip_atomic_load(xr_ + 64 * j_, __ATOMIC_RELAXED, __HIP_MEMORY_SCOPE_AGENT) == 32u); if (ok_) hvcu = (int)(M_[16] * 32u + M_[17]); hvcu = __builtin_amdgcn_readfirstlane(hvcu); HV_DBG(ok_); } (void)hvcu; const int hbx = (G == 256) ? (hvcu & 31) * 8 + (hvcu >> 5) : bx; (void)hbx; \
    bf16* H = (bf16*)(P.ws + WS_H); bf16* HN = (bf16*)(P.ws + WS_HN); bf16* ATTO = (bf16*)(P.ws + WS_ATTO); bf16* MID = (bf16*)(P.ws + WS_MID); \
    bf16* Qb = (bf16*)(P.ws + WS_Q); bf16* Kb = (bf16*)(P.ws + WS_K); bf16* Vb = (bf16*)(P.ws + WS_V); bf16* Ob = (bf16*)(P.ws + WS_O); \
    const bf16* Wqkv_t = (const bf16*)(P.ws + WS_WQKV); const bf16* Wo_t = (const bf16*)(P.ws + WS_WO); const bf16* Wglu_t = (const bf16*)(P.ws + WS_WGLU); \
    const bf16* Wup_t = (const bf16*)(P.ws + WS_WUP); const bf16* Wdn_t = (const bf16*)(P.ws + WS_WDN); \
    (void)H; (void)HN; (void)ATTO; (void)MID; (void)Qb; (void)Kb; (void)Vb; (void)Ob; (void)Wqkv_t; (void)Wo_t; (void)Wglu_t; (void)Wup_t; (void)Wdn_t;

__global__ void __launch_bounds__(512, 2) fwd_kernel(Args args) {
    extern __shared__ __attribute__((aligned(16))) unsigned char lds_raw[];
    LAS unsigned char* lds = (LAS unsigned char*)lds_raw;
    (void)args;
    int ph_lo_, ph_hi_; { const __attribute__((address_space(4))) Args* ap = (const __attribute__((address_space(4))) Args*)__builtin_amdgcn_kernarg_segment_ptr(); ph_lo_ = ap->ph_lo; ph_hi_ = ap->ph_hi; }
#define RUN(k) (ph_lo_ <= (k) && (k) < ph_hi_)
#if defined(PROBE_W)
#define STAMP(k) do { if (blockIdx.x == 0 && threadIdx.x == 0) { const Ptrs Ps = load_ptrs(); ((volatile unsigned long long*)(Ps.ws + WS_CTL + 65536))[k] = __builtin_amdgcn_s_memrealtime(); } } while (0)
#else
#define STAMP(k) do {} while (0)
#endif
    STAMP(0);
    XcdBarrier bar;
    { PHASE_VARS();
      volatile LAS unsigned* MISC = (volatile LAS unsigned*)(lds + MISC_OFF);
      if (tid < 32) MISC[tid] = 0u;
      __syncthreads();
      bar = xcd_barrier_post((unsigned*)(P.ws + WS_CTL) + CW_BAR, MISC + 8);
      if (tid == 0) { const unsigned xcc = xb_xcc_id() & 7u; MISC[16] = xcc; MISC[17] = __hip_atomic_fetch_add((unsigned*)(P.ws + WS_CTL) + CW_XRANK + 64 * xcc, 1u, __ATOMIC_RELAXED, __HIP_MEMORY_SCOPE_AGENT); }
      __syncthreads(); }

#if PH_P0
    if (RUN(0)) {
    { PHASE_VARS(); p0_prologue(P, lds, gw, NGW, wave, lane); }
    }
#endif
    if (RUN(0) && RUN(1)) xcd_barrier(bar);
    STAMP(1);
#if PH_QKV
    if (RUN(1)) {
    { PHASE_VARS(); pg8::Gemm g{HN, Wqkv_t, MX, 3 * DM, DM}; pg8::StaticOrder S; S.init(MX, 3 * DM, G, hbx); pg8::EpiQKV E{Qb, QKV_T_BYTES / 2};
      pg8::gemm_phase<pg8::EpiQKV, pg8::StaticOrder, true, GEMM_SP2>(lds, g, S, E);
      skinny16(lds, HN + (size_t)MX * DM, Wqkv_t, DM, 3 * DM, 1, vcu, G, tid, SkQKV{Qb}); }
    }
#endif
    if (RUN(1) && RUN(2)) xcd_barrier(bar);
    STAMP(2);
#if PH_ROPE
    if (RUN(2)) {
    { PHASE_VARS(); qk_rope_phase(Qb, Kb, P.qg, P.kg, gw, NGW, lane); }
    }
#endif
    if (RUN(2) && RUN(3)) xcd_barrier(bar);
    STAMP(3);
#if PH_ATTN
    if (RUN(3)) {
    { PHASE_VARS();
      ab::da_phase((char*)lds_raw, Qb, Kb, Vb, Ob, hvcu, G, SKVP, SEQ, NMETA); }
    }
#endif
    if (RUN(3) && RUN(4)) xcd_barrier(bar);
    STAMP(4);
#if PH_COMB
    if (RUN(4)) {
    { PHASE_VARS();
#if defined(DA_TESTRUN)
      ab::da_phase((char*)lds_raw, Qb, Kb, Vb, Ob, hvcu, G, SKVP, SEQ, NMETA, DA_TESTRUN); __syncthreads();
#endif
      combine_phase(P, gw, NGW, lane); }
    }
#endif
    if (RUN(4) && RUN(5)) xcd_barrier(bar);
    STAMP(5);
#if PH_WO
    if (RUN(5)) {
    { PHASE_VARS(); pg8::Gemm g{ATTO, Wo_t, MX, DM, DM}; pg8::StaticOrder S; S.init(MX, DM, G, hbx); pg8::EpiRes<true, false, true> E{P.x, H, (float*)(P.ws + WS_PART)};
      pg8::gemm_phase<pg8::EpiRes<true, false, true>, pg8::StaticOrder, true, GEMM_SP2>(lds, g, S, E);
      skinny16(lds, ATTO + (size_t)MX * DM, Wo_t, DM, DM, 1, vcu, G, tid, SkRes{H}); }
    }
#endif
    if (RUN(5) && RUN(6)) xcd_barrier(bar);
    STAMP(6);
#if PH_NORM
    if (RUN(6)) {
    { PHASE_VARS(); rstd_phase((const float*)(P.ws + WS_PART), 64, (float*)(P.ws + WS_RSTD), H, true, gw, NGW, lane); }
    }
#endif
    if (RUN(6) && RUN(7)) xcd_barrier(bar);
    STAMP(7);
#if PH_UP
    if (RUN(7)) {
    { PHASE_VARS(); pg8::Gemm g{H, Wup_t, MX, FF, DM}; pg8::StaticOrder S; S.init(MX, FF, G, hbx); pg8::EpiRelu2 E{MID, FF, (const float*)(P.ws + WS_RSTD)};
      pg8::gemm_phase<pg8::EpiRelu2, pg8::StaticOrder, true, GEMM_SP2>(lds, g, S, E);
      skinny16(lds, H + (size_t)MX * DM, Wup_t, DM, FF, 1, vcu, G, tid, SkRelu2{MID, (const float*)(P.ws + WS_RSTD)}); }
    }
#endif
    if (RUN(7) && RUN(8)) xcd_barrier(bar);
    STAMP(8);
#if PH_DN
    if (RUN(8)) {
    { PHASE_VARS(); pg8::Gemm g{MID, Wdn_t, MX, DM, FF}; pg8::StaticOrder S; S.init(MX, DM, G, hbx); pg8::EpiRes<false, false> E{H, H, nullptr};
      pg8::gemm_phase<pg8::EpiRes<false, false>, pg8::StaticOrder, true, GEMM_SP2>(lds, g, S, E);
      skinny16(lds, MID + (size_t)MX * FF, Wdn_t, FF, DM, 4, vcu, G, tid, SkPart{(float*)(P.ws + WS_MPART)}); }
    }
#endif
    if (RUN(8) && RUN(9)) xcd_barrier(bar);
    STAMP(9);
#if PH_NORM
    if (RUN(9)) {
    { PHASE_VARS();
      if (gw < NMETA) {
          bf16* hr = H + (size_t)(MX + gw) * DM; const float* pp = (const float*)(P.ws + WS_MPART) + (size_t)gw * DM;
#pragma unroll 4
          for (int j = 0; j < 16; ++j) { const int o = 4 * (lane + 64 * j); const u32x2 w = *(const u32x2*)(hr + o); f32x4 v = (f32x4){bflo(w.x), bfhi(w.x), bflo(w.y), bfhi(w.y)};
              v += *(const f32x4*)(pp + o); v += *(const f32x4*)(pp + (size_t)NMETA * DM + o); v += *(const f32x4*)(pp + (size_t)2 * NMETA * DM + o); v += *(const f32x4*)(pp + (size_t)3 * NMETA * DM + o);
              *(u32x2*)(hr + o) = (u32x2){pk2(v.x, v.y), pk2(v.z, v.w)}; }
          asm volatile("s_waitcnt vmcnt(0)" ::: "memory"); }
      norm_phase(H, P.g_mix + DM, HN, MX + NMETA, gw, NGW, lane); }
    }
#endif
    if (RUN(9) && RUN(10)) xcd_barrier(bar);
    STAMP(10);
#if PH_S5
    if (RUN(10)) {
    { PHASE_VARS();
#if defined(S5_TESTRUN)
      s5_phase<0>(P, lds, vcu, G, tid, true); __syncthreads();
#endif
      s5_phase<0>(P, lds, vcu, G, tid); }
    }
#endif
    if (RUN(10) && RUN(11)) xcd_barrier(bar);
    STAMP(11);
#if PH_GLU
    if (RUN(11)) {
    { PHASE_VARS(); pg8::Gemm g{ATTO, Wglu_t, MX, 2 * DM, DM}; pg8::StaticOrder S; S.init(MX, 2 * DM, G, hbx); pg8::EpiGlu E{H, P.bglu, (float*)(P.ws + WS_PART)};
      pg8::gemm_phase<pg8::EpiGlu, pg8::StaticOrder, true, GEMM_SP2>(lds, g, S, E); }
    }
#endif
    if (RUN(11) && RUN(12)) xcd_barrier(bar);
    STAMP(12);
#if PH_NORM
    if (RUN(12)) {
    { PHASE_VARS(); rstd_phase((const float*)(P.ws + WS_PART), 128, (float*)(P.ws + WS_RSTD), H, false, gw, NGW, lane); }
    }
#endif
    if (RUN(12) && RUN(13)) xcd_barrier(bar);
    STAMP(13);
#if PH_UP
    if (RUN(13)) {
    { PHASE_VARS(); pg8::Gemm g{H, Wup_t + (size_t)DM * FF, MX, FF, DM}; pg8::StaticOrder S; S.init(MX, FF, G, hbx); pg8::EpiRelu2 E{MID, FF, (const float*)(P.ws + WS_RSTD)};
      pg8::gemm_phase<pg8::EpiRelu2, pg8::StaticOrder, true, GEMM_SP2>(lds, g, S, E); }
    }
#endif
    if (RUN(13) && RUN(14)) xcd_barrier(bar);
    STAMP(14);
#if PH_DN
    if (RUN(14)) {
    { PHASE_VARS(); pg8::Gemm g{MID, Wdn_t + (size_t)DM * FF, MX, DM, FF}; pg8::StaticOrder S; S.init(MX, DM, G, hbx); pg8::EpiRes<false, true> E{H, P.out, nullptr};
      pg8::gemm_phase<pg8::EpiRes<false, true>, pg8::StaticOrder, true, GEMM_SP2>(lds, g, S, E); }
    }
#endif
#if defined(PROBE_W)
    STAMP(15);
    if (blockIdx.x == 0 && threadIdx.x == 0) { const Ptrs Ps = load_ptrs(); volatile unsigned long long* st = (volatile unsigned long long*)(Ps.ws + WS_CTL + 65536); const int w[15] = PROBE_W; unsigned long long dur = 0;
#pragma unroll
        for (int k = 0; k < 15; ++k) dur += (unsigned long long)w[k] * (st[k + 1] - st[k]);
        const unsigned long long t0 = __builtin_amdgcn_s_memrealtime(); while (__builtin_amdgcn_s_memrealtime() - t0 < dur) __builtin_amdgcn_s_sleep(8); }
#endif
}

#undef STAMP
#undef RUN
#if defined(CHK) && CHK && defined(CHK_DUMP)
__global__ void __launch_bounds__(512, 2) s5_dbg_kernel(Args args) {
    extern __shared__ __attribute__((aligned(16))) unsigned char lds_raw[];
    LAS unsigned char* lds = (LAS unsigned char*)lds_raw; (void)args;
    PHASE_VARS(); s5_phase<CHK_DUMP>(P, lds, vcu, G, tid);
}
#endif
extern "C" void kernel_launch(void* const* d_in, const int* in_sizes, int n_in, void* d_out, int out_size, void* d_ws, size_t ws_size, hipStream_t stream) {
    static int grid = 0;
    if (grid == 0) {
        if (n_in != 22 || in_sizes[0] != MX * DM || out_size != MX * DM || ws_size < WS_END + 16 * MiB) {
            fprintf(stderr, "kernel_launch: built for 22 inputs, x/out of %d floats, >= %zu bytes of workspace; got n_in %d, in0 %d, out %d, ws %zu; nothing launched\n", MX * DM, (size_t)WS_END, n_in, n_in > 0 ? in_sizes[0] : -1, out_size, ws_size); grid = -1; return; }
        int dev = 0, cus = 0, per_cu = 0;
        if (hipGetDevice(&dev) != hipSuccess || hipDeviceGetAttribute(&cus, hipDeviceAttributeMultiprocessorCount, dev) != hipSuccess) { fprintf(stderr, "kernel_launch: device query failed\n"); grid = -1; return; }
        if (hipFuncSetAttribute((const void*)fwd_kernel, hipFuncAttributeMaxDynamicSharedMemorySize, LDS_BYTES) != hipSuccess) { fprintf(stderr, "kernel_launch: hipFuncSetAttribute(%d B LDS) failed\n", LDS_BYTES); grid = -1; return; }
        if (hipOccupancyMaxActiveBlocksPerMultiprocessor(&per_cu, (const void*)fwd_kernel, 512, LDS_BYTES) != hipSuccess || per_cu < 1)
            fprintf(stderr, "kernel_launch: note: occupancy query reports %d workgroups per CU; launching one per CU anyway (%d B LDS)\n", per_cu, LDS_BYTES);
        (void)hipGetLastError();
        grid = cus;
    }
    if (grid < 0) return;
    if (hipMemsetAsync((char*)d_ws + WS_CTL, 0, CTL_ZERO_BYTES, stream) != hipSuccess) { fprintf(stderr, "kernel_launch: memset failed\n"); return; }
    Args a{};
    for (int i = 0; i < 22; ++i) a.in[i] = (const float*)d_in[i];
    a.out = (float*)d_out; a.ws = (unsigned char*)d_ws;
#if defined(CHK) && CHK
    (void)hipMemsetAsync((char*)d_ws + WS_RES, 0, 1024, stream);
    for (int k = 0; k < 15; ++k) {
        if (k == 8 || k == 11) hipLaunchKernelGGL(chk_snap, dim3(64), dim3(256), 0, stream, (const float*)((char*)d_ws + WS_H), (float*)((char*)d_ws + WS_SNAP));
        a.ph_lo = k; a.ph_hi = k + 1;
        hipLaunchKernelGGL(fwd_kernel, dim3(grid), dim3(512), LDS_BYTES, stream, a);
        if (k == 3) hipLaunchKernelGGL(chk_attn, dim3(48), dim3(128), 0, stream, a);
        else if (k == 10) { hipLaunchKernelGGL(chk_s5, dim3(12), dim3(64), 0, stream, a);
#if defined(CHK_DUMP)
            (void)hipFuncSetAttribute((const void*)s5_dbg_kernel, hipFuncAttributeMaxDynamicSharedMemorySize, LDS_BYTES);
            hipLaunchKernelGGL(s5_dbg_kernel, dim3(grid), dim3(512), LDS_BYTES, stream, a);
            hipLaunchKernelGGL(chk_s5_int, dim3(1), dim3(64), 0, stream, a);
#endif
        }
        else hipLaunchKernelGGL(chk_kernel, dim3(64), dim3(64), 0, stream, a, k);
    }
    hipLaunchKernelGGL(chk_report, dim3(1), dim3(1), 0, stream, a);
#else
    a.ph_lo = 0; a.ph_hi = 15;
    hipLaunchKernelGGL(fwd_kernel, dim3(grid), dim3(512), LDS_BYTES, stream, a);
#endif
    const hipError_t le = hipPeekAtLastError();
    if (le != hipSuccess) fprintf(stderr, "kernel_launch: launch failed: %s\n", hipGetErrorName(le));
}
```

```cpp
#include <hip/hip_runtime.h>
#include <cstdio>
#include <cstdint>
__device__ __forceinline__ int tid_fresh() { int t = threadIdx.x; asm volatile("" : "+v"(t)); return t; }
namespace pg8 {
#define PG8_LAS __attribute__((address_space(3)))
typedef unsigned short bf16_t;
typedef short bf16x8 __attribute__((ext_vector_type(8)));
typedef float f32x4 __attribute__((ext_vector_type(4)));
typedef unsigned u32x4 __attribute__((ext_vector_type(4)));
constexpr int BM = 256, BK = 64, HALF = 128, HTB = HALF * BK * 2  , STAGE_BYTES = 8 * HTB, NXCD = 8, WGM = 8;

__host__ __device__ __forceinline__ int lds_byte(int r, int c) { const int st = (r >> 4) * 2 + (c >> 5), rr = r & 15, cc = c & 31, ob = rr * 64 + cc * 2; return st * 1024 + (ob ^ (((ob >> 9) & 1) << 5)); }
__host__ __device__ __forceinline__ void stage_rc(int b, int& R, int& C) { const int st = b / 1024, sb = b % 1024, swz = sb ^ (((sb >> 9) & 1) << 5); R = (st >> 1) * 16 + swz / 64; C = (st & 1) * 32 + (swz % 64) / 2; }
__host__ __device__ __forceinline__ int perm32(int rho) { const int n = rho >> 4, i = rho & 15; return 8 * (i >> 2) + 4 * n + (i & 3); }

struct Unit { int pm, pn; };
struct Gemm { const bf16_t* A; const bf16_t* Bt; int M, N, K; };

struct StaticOrder {
    int nM, nN, nwg, G, c;
    __host__ __device__ void init(int M, int N, int G_, int c_) { nM = M / BM; nN = N / BM; nwg = nM * nN; G = G_; c = c_; }
    __host__ __device__ bool next(int i, Unit& u) const {
        const long L = (long)i * G + c; if (L >= nwg) return false;
        int wgid = (int)L; { const int q = nwg / NXCD, r = nwg % NXCD, xcd = wgid % NXCD, off = wgid / NXCD; wgid = (xcd < r ? xcd * (q + 1) : r * (q + 1) + (xcd - r) * q) + off; }
        const int nig = WGM * nN, gid = wgid / nig, fm = gid * WGM, gsz = (nM - fm) < WGM ? (nM - fm) : WGM;
        u.pm = fm + ((wgid % nig) % gsz); u.pn = (wgid % nig) / gsz; return true;
    }
    __device__ __forceinline__ void a_ready(const Unit&) const {}
    __device__ __forceinline__ void done(const Unit&) const {}
};
typedef unsigned u32x2v __attribute__((ext_vector_type(2)));
__device__ __forceinline__ unsigned cvt_pk_bf16(float lo, float hi) { unsigned r; asm volatile("v_cvt_pk_bf16_f32 %0, %1, %2" : "=v"(r) : "v"(lo), "v"(hi)); return r; }
constexpr int E_SKVP = 8256, E_NMETA = 16, E_MXP = 64  ;
struct EpiQKV {
    static constexpr bool PERM = true, AFTER_DRAIN = false;
    bf16_t* Q; size_t sec_stride;
    __device__ __forceinline__ void operator()(const f32x4 (&acc)[2][2][4][2], const Unit& u, int wr, int wc, int fr, int fq) const {
        const int sec = u.pn >> 4; bf16_t* base = Q + (size_t)sec * sec_stride;
        const int hid0 = (u.pn & 15) * 2, d0 = wc * 32 + 8 * fq;
        const bool meta = u.pm >= E_MXP; const int b = meta ? 0 : (u.pm >> 5), pos0 = meta ? 0 : E_NMETA + (u.pm & 31) * 256;
#pragma unroll
        for (int ai = 0; ai < 2; ++ai)
#pragma unroll
            for (int m = 0; m < 4; ++m) { const int r = ai * HALF + wr * 64 + m * 16 + fr;
                if (meta && r >= E_NMETA) continue;
#pragma unroll
                for (int bj = 0; bj < 2; ++bj) { const f32x4 v0 = acc[ai][bj][m][0], v1 = acc[ai][bj][m][1];
                    u32x4 w; w.x = cvt_pk_bf16(v0[0], v0[1]); w.y = cvt_pk_bf16(v0[2], v0[3]); w.z = cvt_pk_bf16(v1[0], v1[1]); w.w = cvt_pk_bf16(v1[2], v1[3]);
                    bf16_t* dst = base + ((size_t)(b * 32 + hid0 + bj) * E_SKVP + pos0 + r) * 128 + d0;
                    *(u32x4*)dst = w;
                    if (meta) *(u32x4*)(dst + (size_t)32 * E_SKVP * 128) = w; } }
    }
};
__device__ __forceinline__ f32x4 bf4_to_f32(u32x2v w) { return (f32x4){__builtin_bit_cast(float, w.x << 16), __builtin_bit_cast(float, w.x & 0xffff0000u), __builtin_bit_cast(float, w.y << 16), __builtin_bit_cast(float, w.y & 0xffff0000u)}; }
template <bool BASE_F32, bool OUT_F32, bool STATS = false> struct EpiRes {
    static constexpr bool PERM = false, AFTER_DRAIN = false;
    const void* base; void* out; float* part;
    __device__ __forceinline__ void operator()(const f32x4 (&acc)[2][2][4][2], const Unit& u, int wr, int wc, int fr, int fq) const {
        const int row0 = u.pm * BM + wr * 64 + fr, col0 = u.pn * BM + wc * 32 + 4 * fq;
#pragma unroll
        for (int ai = 0; ai < 2; ++ai)
#pragma unroll
            for (int m = 0; m < 4; ++m) { const size_t off = (size_t)(row0 + ai * HALF + m * 16) * 4096 + col0; float ssq = 0.f;
#pragma unroll
                for (int bj = 0; bj < 2; ++bj)
#pragma unroll
                    for (int n = 0; n < 2; ++n) { const size_t o2 = off + bj * HALF + n * 16;
                        f32x4 bs; if (BASE_F32) bs = *(const f32x4*)((const float*)base + o2); else bs = bf4_to_f32(*(const u32x2v*)((const bf16_t*)base + o2));
                        const f32x4 r = bs + acc[ai][bj][m][n];
                        if (STATS) ssq += (r[0] * r[0] + r[1] * r[1]) + (r[2] * r[2] + r[3] * r[3]);
                        if (OUT_F32) *(f32x4*)((float*)out + o2) = r; else *(u32x2v*)((bf16_t*)out + o2) = (u32x2v){cvt_pk_bf16(r[0], r[1]), cvt_pk_bf16(r[2], r[3])}; }
                if (STATS) { ssq += __shfl_xor(ssq, 16); ssq += __shfl_xor(ssq, 32); if (fq == 0) part[(size_t)(row0 + ai * HALF + m * 16) * 128 + 4 * u.pn + wc] = ssq; }
                if (m & 1) asm volatile("" ::: "memory"); }
    }
};
struct EpiRelu2 {
    static constexpr bool PERM = true, AFTER_DRAIN = false;
    bf16_t* O; int ldc; const float* rstd;
    __device__ __forceinline__ void operator()(const f32x4 (&acc)[2][2][4][2], const Unit& u, int wr, int wc, int fr, int fq) const {
        const int row0 = u.pm * BM + wr * 64 + fr, col0 = u.pn * BM + wc * 32 + 8 * fq;
#pragma unroll
        for (int ai = 0; ai < 2; ++ai)
#pragma unroll
            for (int m = 0; m < 4; ++m) { bf16_t* rowp = O + (size_t)(row0 + ai * HALF + m * 16) * ldc + col0; float rs2 = 1.0f; if (rstd) { const float rs = rstd[row0 + ai * HALF + m * 16]; rs2 = rs * rs; }
#pragma unroll
                for (int bj = 0; bj < 2; ++bj) { f32x4 v0 = acc[ai][bj][m][0], v1 = acc[ai][bj][m][1];
#pragma unroll
                    for (int j = 0; j < 4; ++j) { const float a = fmaxf(v0[j], 0.f), b = fmaxf(v1[j], 0.f); v0[j] = a * a * rs2; v1[j] = b * b * rs2; }
                    u32x4 w; w.x = cvt_pk_bf16(v0[0], v0[1]); w.y = cvt_pk_bf16(v0[2], v0[3]); w.z = cvt_pk_bf16(v1[0], v1[1]); w.w = cvt_pk_bf16(v1[2], v1[3]);
                    *(u32x4*)(rowp + bj * HALF) = w; } }
    }
};
struct EpiGlu {
    static constexpr bool PERM = false, AFTER_DRAIN = false;
    bf16_t* h; const float* bias; float* part;
    __device__ __forceinline__ void operator()(const f32x4 (&acc)[2][2][4][2], const Unit& u, int wr, int wc, int fr, int fq) const {
        const int row0 = u.pm * BM + wr * 64 + fr, f0 = u.pn * HALF + wc * 32 + 4 * fq;
        f32x4 bv[2], bg[2];
#pragma unroll
        for (int n = 0; n < 2; ++n) { bv[n] = *(const f32x4*)(bias + f0 + n * 16); bg[n] = *(const f32x4*)(bias + 4096 + f0 + n * 16); }
#pragma unroll
        for (int ai = 0; ai < 2; ++ai)
#pragma unroll
            for (int m = 0; m < 4; ++m) { bf16_t* rowp = h + (size_t)(row0 + ai * HALF + m * 16) * 4096 + f0;
                float ssq = 0.f;
#pragma unroll
                for (int n = 0; n < 2; ++n) { const f32x4 val = acc[ai][0][m][n] + bv[n], gt = acc[ai][1][m][n] + bg[n]; f32x4 o = bf4_to_f32(*(const u32x2v*)(rowp + n * 16));
#pragma unroll
                    for (int j = 0; j < 4; ++j) o[j] += val[j] * __builtin_amdgcn_rcpf(1.0f + __builtin_amdgcn_exp2f(-1.4426950408889634f * gt[j]));
                    ssq += (o[0] * o[0] + o[1] * o[1]) + (o[2] * o[2] + o[3] * o[3]);
                    *(u32x2v*)(rowp + n * 16) = (u32x2v){cvt_pk_bf16(o[0], o[1]), cvt_pk_bf16(o[2], o[3])}; }
                ssq += __shfl_xor(ssq, 16); ssq += __shfl_xor(ssq, 32); if (fq == 0) part[(size_t)(row0 + ai * HALF + m * 16) * 128 + 4 * u.pn + wc] = ssq;
                if (m & 1) asm volatile("" ::: "memory"); }
    }
};
template <class Epi, class Sched, bool ALIGN_EPI = false, bool SP2 = false>
__device__ __forceinline__ void gemm_phase(PG8_LAS unsigned char* lds, const Gemm g, const Sched& S, const Epi& E) {
    const int tid = tid_fresh(), wid = __builtin_amdgcn_readfirstlane(tid >> 6), lane = tid & 63, wr = wid >> 2, wc = wid & 3, fr = lane & 15, fq = lane >> 4;
    const int K = g.K, nt = K / BK;
    unsigned voffA[2], voffB[2];
#pragma unroll
    for (int i = 0; i < 2; ++i) { int R, C; stage_rc(tid * 16 + i * 8192, R, C); const int Rb = Epi::PERM ? ((R & ~31) + perm32(R & 31)) : R;
        voffA[i] = (unsigned)(R * K + C) * 2u; voffB[i] = (unsigned)(Rb * K + C) * 2u; }
    const size_t kstep = (size_t)(BK * 2);
    const size_t hstep = (size_t)HALF * K * 2;
    const size_t tstep = 2 * hstep;
    const unsigned ldsw = (unsigned)wid * 1024u;
    const int aoff = lds_byte(wr * 64 + fr, fq * 8), boff = lds_byte(wc * 32 + fr, fq * 8);
#define PG8_SA(b, h) (((b) * 2 + (h)) * HTB)
#define PG8_SB(b, h) ((4 + (b) * 2 + (h)) * HTB)
#define PG8_STAGE(bufoff, gbase, voff) do { _Pragma("unroll") for (int _i = 0; _i < 2; ++_i) \
        __builtin_amdgcn_global_load_lds((const unsigned*)((const char*)(gbase) + (voff)[_i]), (PG8_LAS unsigned*)(lds + (bufoff) + ldsw + _i * 8192), 16, 0, 0); } while (0)
#define PG8_LDA(dst, b, h) do { _Pragma("unroll") for (int m = 0; m < 4; ++m) _Pragma("unroll") for (int k = 0; k < 2; ++k) dst[m][k] = *(const PG8_LAS bf16x8*)(lds + PG8_SA(b, h) + aoff + m * 2048 + k * 1024); } while (0)
#define PG8_LDB(dst, b, h) do { _Pragma("unroll") for (int n = 0; n < 2; ++n) _Pragma("unroll") for (int k = 0; k < 2; ++k) dst[n][k] = *(const PG8_LAS bf16x8*)(lds + PG8_SB(b, h) + boff + n * 2048 + k * 1024); } while (0)
#define PG8_MMA(ai, bj, At, Bt) do { __builtin_amdgcn_s_setprio(1); _Pragma("unroll") for (int m = 0; m < 4; ++m) _Pragma("unroll") for (int n = 0; n < 2; ++n) _Pragma("unroll") for (int k = 0; k < 2; ++k) \
        acc[ai][bj][m][n] = __builtin_amdgcn_mfma_f32_16x16x32_bf16(Bt[n][k], At[m][k], acc[ai][bj][m][n], 0, 0, 0); __builtin_amdgcn_s_setprio(0); } while (0)
#define PG8_WAIT_V(n) asm volatile("s_waitcnt vmcnt(" #n ")" ::: "memory")
#define PG8_WAIT_L(n) asm volatile("s_waitcnt lgkmcnt(" #n ")" ::: "memory")
#define PG8_BAR __builtin_amdgcn_s_barrier()
#define PG8_SCHED __builtin_amdgcn_sched_barrier(0)
    Unit cur, nxt; int ui = 0;
    if (!S.next(0, cur)) return;
    f32x4 acc[2][2][4][2];
#pragma unroll
    for (int a = 0; a < 2; ++a)
#pragma unroll
        for (int b = 0; b < 2; ++b)
#pragma unroll
            for (int m = 0; m < 4; ++m)
#pragma unroll
                for (int n = 0; n < 2; ++n) acc[a][b][m][n] = (f32x4){0.f, 0.f, 0.f, 0.f};
    bf16x8 At[4][2], B0[2][2], B1[2][2];
    const char* cA = (const char*)g.A + (size_t)cur.pm * tstep; const char* cB = (const char*)g.Bt + (size_t)cur.pn * tstep;
    S.a_ready(cur);
    if constexpr (SP2) {
        PG8_STAGE(PG8_SB(0, 0), cB, voffB); PG8_STAGE(PG8_SB(0, 1), cB + hstep, voffB); PG8_STAGE(PG8_SA(0, 0), cA, voffA); PG8_STAGE(PG8_SA(0, 1), cA + hstep, voffA);
        if (wr == 1) PG8_BAR;
        PG8_WAIT_V(2); PG8_BAR;
        PG8_STAGE(PG8_SB(1, 0), cB + kstep, voffB); PG8_STAGE(PG8_SA(1, 0), cA + kstep, voffA); PG8_STAGE(PG8_SB(1, 1), cB + hstep + kstep, voffB);
        PG8_WAIT_V(6); PG8_BAR;
    } else {
        PG8_STAGE(PG8_SB(0, 0), cB, voffB); PG8_STAGE(PG8_SA(0, 0), cA, voffA); PG8_STAGE(PG8_SB(0, 1), cB + hstep, voffB); PG8_STAGE(PG8_SA(0, 1), cA + hstep, voffA);
        if (wr == 1) PG8_BAR;
        PG8_WAIT_V(4); PG8_BAR;
        PG8_STAGE(PG8_SB(1, 0), cB + kstep, voffB); PG8_STAGE(PG8_SA(1, 0), cA + kstep, voffA); PG8_STAGE(PG8_SB(1, 1), cB + hstep + kstep, voffB);
        PG8_WAIT_V(6); PG8_BAR;
    }
    for (;;) {
        const bool has_next = S.next(ui + 1, nxt);
        const char* nA = has_next ? (const char*)g.A + (size_t)nxt.pm * tstep : cA; const char* nB = has_next ? (const char*)g.Bt + (size_t)nxt.pn * tstep : cB;
        for (int t = 0; t < nt; t += 2) {
            const bool last = (t == nt - 2);
            const char* a1 = cA + (size_t)(t + 1) * kstep;
            const char* a2 = last ? nA : cA + (size_t)(t + 2) * kstep; const char* b2 = last ? nB : cB + (size_t)(t + 2) * kstep;
            const char* a3 = a2 + kstep; const char* b3 = b2 + kstep;
            if (last && has_next) S.a_ready(nxt);
            if constexpr (SP2) {
            PG8_LDB(B0, 0, 0); PG8_LDB(B1, 0, 1); PG8_SCHED; PG8_LDA(At, 0, 0); PG8_STAGE(PG8_SA(1, 1), a1 + hstep, voffA);
            PG8_WAIT_V(8); PG8_WAIT_L(0); PG8_BAR; PG8_MMA(0, 0, At, B0); PG8_MMA(0, 1, At, B1); PG8_BAR; PG8_SCHED;
            PG8_LDA(At, 0, 1); PG8_STAGE(PG8_SB(0, 0), b2, voffB); PG8_STAGE(PG8_SB(0, 1), b2 + hstep, voffB); PG8_STAGE(PG8_SA(0, 0), a2, voffA);
            PG8_WAIT_V(8); PG8_WAIT_L(0); PG8_BAR; PG8_MMA(1, 0, At, B0); PG8_MMA(1, 1, At, B1); PG8_BAR; PG8_SCHED;
            PG8_LDB(B0, 1, 0); PG8_LDB(B1, 1, 1); PG8_SCHED; PG8_LDA(At, 1, 0); PG8_STAGE(PG8_SA(0, 1), a2 + hstep, voffA);
            PG8_WAIT_V(8); PG8_WAIT_L(0); PG8_BAR; PG8_MMA(0, 0, At, B0); PG8_MMA(0, 1, At, B1); PG8_BAR; PG8_SCHED;
            PG8_LDA(At, 1, 1); PG8_STAGE(PG8_SB(1, 0), b3, voffB); PG8_STAGE(PG8_SB(1, 1), b3 + hstep, voffB); PG8_STAGE(PG8_SA(1, 0), a3, voffA);
            PG8_WAIT_V(8); PG8_WAIT_L(0); PG8_BAR; PG8_MMA(1, 0, At, B0); PG8_MMA(1, 1, At, B1); PG8_BAR; PG8_SCHED;
            } else {
            PG8_LDB(B0, 0, 0); PG8_SCHED; PG8_LDA(At, 0, 0); PG8_STAGE(PG8_SA(1, 1), a1 + hstep, voffA);
            PG8_WAIT_L(8); PG8_BAR; PG8_WAIT_L(0); PG8_MMA(0, 0, At, B0); PG8_BAR; PG8_SCHED;
            PG8_LDB(B1, 0, 1); PG8_STAGE(PG8_SB(0, 0), b2, voffB);
            PG8_BAR; PG8_WAIT_L(0); PG8_MMA(0, 1, At, B1); PG8_BAR;
            PG8_LDA(At, 0, 1); PG8_STAGE(PG8_SA(0, 0), a2, voffA);
            PG8_BAR; PG8_WAIT_L(0); PG8_MMA(1, 0, At, B0); PG8_BAR; PG8_SCHED;
            PG8_STAGE(PG8_SB(0, 1), b2 + hstep, voffB);
            PG8_WAIT_V(6); PG8_BAR; PG8_MMA(1, 1, At, B1); PG8_BAR;
            PG8_LDB(B0, 1, 0); PG8_SCHED; PG8_LDA(At, 1, 0); PG8_STAGE(PG8_SA(0, 1), a2 + hstep, voffA);
            PG8_WAIT_L(8); PG8_BAR; PG8_WAIT_L(0); PG8_MMA(0, 0, At, B0); PG8_BAR; PG8_SCHED;
            PG8_LDB(B1, 1, 1); PG8_STAGE(PG8_SB(1, 0), b3, voffB);
            PG8_BAR; PG8_WAIT_L(0); PG8_MMA(0, 1, At, B1); PG8_BAR;
            PG8_LDA(At, 1, 1); PG8_STAGE(PG8_SA(1, 0), a3, voffA);
            PG8_BAR; PG8_WAIT_L(0); PG8_MMA(1, 0, At, B0); PG8_BAR; PG8_SCHED;
            PG8_STAGE(PG8_SB(1, 1), b3 + hstep, voffB);
            PG8_WAIT_V(6); PG8_BAR; PG8_MMA(1, 1, At, B1); PG8_BAR;
            }
        }
        if constexpr (ALIGN_EPI) { if (wr == 0) PG8_BAR; }
        if constexpr (!Epi::AFTER_DRAIN) { E(acc, cur, wr, wc, fr, fq); S.done(cur); }
        if (!has_next) break;
#pragma unroll
        for (int a = 0; a < 2; ++a)
#pragma unroll
            for (int b = 0; b < 2; ++b)
#pragma unroll
                for (int m = 0; m < 4; ++m)
#pragma unroll
                    for (int n = 0; n < 2; ++n) acc[a][b][m][n] = (f32x4){0.f, 0.f, 0.f, 0.f};
        cur = nxt; cA = nA; cB = nB; ++ui;
        if constexpr (ALIGN_EPI) { if (wr == 1) PG8_BAR; }
    }
    PG8_WAIT_V(0);
    if constexpr (!ALIGN_EPI) { if (wr == 0) PG8_BAR; }
    PG8_BAR;
    if constexpr (Epi::AFTER_DRAIN) { E.fused(acc, cur, wr, wc, fr, fq, lds, wid, lane); S.done(cur); }
#undef PG8_SA
#undef PG8_SB
#undef PG8_STAGE
#undef PG8_LDA
#undef PG8_LDB
#undef PG8_MMA
#undef PG8_WAIT_V
#undef PG8_WAIT_L
#undef PG8_BAR
#undef PG8_SCHED
}
}
namespace ab {
constexpr int D = 128;
constexpr float THR = 8.f;
constexpr bool WSKIP = false;
constexpr float SCALE = 0.08838834764831845f;
constexpr int NW = 8, QBLK = 32, KVBLK = 64, QB = NW * QBLK;
constexpr int SHM_V = KVBLK * D * 2, SHM_K = KVBLK * D * 2;
constexpr int LDS_BYTES = 2 * SHM_V + 2 * SHM_K + NW * 64 * 4;
typedef unsigned short bf16;
typedef short bf16x8 __attribute__((ext_vector_type(8)));
typedef short s16x4 __attribute__((ext_vector_type(4)));
typedef float f32x16 __attribute__((ext_vector_type(16)));
typedef float f32x4 __attribute__((ext_vector_type(4)));
typedef unsigned u32x4 __attribute__((ext_vector_type(4)));
template <class A, class Bt> struct same_t { static constexpr bool v = false; };
template <class A> struct same_t<A, A> { static constexpr bool v = true; };

#define KSWZ(row, colB) ((row) * 256 + ((colB) ^ (((row) & 7) << 4)))
#define SBAR() __builtin_amdgcn_sched_barrier(0)
__device__ __forceinline__ int v_st(int k, int c) { const int kk = (k & ~0xC) | ((k & 4) << 1) | ((k & 8) >> 1); return ((kk >> 3) * 4 + (c >> 5)) * 512 + ((kk & 7) * 32 + (c & 31)) * 2; }
__device__ __forceinline__ int v_rd_base(int lane) { return ((lane & 3) << 3) | (((lane >> 2) & 3) << 6) | (((lane >> 4) & 1) << 5) | (((lane >> 5) & 1) << 8); }
constexpr int v_rd_off(int d0, int ks, int half) { return d0 * 512 + ks * 4096 + half * 2048; }
__device__ __forceinline__ int crow(int r, int hi) { return (r & 3) + 8 * (r >> 2) + 4 * hi; }
__device__ __forceinline__ unsigned cvtpk(float lo, float hi) {
    unsigned r; asm volatile("v_cvt_pk_bf16_f32 %0, %1, %2" : "=v"(r) : "v"(lo), "v"(hi)); return r;
}
__device__ __forceinline__ bf16x8 pack8(f32x4 a, f32x4 b) {
    u32x4 w = {cvtpk(a[0], a[1]), cvtpk(a[2], a[3]), cvtpk(b[0], b[1]), cvtpk(b[2], b[3])};
    return *reinterpret_cast<bf16x8*>(&w);
}
template <class T> __device__ __forceinline__ bf16x8 load8(const T* p) {
    if constexpr (same_t<T, float>::v) { return pack8(*(const f32x4*)p, *(const f32x4*)(p + 4)); }
    else { return *reinterpret_cast<const bf16x8*>(p); }
}
__device__ __forceinline__ void mask_tile(f32x16& p0, f32x16& p1, int dq, unsigned W) {
    const float NEG = -__builtin_inff();
#pragma unroll
    for (int r = 0; r < 16; ++r) {
        const int c = (r & 3) + 8 * (r >> 2);
        if ((unsigned)(dq - c) >= W) p0[r] = NEG;
        if ((unsigned)(dq - c - 32) >= W) p1[r] = NEG;
    }
}
__device__ __forceinline__ void partialSM(f32x16& p0, f32x16& p1, float& m_reg, float& mn, float& alpha) {
    float pmax = p0[0]; for (int r = 1; r < 16; ++r) pmax = fmaxf(pmax, p0[r]); for (int r = 0; r < 16; ++r) pmax = fmaxf(pmax, p1[r]);
    { auto rr = __builtin_amdgcn_permlane32_swap(__float_as_uint(pmax), __float_as_uint(pmax), false, false);
      pmax = fmaxf(__uint_as_float(rr[0]), __uint_as_float(rr[1])); }
    constexpr float C2 = 1.4426950408889634f * SCALE;
    if (__builtin_expect(__all((pmax - m_reg) * SCALE <= THR), 1)) { mn = m_reg; alpha = 1.f; }
    else { mn = fmaxf(m_reg, pmax); alpha = __builtin_amdgcn_exp2f((m_reg - mn) * C2); m_reg = mn; }
    const float mnL = -mn * C2;
    for (int r = 0; r < 16; ++r) p0[r] = fmaf(p0[r], C2, mnL); for (int r = 0; r < 16; ++r) p1[r] = fmaf(p1[r], C2, mnL);
    for (int r = 0; r < 16; ++r) p0[r] = __builtin_amdgcn_exp2f(p0[r]);
}
__device__ __forceinline__ void finishSM(f32x16& p0, f32x16& p1, float alpha, float& l_reg, bf16x8& pa0, bf16x8& pa1, bf16x8& pa2, bf16x8& pa3) {
    for (int r = 0; r < 16; ++r) p1[r] = __builtin_amdgcn_exp2f(p1[r]);
    float ps = 0; for (int r = 0; r < 16; ++r) ps += p0[r]; for (int r = 0; r < 16; ++r) ps += p1[r];
    { auto rr = __builtin_amdgcn_permlane32_swap(__float_as_uint(ps), __float_as_uint(ps), false, false);
      ps = __uint_as_float(rr[0]) + __uint_as_float(rr[1]); }
    l_reg = l_reg * alpha + ps;
#define PK4(P, B_, OUT) do { unsigned a0 = cvtpk(P[B_+0], P[B_+1]), a1 = cvtpk(P[B_+2], P[B_+3]);                          \
        unsigned b0 = cvtpk(P[B_+4], P[B_+5]), b1 = cvtpk(P[B_+6], P[B_+7]);                                             \
        auto r0 = __builtin_amdgcn_permlane32_swap(a0, b0, false, false); auto r1 = __builtin_amdgcn_permlane32_swap(a1, b1, false, false); \
        u32x4 w = {r0[0], r1[0], r0[1], r1[1]}; OUT = *reinterpret_cast<bf16x8*>(&w); } while (0)
    PK4(p0, 0, pa0); PK4(p0, 8, pa1); PK4(p1, 0, pa2); PK4(p1, 8, pa3);
#undef PK4
}
template <int KB, bool SK>
__device__ __forceinline__ void qkt(f32x16& p0, f32x16& p1, const char* K_lds, int r32, int hi, const bf16x8* qr, bool act) {
    if (SK && !act) { const float NEG = -__builtin_inff();
#pragma unroll
        for (int r = 0; r < 16; ++r) { p0[r] = NEG; p1[r] = NEG; } return; }
    p0 = f32x16{}; p1 = f32x16{};
    const char* kb[4];
#pragma unroll
    for (int dd = 0; dd < 4; ++dd) kb[dd] = K_lds + KB * SHM_K + KSWZ(r32, (dd * 16 + hi * 8) * 2);
#pragma unroll
    for (int d0 = 0; d0 < 8; ++d0) { const char* a = kb[d0 & 3] + (d0 >> 2) * 128;
        bf16x8 b0 = *reinterpret_cast<const bf16x8*>(a);
        bf16x8 b1 = *reinterpret_cast<const bf16x8*>(a + 32 * 256);
        p0 = __builtin_amdgcn_mfma_f32_32x32x16_bf16(b0, qr[d0], p0, 0, 0, 0);
        p1 = __builtin_amdgcn_mfma_f32_32x32x16_bf16(b1, qr[d0], p1, 0, 0, 0); }
}
template <int VB, bool SK>
__device__ __forceinline__ void pv_tile(f32x16* o, int vb0, bf16x8 pa0, bf16x8 pa1, bf16x8 pa2, bf16x8 pa3, bool act) {
    if (SK && !act) return;
#define TRRD(dst, off) asm volatile("ds_read_b64_tr_b16 %0, %1 offset:%2" : "=&v"(dst) : "v"(vb0), "i"(off) : "memory")
#define PV_D0(d0) do { s16x4 l0, l1, l2, l3, h0, h1, h2, h3; constexpr int b_ = VB * SHM_V + v_rd_off(d0, 0, 0);     \
        TRRD(l0, b_); TRRD(h0, b_ + 2048); TRRD(l1, b_ + 4096); TRRD(h1, b_ + 6144); TRRD(l2, b_ + 8192); TRRD(h2, b_ + 10240); TRRD(l3, b_ + 12288); TRRD(h3, b_ + 14336); \
        asm volatile("s_waitcnt lgkmcnt(0)" ::: "memory"); SBAR();                 \
        o[d0] = __builtin_amdgcn_mfma_f32_32x32x16_bf16(pa0, (bf16x8){l0[0], l0[1], l0[2], l0[3], h0[0], h0[1], h0[2], h0[3]}, o[d0], 0, 0, 0);   \
        o[d0] = __builtin_amdgcn_mfma_f32_32x32x16_bf16(pa1, (bf16x8){l1[0], l1[1], l1[2], l1[3], h1[0], h1[1], h1[2], h1[3]}, o[d0], 0, 0, 0);   \
        o[d0] = __builtin_amdgcn_mfma_f32_32x32x16_bf16(pa2, (bf16x8){l2[0], l2[1], l2[2], l2[3], h2[0], h2[1], h2[2], h2[3]}, o[d0], 0, 0, 0);   \
        o[d0] = __builtin_amdgcn_mfma_f32_32x32x16_bf16(pa3, (bf16x8){l3[0], l3[1], l3[2], l3[3], h3[0], h3[1], h3[2], h3[3]}, o[d0], 0, 0, 0); } while (0)
    PV_D0(0); PV_D0(1); PV_D0(2); PV_D0(3);
#undef PV_D0
#undef TRRD
}

template <class TIn, class TOut> struct BlockRef { const TIn* Q; const TIn* K; const TIn* V; TOut* O; int P0; };
template <class TIn> struct Seam {
    bf16x8 qr[8];
    bf16x8 st_v0, st_v1, st_k0, st_k1; f32x4 sf0, sf1, sf2, sf3;
    f32x4 tq[16];
};
__device__ __forceinline__ int swa_jlo(int P0, int W) { const int lowk = P0 - W + 1; return lowk > 0 ? lowk / KVBLK : 0; }
#define ROW(p, k0, rr) ((p) + (size_t)((k0) + (rr)) * D + sc)
#define VMW() asm volatile("s_waitcnt vmcnt(0)" ::: "memory")
#define VMWN(n) asm volatile("s_waitcnt vmcnt(%0)" :: "i"(n) : "memory")
#define SLOAD_H(Kp, Vp, k0) do { S.st_v0 = load8<TIn>(ROW(Vp, k0, sr)); S.st_v1 = load8<TIn>(ROW(Vp, k0, 32 + sr));              \
                         S.st_k0 = load8<TIn>(ROW(Kp, k0, sr)); S.st_k1 = load8<TIn>(ROW(Kp, k0, 32 + sr)); } while (0)
#define SWRITE_HK(bf) do { *(bf16x8*)(K_lds + (bf) * SHM_K + kws) = S.st_k0; *(bf16x8*)(K_lds + (bf) * SHM_K + kws + 32 * 256) = S.st_k1; } while (0)
#define SWRITE_HV(bf) do { *(bf16x8*)(V_lds + (bf) * SHM_V + vst0) = S.st_v0; *(bf16x8*)(V_lds + (bf) * SHM_V + vst1) = S.st_v1; } while (0)
#define SWRITE_H(bf) do { SWRITE_HV(bf); SWRITE_HK(bf); } while (0)
#define SLOAD_F(p, k0) do { S.sf0 = *(const f32x4*)ROW(p, k0, sr); S.sf1 = *(const f32x4*)(ROW(p, k0, sr) + 4);                \
                            S.sf2 = *(const f32x4*)ROW(p, k0, 32 + sr); S.sf3 = *(const f32x4*)(ROW(p, k0, 32 + sr) + 4); } while (0)
#define SWRITE_KF(bf) do { *(bf16x8*)(K_lds + (bf) * SHM_K + kws) = pack8(S.sf0, S.sf1); *(bf16x8*)(K_lds + (bf) * SHM_K + kws + 32 * 256) = pack8(S.sf2, S.sf3); } while (0)
#define SWRITE_VF(bf) do { *(bf16x8*)(V_lds + (bf) * SHM_V + vst0) = pack8(S.sf0, S.sf1); *(bf16x8*)(V_lds + (bf) * SHM_V + vst1) = pack8(S.sf2, S.sf3); } while (0)
template <class TIn, class TOut>
__device__ __forceinline__ void causal_swa_prime(const BlockRef<TIn, TOut>& cur, int W, char* lds, Seam<TIn>& S) {
    constexpr bool F32 = same_t<TIn, float>::v;
    const int tid = tid_fresh(), wid = __builtin_amdgcn_readfirstlane(tid >> 6), lane = tid & 63, r32 = lane & 31, hi = lane >> 5;
    const int sr = tid >> 4, sc = (tid & 15) * 8, kws = KSWZ(sr, sc * 2); char* K_lds = lds + 2 * SHM_V;
    const int kb0 = swa_jlo(cur.P0, W) * KVBLK;
    for (int d0 = 0; d0 < 8; ++d0) S.qr[d0] = load8<TIn>(cur.Q + (size_t)(wid * QBLK + r32) * D + d0 * 16 + hi * 8);
    if constexpr (F32) { SLOAD_F((const float*)cur.K, kb0); VMW(); SWRITE_KF(0); SBAR(); SLOAD_F((const float*)cur.V, kb0); }
    else { SLOAD_H(cur.K, cur.V, kb0); VMW(); SWRITE_HK(0); }
    __syncthreads();
}
template <class TIn, class TOut>
__device__ __forceinline__ void causal_swa_block(const BlockRef<TIn, TOut>& cur, const BlockRef<TIn, TOut>& nxt, int skv, int W, char* lds, Seam<TIn>& S) {
    constexpr bool F32 = same_t<TIn, float>::v;
    const int tid = tid_fresh(), wid = __builtin_amdgcn_readfirstlane(tid >> 6), lane = tid & 63, r32 = lane & 31, hi = lane >> 5;
    const int j_lo = swa_jlo(cur.P0, W);
    int j_hi = (cur.P0 + QB - 1) / KVBLK + 1; if (j_hi > skv / KVBLK) j_hi = skv / KVBLK;
    const int NT = j_hi - j_lo;
    const int kbn = swa_jlo(nxt.P0, W) * KVBLK;
    const int qlo = cur.P0 + wid * QBLK, qm = qlo + r32 - 4 * hi;
    char* V_lds = lds; char* K_lds = lds + 2 * SHM_V;
    float* ws = (float*)(lds + 2 * SHM_V + 2 * SHM_K) + wid * 64; float* li_l = ws, * al_l = ws + 32;
    float m_reg = -1e30f, l_reg = 0; f32x16 o[4] = {};
    const int sr = tid >> 4, sc = (tid & 15) * 8, vst0 = v_st(sr, sc), vst1 = v_st(32 + sr, sc), kws = KSWZ(sr, sc * 2);
    const int vb0 = (int)(uintptr_t)V_lds + v_rd_base(lane);
    const TIn* Kh = cur.K; const TIn* Vh = cur.V;
#define RESC(a) do { if (__any((a) < 1.f)) { if (hi == 0) al_l[r32] = (a); asm volatile("s_waitcnt lgkmcnt(0)" ::: "memory");              \
                     for (int d_ = 0; d_ < 4; ++d_) for (int r = 0; r < 16; ++r) o[d_][r] *= al_l[crow(r, hi)]; } } while (0)
#define KBASE(t) ((j_lo + (t)) * KVBLK)
#define ACT(t) (KBASE(t) <= qlo + QBLK - 1 && KBASE(t) + KVBLK - 1 >= qlo - W + 1)
#define MASKT(P0_, P1_, t) do { const int kb_ = KBASE(t); if ((!SK || ACT(t)) && (kb_ + KVBLK - 1 > qlo || kb_ <= qlo + QBLK - 1 - W)) mask_tile(P0_, P1_, qm - kb_, (unsigned)W); } while (0)
    constexpr int NQL = F32 ? 16 : 8;
    constexpr bool SK = WSKIP && !F32;
#define SEAM_K0() do { VMWN(NQL); if constexpr (F32) { SWRITE_KF(0); SBAR(); SLOAD_F((const float*)nxt.V, kbn); } else { SWRITE_HK(0); } SBAR(); } while (0)
    f32x16 pA0, pA1, pB0, pB1; float mnA, mnB, alA, alB; bf16x8 pa0, pa1, pa2, pa3;
    if constexpr (F32) { VMW(); SWRITE_VF(0); SBAR(); } else { SWRITE_HV(0); SBAR(); }
    if (NT > 1) { if constexpr (F32) SLOAD_F((const float*)Kh, KBASE(1)); else SLOAD_H(Kh, Vh, KBASE(1)); }
    SBAR(); qkt<0, SK>(pA0, pA1, K_lds, r32, hi, S.qr, ACT(0));
    if constexpr (F32) { if (NT > 1) { VMW(); SWRITE_KF(1); SBAR(); SLOAD_F((const float*)Vh, KBASE(1)); } }
    MASKT(pA0, pA1, 0); partialSM(pA0, pA1, m_reg, mnA, alA);
    if (NT > 1) { VMW(); if constexpr (F32) { SWRITE_VF(1); SBAR(); if (NT > 2) SLOAD_F((const float*)Kh, KBASE(2)); } else SWRITE_H(1); }
    __syncthreads();
#define HALF_STEP(PX0, PX1, mnX, alX, PY0, PY1, alY, t, KB, VB, SB) do {                                                      \
        SBAR(); qkt<KB, SK>(PX0, PX1, K_lds, r32, hi, S.qr, ACT(t));                                             \
        finishSM(PY0, PY1, alY, l_reg, pa0, pa1, pa2, pa3); SBAR();                                                           \
        if ((t) + 1 < NT) { if constexpr (F32) { VMW(); SWRITE_KF(SB); SBAR(); SLOAD_F((const float*)Vh, KBASE((t) + 1)); }  \
                            else { SLOAD_H(Kh, Vh, KBASE((t) + 1)); } SBAR(); }                                               \
        pv_tile<VB, SK>(o, vb0, pa0, pa1, pa2, pa3, ACT((t) - 1)); MASKT(PX0, PX1, (t)); partialSM(PX0, PX1, m_reg, mnX, alX);                                        \
        __syncthreads();                                                                                                      \
        if ((t) + 1 < NT) { VMW(); if constexpr (F32) { SWRITE_VF(SB); SBAR(); if ((t) + 2 < NT) SLOAD_F((const float*)Kh, KBASE((t) + 2)); } \
                            else { SWRITE_H(SB); } }                                                                          \
        RESC(alX); __syncthreads(); } while (0)
    for (int t = 1; t + 1 < NT; t += 2) {
        HALF_STEP(pB0, pB1, mnB, alB, pA0, pA1, alA, t, 1, 0, 0);
        HALF_STEP(pA0, pA1, mnA, alA, pB0, pB1, alB, t + 1, 0, 1, 1);
    }
    const bool even = (NT & 1) == 0;
    if (even) { SBAR(); qkt<1, SK>(pB0, pB1, K_lds, r32, hi, S.qr, ACT(NT - 1)); SBAR(); }
#define QROW(e) (nxt.Q + (size_t)(wid * QBLK + r32) * D + ((e) >> 1) * 16 + hi * 8 + ((e) & 1) * 4)
    if constexpr (F32) { SLOAD_F((const float*)nxt.K, kbn); SBAR();
#pragma unroll
        for (int e = 0; e < 8; ++e) S.tq[e] = *(const f32x4*)QROW(e); }
    else { SLOAD_H(nxt.K, nxt.V, kbn); SBAR();
#pragma unroll
        for (int d0 = 0; d0 < 8; ++d0) S.qr[d0] = load8<TIn>(nxt.Q + (size_t)(wid * QBLK + r32) * D + d0 * 16 + hi * 8); }
    SBAR();
    finishSM(pA0, pA1, alA, l_reg, pa0, pa1, pa2, pa3); SBAR();
    if constexpr (F32) {
#pragma unroll
        for (int e = 8; e < 16; ++e) S.tq[e] = *(const f32x4*)QROW(e); SBAR(); }
#undef QROW
    pv_tile<0, SK>(o, vb0, pa0, pa1, pa2, pa3, ACT(even ? NT - 2 : NT - 1));
    if (even) { MASKT(pB0, pB1, NT - 1); partialSM(pB0, pB1, m_reg, mnB, alB); __syncthreads(); RESC(alB);
        finishSM(pB0, pB1, alB, l_reg, pa0, pa1, pa2, pa3); SBAR(); pv_tile<1, SK>(o, vb0, pa0, pa1, pa2, pa3, ACT(NT - 1)); }
    SBAR(); SEAM_K0();
    if (hi == 0) li_l[r32] = l_reg; asm volatile("s_waitcnt lgkmcnt(0)" ::: "memory");
    float rli[16];
#pragma unroll
    for (int r = 0; r < 16; ++r) rli[r] = __builtin_amdgcn_rcpf(li_l[crow(r, hi)]);
    TOut* Ow = cur.O + (size_t)(wid * QBLK) * D;
#pragma unroll
    for (int r = 0; r < 16; ++r) { const int orow = crow(r, hi);
#pragma unroll
        for (int d0 = 0; d0 < 4; ++d0) { const float v = o[d0][r] * rli[r];
            if constexpr (same_t<TOut, float>::v) { Ow[(size_t)orow * D + d0 * 32 + r32] = v; }
            else { const float vn = __shfl_xor(v, 1);
                   if ((r32 & 1) == 0) *(unsigned*)(Ow + (size_t)orow * D + d0 * 32 + r32) = cvtpk(v, vn); } } }
    if constexpr (F32) {
#pragma unroll
        for (int d0 = 0; d0 < 8; ++d0) S.qr[d0] = pack8(S.tq[2 * d0], S.tq[2 * d0 + 1]); }
    __syncthreads();
#undef RESC
#undef KBASE
#undef ACT
#undef MASKT
#undef SEAM_K0
#undef HALF_STEP
}
#undef ROW
#undef VMW
#undef VMWN
#undef SLOAD_H
#undef SWRITE_HK
#undef SWRITE_HV
#undef SWRITE_H
#undef SLOAD_F
#undef SWRITE_KF
#undef SWRITE_VF
constexpr int DA_K = 0, DA_V = 32768, DA_PX = 98304, DA_AL = 131072, DA_FL = DA_AL + 1024, DA_LL = DA_FL + 64, DA_OSC = DA_LL + 512  , DA_LDS = DA_OSC + 16384;
struct DaBlk { const bf16* Q; const bf16* K; const bf16* V0; const bf16* V1; bf16* O0; bf16* O1; int P0, nt; };
#if defined(DA_TESTRUN)
#define DA_TESTV(g) ((g).test)
#else
#define DA_TESTV(g) 0
#endif
struct DaGeom { const bf16* Qb; const bf16* Kb; const bf16* Vb; bf16* Ob; int vcu, G, nblk, skvp, seq, nmeta, test; };
template <int TEST = 0> __device__ __forceinline__ DaBlk da_blk_t(const DaGeom& g, int j) {
    const int item = g.vcu + g.G * (j >> 1), head = (DA_TESTV(g) == 1) ? 0 : ((DA_TESTV(g) == 2) ? ((item >> 5) & 7) : (item >> 5)), x = item & 31, qb = (j & 1) ? x : 63 - x;
    const int b = head >> 5, h = (head >> 1) & 15, c = head & 1;
    DaBlk B; const size_t hs = (size_t)g.skvp * D;
    B.Q = g.Qb + (size_t)(b * 32 + 2 * h + c) * hs + (size_t)(g.nmeta + 128 * qb) * D; B.K = g.Kb + (size_t)(b * 32 + 2 * h + c) * hs;
    B.V0 = g.Vb + (size_t)(b * 32 + 2 * h) * hs; B.V1 = B.V0 + hs;
    B.O0 = g.Ob + ((size_t)(head * 2) * g.seq + 128 * qb) * D; B.O1 = B.O0 + (size_t)g.seq * D;
    B.P0 = g.nmeta + 128 * qb; B.nt = (B.P0 + 127) / KVBLK + 1;
    return B;
}
__device__ __forceinline__ DaBlk da_blk(const DaGeom& g, int j) { return da_blk_t<0>(g, j); }
struct DaCur { int j, t, nt; };
__device__ __forceinline__ int da_tile(const DaCur& c) { return (c.j & 1) ? c.nt - 1 - c.t : c.t; }
__device__ __forceinline__ void da_adv(const DaGeom& g, DaCur& c) { if (c.t + 1 < c.nt) { ++c.t; } else if (c.j + 1 < g.nblk) { ++c.j; c.t = 0; c.nt = da_blk(g, c.j).nt; } }

template <int CTRL, bool BC> __device__ __forceinline__ float dppf(float x) { return __builtin_bit_cast(float, __builtin_amdgcn_update_dpp(0, __builtin_bit_cast(int, x), CTRL, 0xF, 0xF, BC)); }
template <int VB, class HOOK> __device__ __forceinline__ void da_pv2(f32x16* o, int vb0, bf16x8 pa0, bf16x8 pa1, bf16x8 pa2, bf16x8 pa3, bf16x8 pb0, bf16x8 pb1, bf16x8 pb2, bf16x8 pb3, HOOK&& hook) {
#define DA_TR(dst, off) asm volatile("ds_read_b64_tr_b16 %0, %1 offset:%2" : "=&v"(dst) : "v"(vb0), "i"(off) : "memory")
#define DA_TR8(S, d0) do { constexpr int b_ = VB * SHM_V + v_rd_off(d0, 0, 0); \
        DA_TR(S##l0, b_); DA_TR(S##h0, b_ + 2048); DA_TR(S##l1, b_ + 4096); DA_TR(S##h1, b_ + 6144); DA_TR(S##l2, b_ + 8192); DA_TR(S##h2, b_ + 10240); DA_TR(S##l3, b_ + 12288); DA_TR(S##h3, b_ + 14336); } while (0)
#define DA_VF(S, k) (bf16x8){S##l##k[0], S##l##k[1], S##l##k[2], S##l##k[3], S##h##k[0], S##h##k[1], S##h##k[2], S##h##k[3]}
#define DA_HK(h) do { if ((h) >= 0 && (h) < 0) { SBAR(); hook(h); SBAR(); } } while (0)
#define DA_MM(S, d0, H) do { \
        o[d0] = __builtin_amdgcn_mfma_f32_32x32x16_bf16(pa0, DA_VF(S, 0), o[d0], 0, 0, 0); DA_HK(H); o[4 + d0] = __builtin_amdgcn_mfma_f32_32x32x16_bf16(pb0, DA_VF(S, 0), o[4 + d0], 0, 0, 0); DA_HK(H + 1); \
        o[d0] = __builtin_amdgcn_mfma_f32_32x32x16_bf16(pa1, DA_VF(S, 1), o[d0], 0, 0, 0); DA_HK(H + 2); o[4 + d0] = __builtin_amdgcn_mfma_f32_32x32x16_bf16(pb1, DA_VF(S, 1), o[4 + d0], 0, 0, 0); DA_HK(H + 3); \
        o[d0] = __builtin_amdgcn_mfma_f32_32x32x16_bf16(pa2, DA_VF(S, 2), o[d0], 0, 0, 0); DA_HK(H + 4); o[4 + d0] = __builtin_amdgcn_mfma_f32_32x32x16_bf16(pb2, DA_VF(S, 2), o[4 + d0], 0, 0, 0); DA_HK(H + 5); \
        o[d0] = __builtin_amdgcn_mfma_f32_32x32x16_bf16(pa3, DA_VF(S, 3), o[d0], 0, 0, 0); DA_HK(H + 6); o[4 + d0] = __builtin_amdgcn_mfma_f32_32x32x16_bf16(pb3, DA_VF(S, 3), o[4 + d0], 0, 0, 0); DA_HK(H + 7); } while (0)
    s16x4 Al0, Al1, Al2, Al3, Ah0, Ah1, Ah2, Ah3, Bl0, Bl1, Bl2, Bl3, Bh0, Bh1, Bh2, Bh3;
    DA_TR8(A, 0);
    DA_TR8(B, 1); asm volatile("s_waitcnt lgkmcnt(8)" ::: "memory"); SBAR(); DA_MM(A, 0, 0); SBAR();
    DA_TR8(A, 2); asm volatile("s_waitcnt lgkmcnt(8)" ::: "memory"); SBAR(); DA_MM(B, 1, 8); SBAR();
    DA_TR8(B, 3); asm volatile("s_waitcnt lgkmcnt(8)" ::: "memory"); SBAR(); DA_MM(A, 2, -100); SBAR();
    asm volatile("s_waitcnt lgkmcnt(0)" ::: "memory"); SBAR(); DA_MM(B, 3, -100); SBAR();
#undef DA_TR
#undef DA_TR8
#undef DA_VF
#undef DA_MM
#undef DA_HK
}
#define DA_KSWZ(row, colB) ((row) * 256 + ((colB) ^ (((row) & 15) << 4)))
template <int KB> __device__ __forceinline__ void da_qkt(f32x16& p0, f32x16& p1, const char* K_lds, int r32, int hi, const bf16x8* qr) {
    const char* kb[4];
#pragma unroll
    for (int dd = 0; dd < 4; ++dd) kb[dd] = K_lds + KB * SHM_K + DA_KSWZ(r32, (dd * 16 + hi * 8) * 2);
    bf16x8 f0[8], f1[8];
#pragma unroll
    for (int d0 = 0; d0 < 8; ++d0) { const char* a = (d0 >> 2) ? K_lds + KB * SHM_K + DA_KSWZ(r32, ((d0 & 3) * 16 + hi * 8) * 2 + 128) : kb[d0 & 3]; f0[d0] = *reinterpret_cast<const bf16x8*>(a); f1[d0] = *reinterpret_cast<const bf16x8*>(a + 32 * 256); }
    SBAR();
    p0 = f32x16{}; p1 = f32x16{};
    __builtin_amdgcn_s_setprio(3);
#pragma unroll
    for (int d0 = 0; d0 < 8; ++d0) { p0 = __builtin_amdgcn_mfma_f32_32x32x16_bf16(f0[d0], qr[d0], p0, 0, 0, 0); p1 = __builtin_amdgcn_mfma_f32_32x32x16_bf16(f1[d0], qr[d0], p1, 0, 0, 0); }
    __builtin_amdgcn_s_setprio(0);
    SBAR();
}
typedef const __attribute__((address_space(1))) char* da_gptr;
__device__ __forceinline__ da_gptr da_uni(const char* p) { const unsigned long long v = (unsigned long long)p;
    const unsigned lo = __builtin_amdgcn_readfirstlane((unsigned)v), hi = __builtin_amdgcn_readfirstlane((unsigned)(v >> 32)); return (da_gptr)(((unsigned long long)hi << 32) | lo); }
__device__ __forceinline__ bool da_adv2(const DaGeom& g, DaCur& c) { if (c.t + 1 < c.nt) { ++c.t; return false; } if (c.j + 1 < g.nblk) { ++c.j; c.t = 0; c.nt = da_blk(g, c.j).nt; return true; } return false; }
__device__ __forceinline__ void da_phase(char* lds, const bf16* Qb, const bf16* Kb, const bf16* Vb, bf16* Ob, int vcu, int G, int skvp, int seq, int nmeta, int test = 0) {
    const int tid = tid_fresh(), wid = __builtin_amdgcn_readfirstlane(tid >> 6), lane = tid & 63, r32 = lane & 31, hi = lane >> 5;
    const bool prod = wid < 4; const int pw = wid & 3;
    DaGeom g{Qb, Kb, Vb, Ob, vcu, G, 0, skvp, seq, nmeta, test};
    { const int nitems = (2048 - vcu + G - 1) / G; g.nblk = vcu < 2048 ? 2 * nitems : 0; }
    if (g.nblk == 0) return;
    int nsteps = 1; for (int j = 0; j < g.nblk; ++j) nsteps += da_blk(g, j).nt;
    char* K_lds = lds + DA_K; char* V_lds = lds + DA_V;
    const int vb0 = (int)(uintptr_t)V_lds + v_rd_base(lane);
    float* al_w = (float*)(lds + DA_AL); unsigned* fl_w = (unsigned*)(lds + DA_FL); float* ll_w = (float*)(lds + DA_LL);
    const DaCur cstart{0, 0, da_blk(g, 0).nt};
    unsigned voffK[4], voffV[4];
#pragma unroll
    for (int j = 0; j < 4; ++j) { const int row = 16 * pw + 4 * j + (lane >> 4), chunk = (lane & 15) ^ (row & 15); voffK[j] = (unsigned)(row * 256 + chunk * 16);
        const int key = (pw << 4) | (((lane >> 4) & 1) << 3) | ((j >> 1) << 2) | ((lane >> 2) & 3), col = ((2 * (j & 1) + (lane >> 5)) << 5) | ((lane & 3) * 8); voffV[j] = (unsigned)(key * 256 + col * 2); }
    const unsigned dmaw = (unsigned)pw * 4096u;
#define DA_GLDS(src, ldsoff) __builtin_amdgcn_global_load_lds((const __attribute__((address_space(1))) unsigned*)(src), (__attribute__((address_space(3))) unsigned*)(lds + (ldsoff)), 16, 0, 0)
    DaCur ck = cstart, cv = cstart; const DaBlk Bkv = da_blk(g, 0);
    const char* kbase = (const char*)Bkv.K; const char* v0base = (const char*)Bkv.V0; const char* v1base = (const char*)Bkv.V1;
#define DA_ADVK() do { if (da_adv2(g, ck)) kbase = (const char*)da_blk(g, ck.j).K; } while (0)
#define DA_ADVV() do { if (da_adv2(g, cv)) { const DaBlk Bn_ = da_blk(g, cv.j); v0base = (const char*)Bn_.V0; v1base = (const char*)Bn_.V1; } } while (0)
#define DA_BAR() do { asm volatile("s_waitcnt lgkmcnt(0)" ::: "memory"); __builtin_amdgcn_s_barrier(); asm volatile("" ::: "memory"); } while (0)
#define DA_DMA1(PAR, i) do { const int j_ = (i) / 2, k_ = (i) % 2; unsigned vo_ = voffV[j_]; asm volatile("" : "+v"(vo_));     \
        if (k_ == 0) DA_GLDS(p0_ + vo_, DA_V + (2 * PAR) * SHM_V + dmaw + j_ * 1024); else DA_GLDS(p1_ + vo_, DA_V + (2 * PAR + 1) * SHM_V + dmaw + j_ * 1024); } while (0)
#define DA_DMAK(PAR) do { DA_ADVK(); const da_gptr kp = da_uni(kbase + (size_t)da_tile(ck) * 16384u); \
        _Pragma("unroll") for (int j_ = 0; j_ < 4; ++j_) { unsigned vo_ = voffK[j_]; asm volatile("" : "+v"(vo_)); DA_GLDS(kp + vo_, DA_K + (1 - PAR) * SHM_K + dmaw + j_ * 1024); } } while (0)
    if (prod) {
#pragma unroll
        for (int j = 0; j < 4; ++j) DA_GLDS(da_uni(kbase) + voffK[j], DA_K + dmaw + j * 1024);
    }
    if (prod) {
        bf16x8 qr[8]; float m_reg = -1e30f, l_reg = 0.f; DaCur cp = cstart; DaBlk Bp = da_blk(g, 0);
        bf16x8 qn[8];
#pragma unroll
        for (int d0 = 0; d0 < 8; ++d0) qn[d0] = bf16x8{};
#pragma unroll
        for (int d0 = 0; d0 < 8; ++d0) qr[d0] = load8<bf16>(Bp.Q + (size_t)(pw * QBLK + r32) * D + d0 * 16 + hi * 8);
        asm volatile("s_waitcnt vmcnt(0)" ::: "memory");
        DA_BAR();
#define DA_PSTEP(PAR, S, s_) do { bool qpf = false; \
            if ((s_) < nsteps - 1) { \
                f32x16 p0 = f32x16{}, p1 = f32x16{}; float mn, al = 1.f; bf16x8 pa0 = qr[0], pa1 = qr[1], pa2 = qr[2], pa3 = qr[3]; \
                { da_qkt<PAR>(p0, p1, K_lds, r32, hi, qr); DA_DMAK(PAR); SBAR();     \
                { const int qlo = Bp.P0 + pw * QBLK, kb_ = da_tile(cp) * KVBLK; if (kb_ + KVBLK - 1 > qlo) mask_tile(p0, p1, qlo + r32 - 4 * hi - kb_, 1u << 30); } \
                partialSM(p0, p1, m_reg, mn, al); finishSM(p0, p1, al, l_reg, pa0, pa1, pa2, pa3); } \
                char* px = lds + DA_PX + PAR * 16384 + pw * 4096 + lane * 16; \
                *(bf16x8*)(px) = pa0; *(bf16x8*)(px + 1024) = pa1; *(bf16x8*)(px + 2048) = pa2; *(bf16x8*)(px + 3072) = pa3; \
                if (hi == 0) al_w[PAR * 128 + pw * 32 + r32] = al; \
                const bool anyr = __any(al < 1.f); if (lane == 0) fl_w[PAR * 4 + pw] = anyr ? 1u : 0u; \
                if (cp.t == cp.nt - 2 && cp.j + 1 < g.nblk) { const DaBlk Bn = da_blk(g, cp.j + 1); qpf = true;     \
                    _Pragma("unroll") for (int d0 = 0; d0 < 8; ++d0) qn[d0] = load8<bf16>(Bn.Q + (size_t)(pw * QBLK + r32) * D + d0 * 16 + hi * 8); } \
                if (cp.t == cp.nt - 1) {                                     \
                    if (hi == 0) ll_w[pw * 32 + r32] = l_reg; m_reg = -1e30f; l_reg = 0.f; \
                    _Pragma("unroll") for (int d0 = 0; d0 < 8; ++d0) qr[d0] = qn[d0]; } \
                if (da_adv2(g, cp)) Bp = da_blk(g, cp.j); \
            } \
            if (qpf) asm volatile("s_waitcnt vmcnt(8)" ::: "memory"); else asm volatile("s_waitcnt vmcnt(0)" ::: "memory");     \
            DA_BAR(); } while (0)
        for (int s = 0; s < nsteps; s += 2) { DA_PSTEP(0, 0, s); if (s + 1 < nsteps) DA_PSTEP(1, 0, s + 1); }
#undef DA_PSTEP
    } else {
        f32x16 o[8]; DaCur cc = cstart; DaBlk Bc = da_blk(g, 0);
        const int rh = pw >> 1, ch = pw & 1, vb0c = vb0 + ch * SHM_V;
        bool stored = false;
#pragma unroll
        for (int d = 0; d < 8; ++d) o[d] = f32x16{};
        asm volatile("s_waitcnt vmcnt(0)" ::: "memory");
        DA_BAR();
        {
            const da_gptr p0_ = da_uni(v0base + (size_t)da_tile(cv) * 16384u), p1_ = da_uni(v1base + (size_t)da_tile(cv) * 16384u); DA_ADVV();
#pragma unroll
            for (int i_ = 0; i_ < 8; ++i_) DA_DMA1(0, i_);
            asm volatile("s_waitcnt vmcnt(0)" ::: "memory");
            DA_BAR();
        }
#define DA_CSTEP(PAR, S, s_) do { stored = false; \
            const da_gptr p0_ = da_uni(v0base + (size_t)da_tile(cv) * 16384u), p1_ = da_uni(v1base + (size_t)da_tile(cv) * 16384u); DA_ADVV(); \
            { \
                const char* px = lds + DA_PX + (1 - PAR) * 16384 + rh * 8192 + lane * 16; \
                const bf16x8 pa0 = *(const bf16x8*)(px), pa1 = *(const bf16x8*)(px + 1024), pa2 = *(const bf16x8*)(px + 2048), pa3 = *(const bf16x8*)(px + 3072); \
                const bf16x8 pb0 = *(const bf16x8*)(px + 4096), pb1 = *(const bf16x8*)(px + 5120), pb2 = *(const bf16x8*)(px + 6144), pb3 = *(const bf16x8*)(px + 7168); \
                SBAR(); _Pragma("unroll") for (int i_ = 0; i_ < 8; ++i_) DA_DMA1(PAR, i_); SBAR();     \
                _Pragma("unroll") for (int rb = 0; rb < 2; ++rb) { \
                    if (fl_w[(1 - PAR) * 4 + 2 * rh + rb] != 0u) { const float* alp = al_w + (1 - PAR) * 128 + (2 * rh + rb) * 32; \
                        _Pragma("unroll") for (int r = 0; r < 16; ++r) { const float a_ = alp[crow(r, hi)]; _Pragma("unroll") for (int d_ = 0; d_ < 4; ++d_) o[4 * rb + d_][r] *= a_; } } } \
                asm volatile("s_waitcnt lgkmcnt(0)" ::: "memory"); SBAR(); \
                da_pv2<2 * (1 - PAR)>(o, vb0c, pa0, pa1, pa2, pa3, pb0, pb1, pb2, pb3, [&](int i_) { DA_DMA1(PAR, i_); });     \
                if (cc.t == cc.nt - 1) {                                     \
                    char* osc = lds + DA_OSC + pw * 4096; const bool odd = (r32 & 1) != 0; bf16* Oh = ch ? Bc.O1 : Bc.O0; \
                    _Pragma("unroll") for (int rb = 0; rb < 2; ++rb) { \
                        float rli[16]; _Pragma("unroll") for (int r = 0; r < 16; ++r) rli[r] = __builtin_amdgcn_rcpf(ll_w[(2 * rh + rb) * 32 + crow(r, hi)]); \
                        _Pragma("unroll") for (int k = 0; k < 2; ++k) { \
                            _Pragma("unroll") for (int dd = 0; dd < 2; ++dd) _Pragma("unroll") for (int rp = 0; rp < 8; ++rp) { \
                                const float v0 = o[4 * rb + 2 * k + dd][2 * rp] * rli[2 * rp], v1 = o[4 * rb + 2 * k + dd][2 * rp + 1] * rli[2 * rp + 1]; \
                                const float snd = odd ? v0 : v1, rcv = dppf<0xB1, false>(snd);         \
                                const unsigned w = odd ? cvtpk(rcv, v1) : cvtpk(v0, rcv);                \
                                *(unsigned*)(osc + crow(odd ? 2 * rp + 1 : 2 * rp, hi) * 128 + (dd * 32 + (r32 & ~1)) * 2) = w; } \
                            asm volatile("s_waitcnt lgkmcnt(0)" ::: "memory"); \
                            bf16* Og = Oh + (size_t)((2 * rh + rb) * QBLK) * D + k * 64 + (lane & 7) * 8; \
                            _Pragma("unroll") for (int i = 0; i < 4; ++i) { const int row = (lane >> 3) + 8 * i; const bf16x8 vv = *(const bf16x8*)(osc + row * 128 + (lane & 7) * 16); \
                                if (DA_TESTV(g) == 0) __builtin_nontemporal_store(vv, (bf16x8*)(Og + (size_t)row * D)); } \
                            asm volatile("s_waitcnt lgkmcnt(0)" ::: "memory"); } } \
                    stored = true; _Pragma("unroll") for (int d0 = 0; d0 < 8; ++d0) o[d0] = f32x16{}; } \
                if (da_adv2(g, cc)) Bc = da_blk(g, cc.j); \
            } \
            if (stored) asm volatile("s_waitcnt vmcnt(16)" ::: "memory"); else asm volatile("s_waitcnt vmcnt(0)" ::: "memory");     \
            DA_BAR(); } while (0)
        for (int s = 1; s < nsteps; s += 2) { DA_CSTEP(1, 0, s); if (s + 1 < nsteps) DA_CSTEP(0, 0, s + 1); }
#undef DA_CSTEP
    }
#undef DA_DMA1
#undef DA_DMAK
#undef DA_GLDS
#undef DA_ADVK
#undef DA_ADVV
#undef DA_BAR
}
}
#define GAS __attribute__((address_space(1)))
#define LAS __attribute__((address_space(3)))
typedef unsigned short bf16;
typedef unsigned u32x4 __attribute__((ext_vector_type(4)));
typedef unsigned u32x2 __attribute__((ext_vector_type(2)));
typedef float f32x4 __attribute__((ext_vector_type(4)));
typedef float f32x2 __attribute__((ext_vector_type(2)));
typedef short bf16x8 __attribute__((ext_vector_type(8)));

#ifndef GEMM_SP2
#define GEMM_SP2 true
#endif
constexpr int DM = 4096, NB = 2, SEQ = 8192, NMETA = 16, FF = 16384, NH = 16, DH = 128, NSH = 32;
constexpr int MX = NB * SEQ;
constexpr int MP = MX + 256;
constexpr int SKVP = 8256, LPOS = 8208;
constexpr int SG = 256, SP = 64, SGS = 16;
constexpr float EPS = 1e-6f;
static_assert(SKVP == pg8::E_SKVP && NMETA == pg8::E_NMETA && MX / 256 == pg8::E_MXP, "epilogue constants");

constexpr size_t MiB = 1u << 20;
constexpr size_t WS_CTL = 0, CTL_ZERO_BYTES = 256 * 1024;
constexpr size_t WS_WQKV = 1 * MiB;
constexpr size_t WS_WO   = WS_WQKV + 96 * MiB;
constexpr size_t WS_WGLU = WS_WO + 32 * MiB;
constexpr size_t WS_WUP  = WS_WGLU + 64 * MiB;
constexpr size_t WS_WDN  = WS_WUP + 256 * MiB;
constexpr size_t WS_H    = WS_WDN + 256 * MiB;
constexpr size_t WS_PART = WS_H + 130 * MiB;
constexpr size_t WS_RSTD = WS_PART + 16 * MiB;
constexpr size_t WS_HN   = WS_H + 260 * MiB;
constexpr size_t WS_ATTO = WS_HN + 130 * MiB;
constexpr size_t WS_R    = WS_ATTO + 130 * MiB;
constexpr size_t QKV_T_BYTES = (size_t)NB * NSH * SKVP * DH * 2;
constexpr size_t WS_Q = WS_R, WS_K = WS_Q + QKV_T_BYTES, WS_V = WS_K + QKV_T_BYTES, WS_O = WS_V + QKV_T_BYTES;
constexpr size_t O_BYTES = (size_t)128 * SEQ * DH * 2;
constexpr size_t WS_MID = WS_R;
constexpr size_t WS_END = WS_O + O_BYTES;
static_assert((size_t)MP * DM * 4 == 260 * MiB && (size_t)MP * DM * 2 == 130 * MiB && QKV_T_BYTES == 129 * MiB && (size_t)MP * FF * 2 <= WS_END - WS_R, "ws map");
constexpr size_t WS_MPART = WS_END + 14 * MiB;
constexpr int CW_XRANK = 8192;
constexpr int CW_BAR = 4096;

constexpr int RING_BYTES = 131072;
constexpr int S5_BFRAG = 0, S5_CFRAG = 65536, S5_KTAB = 131072, S5_CPOW = 139264, S5_WPOW = 147456, S5_A256 = 149504, S5_A1024 = 150016, S5_F = 150528  , S5_EMETA = S5_F + 8192  ;
constexpr int MISC_OFF = 159232, LDS_BYTES = 159744;
static_assert(S5_EMETA + 512 == MISC_OFF && ab::LDS_BYTES <= RING_BYTES && 17 * 64 * 8 <= 8704, "LDS map");

#define LDS_WAIT() asm volatile("s_waitcnt lgkmcnt(0)" ::: "memory")
__device__ __forceinline__ unsigned pk2(float lo, float hi) { unsigned r; asm volatile("v_cvt_pk_bf16_f32 %0, %1, %2" : "=v"(r) : "v"(lo), "v"(hi)); return r; }
__device__ __forceinline__ float bflo(unsigned w) { return __builtin_bit_cast(float, w << 16); }
__device__ __forceinline__ float bfhi(unsigned w) { return __builtin_bit_cast(float, w & 0xffff0000u); }
__device__ __forceinline__ float wave_sum(float v) {
#pragma unroll
    for (int o = 1; o < 64; o <<= 1) v += __shfl_xor(v, o);
    return v;
}

#define XB_TMO      128
#define XB_XCNT(j)  (256  + 64 * (j))
#define XB_XSUB(j)  (1280 + 64 * (j))
#define XB_XGEN(j)  (2304 + 64 * (j))
#define XB_TOP      3328
#define XB_TOPGEN   3392
#define XCD_BAR_WORDS 3456
#define XB_SPIN_CAP (1u << 18)

__device__ __forceinline__ unsigned xb_ld(unsigned* p)              { return __hip_atomic_load(p, __ATOMIC_RELAXED, __HIP_MEMORY_SCOPE_AGENT); }
__device__ __forceinline__ unsigned xb_add(unsigned* p, unsigned v) { return __hip_atomic_fetch_add(p, v, __ATOMIC_RELAXED, __HIP_MEMORY_SCOPE_AGENT); }
__device__ __forceinline__ unsigned xb_xcc_id() { return (unsigned)__builtin_amdgcn_s_getreg((3 << 11) | 20) & 0xFu; }
#define XB_SPIN(cond, bar) do { unsigned _sp = 0; while (cond) { __builtin_amdgcn_s_sleep(1); \
    if ((++_sp & 255u) == 0u) { if (xb_ld(&(bar)[XB_TMO])) break; if (_sp > XB_SPIN_CAP) { atomicAdd(&(bar)[XB_TMO], 1u); break; } } } } while (0)

struct XcdBarrier {
    unsigned* bar; unsigned x;
    volatile LAS unsigned* st;
};

__device__ __forceinline__ XcdBarrier xcd_barrier_post(unsigned* bar, volatile LAS unsigned* st) {
    XcdBarrier b; b.bar = bar; b.x = xb_xcc_id(); b.st = st;
    if (threadIdx.x == 0) (void)xb_add(&bar[XB_XCNT(b.x)], 1u);
    return b;
}
__device__ __forceinline__ void xcd_barrier_complete(unsigned* bar, unsigned x, unsigned& nloc, unsigned& nx) {
    const unsigned G = gridDim.x * gridDim.y * gridDim.z;
    unsigned sum, cnt, mine, sp = 0u;
    for (;;) {
        sum = 0u; cnt = 0u; mine = 0u;
#pragma unroll
        for (unsigned j = 0; j < 16; ++j) { const unsigned c = xb_ld(&bar[XB_XCNT(j)]); sum += c; cnt += (c > 0u) ? 1u : 0u; mine = (j == x) ? c : mine; }
        if (sum == G) break;
        __builtin_amdgcn_s_sleep(1);
        if ((++sp & 255u) == 0u) { if (xb_ld(&bar[XB_TMO])) break; if (sp > XB_SPIN_CAP) { atomicAdd(&bar[XB_TMO], 1u); break; } }
    }
    nloc = mine > 0u ? mine : 1u; nx = cnt > 0u ? cnt : 1u;
}

__device__ __forceinline__ void xcd_barrier(const XcdBarrier& b) {
    asm volatile("s_waitcnt vmcnt(0)" ::: "memory");
    __syncthreads();
    if (threadIdx.x == 0) {
        unsigned* bar = b.bar;
        __builtin_amdgcn_s_waitcnt(0);
        unsigned nloc = b.st[0], nx = b.st[1];
        if (nloc == 0u) { xcd_barrier_complete(bar, b.x, nloc, nx); b.st[0] = nloc; b.st[1] = nx; }
        const unsigned old = xb_add(&bar[XB_XSUB(b.x)], 1u);
        const unsigned gen = old / nloc;
        if (old + 1u == (gen + 1u) * nloc) {
            __builtin_amdgcn_fence(__ATOMIC_RELEASE, "agent");
            asm volatile("s_waitcnt vmcnt(0)" ::: "memory");
            const unsigned og = xb_add(&bar[XB_TOP], 1u);
            const unsigned tg = og / nx;
            if (og + 1u == (tg + 1u) * nx) xb_add(&bar[XB_TOPGEN], 1u);
            else XB_SPIN(xb_ld(&bar[XB_TOPGEN]) == tg, bar);
            __builtin_amdgcn_fence(__ATOMIC_ACQUIRE, "agent");
            xb_add(&bar[XB_XGEN(b.x)], 1u);
            asm volatile("s_waitcnt vmcnt(0)" ::: "memory");
        } else {
            XB_SPIN(xb_ld(&bar[XB_XGEN(b.x)]) == gen, bar);
            __builtin_amdgcn_fence(__ATOMIC_ACQUIRE, "agent");
            asm volatile("s_waitcnt vmcnt(0)" ::: "memory");
        }
    }
    __syncthreads();
}

__device__ __forceinline__ void transpose_item(const float* __restrict__ W, int K, int N, bf16* __restrict__ WT, int k0, int n0, int drow0, LAS float* scr, int lane, const float* __restrict__ gk = nullptr) {
    const int kk0 = lane >> 4, nq = lane & 15;
#pragma unroll
    for (int half = 0; half < 2; ++half) {
        f32x4 v[8];
#pragma unroll
        for (int i = 0; i < 8; ++i) v[i] = *(const f32x4*)(W + (size_t)(k0 + (half * 8 + i) * 4 + kk0) * N + n0 + 4 * nq);
#pragma unroll
        for (int i = 0; i < 8; ++i) { LAS float* s = scr + ((half * 8 + i) * 4 + kk0) * 65 + 4 * nq; const float gs = gk ? gk[k0 + (half * 8 + i) * 4 + kk0] : 1.0f; s[0] = v[i].x * gs; s[1] = v[i].y * gs; s[2] = v[i].z * gs; s[3] = v[i].w * gs; }
    }
    LDS_WAIT(); asm volatile("" ::: "memory");
    const int c = lane & 7;
#pragma unroll
    for (int j = 0; j < 8; ++j) { const int n = (lane >> 3) + 8 * j; const LAS float* s = scr + (8 * c) * 65 + n;
        u32x4 o; o.x = pk2(s[0 * 65], s[1 * 65]); o.y = pk2(s[2 * 65], s[3 * 65]); o.z = pk2(s[4 * 65], s[5 * 65]); o.w = pk2(s[6 * 65], s[7 * 65]);
        *(u32x4*)(WT + (size_t)(drow0 + n) * K + k0 + 8 * c) = o; }
    LDS_WAIT(); asm volatile("" ::: "memory");
}
template <bool COPY, bool HCOPY = false> __device__ __forceinline__ void rms_row(const float* __restrict__ src, const float* __restrict__ g, bf16* __restrict__ dst, float* __restrict__ cp, int lane, bf16* __restrict__ hcp = nullptr) {
    const f32x4* s4 = (const f32x4*)src + lane; f32x4 v[16]; float ss = 0.f;
#pragma unroll
    for (int j = 0; j < 16; ++j) { v[j] = s4[64 * j]; ss += (v[j].x * v[j].x + v[j].y * v[j].y) + (v[j].z * v[j].z + v[j].w * v[j].w); }
    if (COPY) {
#pragma unroll
        for (int j = 0; j < 16; ++j) ((f32x4*)cp + lane)[64 * j] = v[j]; }
    if (HCOPY) {
#pragma unroll
        for (int j = 0; j < 16; ++j) ((u32x2*)hcp + lane)[64 * j] = (u32x2){pk2(v[j].x, v[j].y), pk2(v[j].z, v[j].w)}; }
    ss = wave_sum(ss); const float rstd = 1.0f / sqrtf(ss * (1.0f / DM) + EPS);
    const f32x4* g4 = (const f32x4*)g + lane; u32x2* d2 = (u32x2*)dst + lane;
#pragma unroll
    for (int j = 0; j < 16; ++j) { const f32x4 gv = g4[64 * j]; u32x2 o; o.x = pk2(v[j].x * rstd * gv.x, v[j].y * rstd * gv.y); o.y = pk2(v[j].z * rstd * gv.z, v[j].w * rstd * gv.w); d2[64 * j] = o; }
}
__device__ __forceinline__ void rms_row_bf(const bf16* __restrict__ src, const float* __restrict__ g, bf16* __restrict__ dst, int lane) {
    const u32x4* s4 = (const u32x4*)src + lane; u32x4 v[8]; float ss = 0.f;
#pragma unroll
    for (int j = 0; j < 8; ++j) { v[j] = s4[64 * j];
#pragma unroll
        for (int q = 0; q < 4; ++q) { const float a = bflo(v[j][q]), b = bfhi(v[j][q]); ss += a * a + b * b; } }
    ss = wave_sum(ss); const float rstd = 1.0f / sqrtf(ss * (1.0f / DM) + EPS);
    u32x4* d4 = (u32x4*)dst + lane;
#pragma unroll
    for (int j = 0; j < 8; ++j) { const f32x4 g0 = *(const f32x4*)(g + 8 * (lane + 64 * j)), g1 = *(const f32x4*)(g + 8 * (lane + 64 * j) + 4); u32x4 o;
        o.x = pk2(bflo(v[j].x) * rstd * g0.x, bfhi(v[j].x) * rstd * g0.y); o.y = pk2(bflo(v[j].y) * rstd * g0.z, bfhi(v[j].y) * rstd * g0.w);
        o.z = pk2(bflo(v[j].z) * rstd * g1.x, bfhi(v[j].z) * rstd * g1.y); o.w = pk2(bflo(v[j].w) * rstd * g1.z, bfhi(v[j].w) * rstd * g1.w); d4[64 * j] = o; }
}
__device__ __forceinline__ void zero_row(bf16* dst, float* cp, int lane) {
    u32x2* d2 = (u32x2*)dst + lane;
#pragma unroll
    for (int j = 0; j < 16; ++j) { d2[64 * j] = (u32x2){0u, 0u}; if (cp) ((f32x4*)cp + lane)[64 * j] = (f32x4){0.f, 0.f, 0.f, 0.f}; }
}

struct Ptrs {
    const float *x, *meta, *g_mix, *g_mlp, *wqkv, *qg, *kg, *lamv, *sg, *wo, *a_re, *a_im, *log_dt, *b_re, *b_im, *c_re, *c_im, *dsk, *wglu, *bglu, *wup, *wdn;
    float* out; unsigned char* ws;
};

__device__ __forceinline__ void p0_prologue(const Ptrs& P, LAS unsigned char* lds, int gw, int NGW, int wave, int lane) {
    LAS float* scr = (LAS float*)(lds + wave * 16640);
    bf16* Wqkv_t = (bf16*)(P.ws + WS_WQKV); bf16* Wo_t = (bf16*)(P.ws + WS_WO); bf16* Wglu_t = (bf16*)(P.ws + WS_WGLU); bf16* Wup_t = (bf16*)(P.ws + WS_WUP); bf16* Wdn_t = (bf16*)(P.ws + WS_WDN);
    constexpr int I_QKV = 64 * 192, I_O = 64 * 64, I_GLU = 64 * 128, I_UP = 64 * 256, I_DN = 256 * 64;
    constexpr int NITEMS = I_QKV + I_O + I_GLU + 2 * I_UP + 2 * I_DN;
    for (int it = gw; it < NITEMS; it += NGW) {
        int r = it;
        if (r < I_QKV) { const int kb = r / 192, nb = r % 192; transpose_item(P.wqkv, DM, 3 * DM, Wqkv_t, 64 * kb, 64 * nb, 64 * nb, scr, lane); continue; } r -= I_QKV;
        if (r < I_O) { const int kb = r / 64, nb = r % 64; transpose_item(P.wo, DM, DM, Wo_t, 64 * kb, 64 * nb, 64 * nb, scr, lane); continue; } r -= I_O;
        if (r < I_GLU) { const int kb = r / 128, nb = r % 128, n0 = 64 * nb, hf = n0 / DM, f0 = n0 % DM; transpose_item(P.wglu, DM, 2 * DM, Wglu_t, 64 * kb, n0, 256 * (f0 / 128) + 128 * hf + (f0 % 128), scr, lane); continue; } r -= I_GLU;
        if (r < 2 * I_UP) { const int l = r / I_UP; r -= l * I_UP; const int kb = r / 256, nb = r % 256; transpose_item(P.wup + (size_t)l * DM * FF, DM, FF, Wup_t + (size_t)l * DM * FF, 64 * kb, 64 * nb, 64 * nb, scr, lane, P.g_mlp + (size_t)l * DM); continue; } r -= 2 * I_UP;
        { const int l = r / I_DN; r -= l * I_DN; const int kb = r / 64, nb = r % 64; transpose_item(P.wdn + (size_t)l * DM * FF, FF, DM, Wdn_t + (size_t)l * DM * FF, 64 * kb, 64 * nb, 64 * nb, scr, lane); }
    }
    bf16* H = (bf16*)(P.ws + WS_H); bf16* HN = (bf16*)(P.ws + WS_HN);
    for (int m = gw; m < MP; m += NGW) {
        if (m < MX) rms_row<false, true>(P.x + (size_t)m * DM, P.g_mix, HN + (size_t)m * DM, nullptr, lane, H + (size_t)m * DM);
        else if (m < MX + NMETA) { rms_row<false>(P.meta + (size_t)(m - MX) * DM, P.g_mix, HN + (size_t)m * DM, nullptr, lane);
            const f32x4* ms = (const f32x4*)(P.meta + (size_t)(m - MX) * DM) + lane; u32x2* hd = (u32x2*)(H + (size_t)m * DM) + lane;
            for (int j = 0; j < 16; ++j) { const f32x4 t4 = ms[64 * j]; hd[64 * j] = (u32x2){pk2(t4.x, t4.y), pk2(t4.z, t4.w)}; } }
        else zero_row(HN + (size_t)m * DM, nullptr, lane);
    }
    for (int it = gw; it < 3 * 64 * (SKVP - LPOS); it += NGW) { const int t = it / (64 * (SKVP - LPOS)), r2 = it % (64 * (SKVP - LPOS)), bh = r2 / (SKVP - LPOS), pp = LPOS + r2 % (SKVP - LPOS);
        bf16* base = (bf16*)(P.ws + WS_Q + (size_t)t * QKV_T_BYTES) + ((size_t)bh * SKVP + pp) * DH; ((unsigned*)base)[lane] = 0u; }
}

template <class Epi> __device__ __forceinline__ void skinny16(LAS unsigned char* lds, const bf16* __restrict__ A  , const bf16* __restrict__ Bt  , int ld, int N, int kparts, int vcu, int G, int tid, const Epi& E) {
    const int wave = __builtin_amdgcn_readfirstlane(tid >> 6), lane = tid & 63, fr = lane & 15, fq = lane >> 4;
    const int kpart = vcu % kparts, slot = vcu / kparts, nslots = G / kparts;
    LAS f32x4* red = (LAS f32x4*)lds;
    const bf16* ap = A + (size_t)fr * ld + kpart * 4096 + wave * 512 + 16 * fq;
    bf16x8 a[16];
#pragma unroll
    for (int i = 0; i < 8; ++i) { a[2 * i] = *(const bf16x8*)(ap + 64 * i); a[2 * i + 1] = *(const bf16x8*)(ap + 64 * i + 8); }
    for (int task = slot; task < (N >> 4); task += nslots) {
        const int n0 = task * 16;
        const bf16* bp = Bt + (size_t)(n0 + fr) * ld + kpart * 4096 + wave * 512 + 16 * fq;
        bf16x8 b[16];
#pragma unroll
        for (int i = 0; i < 8; ++i) { b[2 * i] = *(const bf16x8*)(bp + 64 * i); b[2 * i + 1] = *(const bf16x8*)(bp + 64 * i + 8); }
        f32x4 acc = (f32x4){0.f, 0.f, 0.f, 0.f};
#pragma unroll
        for (int i = 0; i < 16; ++i) acc = __builtin_amdgcn_mfma_f32_16x16x32_bf16(b[i], a[i], acc, 0, 0, 0);
        __syncthreads();
        red[wave * 64 + lane] = acc;
        __syncthreads();
        if (wave == 0) { f32x4 s = red[lane];
#pragma unroll
            for (int w = 1; w < 8; ++w) s += red[w * 64 + lane];
            E(s, n0 + 4 * fq, fr, kpart); }
    }
    __syncthreads();
}
struct SkQKV { bf16* Q; __device__ __forceinline__ void operator()(f32x4 v, int n, int row, int) const {
    const int sec = n / DM, hid = (n % DM) / DH, d = n % DH; bf16* dst = Q + (size_t)sec * (QKV_T_BYTES / 2) + ((size_t)hid * SKVP + row) * DH + d;
    const u32x2 w = (u32x2){pk2(v.x, v.y), pk2(v.z, v.w)}; *(u32x2*)dst = w; *(u32x2*)(dst + (size_t)NSH * SKVP * DH) = w; } };
struct SkRes { bf16* H; __device__ __forceinline__ void operator()(f32x4 v, int n, int row, int) const { u32x2* p = (u32x2*)(H + (size_t)(MX + row) * DM + n); const u32x2 w = *p;
    *p = (u32x2){pk2(bflo(w.x) + v.x, bfhi(w.x) + v.y), pk2(bflo(w.y) + v.z, bfhi(w.y) + v.w)}; } };
struct SkPart { float* part; __device__ __forceinline__ void operator()(f32x4 v, int n, int row, int kpart) const { *(f32x4*)(part + ((size_t)kpart * NMETA + row) * DM + n) = v; } };
struct SkRelu2 { bf16* MID; const float* rstd; __device__ __forceinline__ void operator()(f32x4 v, int n, int row, int) const { const float rs = rstd[MX + row], q = rs * rs;
    const float a = fmaxf(v.x, 0.f), b = fmaxf(v.y, 0.f), c = fmaxf(v.z, 0.f), d = fmaxf(v.w, 0.f); *(u32x2*)(MID + (size_t)(MX + row) * FF + n) = (u32x2){pk2(a * a * q, b * b * q), pk2(c * c * q, d * d * q)}; } };

__device__ __forceinline__ void norm_phase(const bf16* H, const float* g, bf16* HN, int nrows, int gw, int NGW, int lane) {
    for (int m = gw; m < nrows; m += NGW) rms_row_bf(H + (size_t)m * DM, g, HN + (size_t)m * DM, lane);
}

__device__ __forceinline__ void rstd_phase(const float* part, int npart  , float* rstd, const bf16* H, bool with_meta, int gw, int NGW, int lane) {
    for (int m = gw; m < MX; m += NGW) { const float* pr = part + (size_t)m * 128; float s = pr[lane]; if (npart > 64) s += pr[64 + lane];
        s = wave_sum(s); if (lane == 0) rstd[m] = 1.0f / sqrtf(s * (1.0f / DM) + EPS); }
    if (with_meta) for (int m = MX + gw; m < MX + NMETA; m += NGW) { const u32x4* s4 = (const u32x4*)(H + (size_t)m * DM) + lane; float ss = 0.f;
#pragma unroll
        for (int j = 0; j < 8; ++j) { const u32x4 v = s4[64 * j];
#pragma unroll
            for (int q = 0; q < 4; ++q) { const float a = bflo(v[q]), b = bfhi(v[q]); ss += a * a + b * b; } }
        ss = wave_sum(ss); if (lane == 0) rstd[m] = 1.0f / sqrtf(ss * (1.0f / DM) + EPS); }
}
__device__ __forceinline__ void qk_rope_phase(bf16* Q, bf16* K, const float* qg, const float* kg, int gw, int NGW, int lane) {
    const int j16 = lane & 15, rr = lane >> 4;
    float inv[4];
#pragma unroll
    for (int t = 0; t < 4; ++t) inv[t] = exp2f(-(float)(2 * (4 * j16 + t)) * (13.287712379549449f / 128.0f));
    for (int item = gw; item < NB * LPOS; item += NGW) {
        const int b = item / LPOS, p = item % LPOS;
        float cs[4], sn[4];
#pragma unroll
        for (int t = 0; t < 4; ++t) { const float ang = (float)p * inv[t]; cs[t] = cosf(ang); sn[t] = sinf(ang); }
#pragma unroll 1
        for (int ten = 0; ten < 2; ++ten) {
            bf16* T = ten ? K : Q; const float* g = ten ? kg : qg;
            const f32x4 g1 = *(const f32x4*)(g + 4 * j16), g2 = *(const f32x4*)(g + 64 + 4 * j16);
            bf16* row0 = T + ((size_t)(b * NSH + rr) * SKVP + p) * DH;
            u32x2 a[8], c[8];
#pragma unroll
            for (int ps = 0; ps < 8; ++ps) { const bf16* row = row0 + (size_t)(4 * ps) * SKVP * DH; a[ps] = *(const u32x2*)(row + 4 * j16); c[ps] = *(const u32x2*)(row + 64 + 4 * j16); }
#pragma unroll
            for (int ps = 0; ps < 8; ++ps) {
                bf16* row = row0 + (size_t)(4 * ps) * SKVP * DH;
                float x1[4] = {bflo(a[ps].x), bfhi(a[ps].x), bflo(a[ps].y), bfhi(a[ps].y)}, x2[4] = {bflo(c[ps].x), bfhi(c[ps].x), bflo(c[ps].y), bfhi(c[ps].y)};
                float ss = 0.f;
#pragma unroll
                for (int t = 0; t < 4; ++t) ss += x1[t] * x1[t] + x2[t] * x2[t];
                ss += __shfl_xor(ss, 1); ss += __shfl_xor(ss, 2); ss += __shfl_xor(ss, 4); ss += __shfl_xor(ss, 8);
                const float rstd = 1.0f / sqrtf(ss * (1.0f / DH) + EPS);
                float o1[4], o2[4];
#pragma unroll
                for (int t = 0; t < 4; ++t) { const float y1 = x1[t] * rstd * g1[t], y2 = x2[t] * rstd * g2[t]; o1[t] = y1 * cs[t] - y2 * sn[t]; o2[t] = y2 * cs[t] + y1 * sn[t]; }
                *(u32x2*)(row + 4 * j16) = (u32x2){pk2(o1[0], o1[1]), pk2(o1[2], o1[3])};
                *(u32x2*)(row + 64 + 4 * j16) = (u32x2){pk2(o2[0], o2[1]), pk2(o2[2], o2[3])};
            }
        }
    }
}

typedef ab::BlockRef<ab::bf16, ab::bf16> ARef;
__device__ __forceinline__ ARef attn_ref(int L, int pass, const bf16* Q, const bf16* K, const bf16* V, bf16* O) {
    const int inst = L >> 4, x = L & 15, qb = pass ? 31 - x : x;
    const int b = inst >> 6, h = (inst >> 2) & 15, c = (inst >> 1) & 1, vh = inst & 1;
    ARef r;
    r.Q = Q + ((size_t)(b * NSH + 2 * h + c) * SKVP + NMETA + 256 * qb) * DH;
    r.K = K + (size_t)(b * NSH + 2 * h + c) * SKVP * DH;
    r.V = V + (size_t)(b * NSH + 2 * h + vh) * SKVP * DH;
    r.O = O + ((size_t)inst * SEQ + 256 * qb) * DH;
    r.P0 = NMETA + 256 * qb;
    return r;
}
__device__ __forceinline__ void attn_phase(char* lds, const bf16* Q, const bf16* K, const bf16* V, bf16* O, int vcu, int G) {
    constexpr int TOTAL = 128 * 16, W = 1 << 30;
    int L = vcu; if (L >= TOTAL) return;
    int pass = 0;
    ARef cur = attn_ref(L, 0, Q, K, V, O);
    ab::Seam<ab::bf16> S;
    ab::causal_swa_prime<ab::bf16, ab::bf16>(cur, W, lds, S);
    for (;;) {
        const bool more_pass = pass == 0, more_item = L + G < TOTAL, last = !more_pass && !more_item;
        int passn = pass + 1, Ln = L;
        if (!more_pass) { passn = 0; Ln = more_item ? L + G : L; }
        const ARef nxt = last ? cur : attn_ref(Ln, passn, Q, K, V, O);
        ab::causal_swa_block<ab::bf16, ab::bf16>(cur, nxt, SKVP, W, lds, S);
        if (last) break;
        cur = nxt; pass = passn; L = Ln;
    }
}

__device__ __forceinline__ float wave_sum_dpp(float v) {
    v += ab::dppf<0xB1, false>(v); v += ab::dppf<0x4E, false>(v); v += ab::dppf<0x141, false>(v); v += ab::dppf<0x140, false>(v);
    return (__builtin_bit_cast(float, __builtin_amdgcn_readlane(__builtin_bit_cast(int, v), 0)) + __builtin_bit_cast(float, __builtin_amdgcn_readlane(__builtin_bit_cast(int, v), 16)))
         + (__builtin_bit_cast(float, __builtin_amdgcn_readlane(__builtin_bit_cast(int, v), 32)) + __builtin_bit_cast(float, __builtin_amdgcn_readlane(__builtin_bit_cast(int, v), 48)));
}
__device__ __forceinline__ void combine_phase(const Ptrs& P, int gw, int NGW, int lane) {
    const bf16* Ob = (const bf16*)(P.ws + WS_O); bf16* ATTO = (bf16*)(P.ws + WS_ATTO);
    const bf16* Qb = (const bf16*)(P.ws + WS_Q); const bf16* Kb = (const bf16*)(P.ws + WS_K); const bf16* Vb = (const bf16*)(P.ws + WS_V);
    float lam; { const float s1 = wave_sum(P.lamv[lane] * P.lamv[128 + lane] + P.lamv[64 + lane] * P.lamv[192 + lane]);
                 const float s2 = wave_sum(P.lamv[256 + lane] * P.lamv[384 + lane] + P.lamv[320 + lane] * P.lamv[448 + lane]); lam = expf(s1) - expf(s2) + 0.2f; }
    const f32x4 sgv = *(const f32x4*)(P.sg + 4 * lane);
    const int vh = lane >> 5, d = (lane & 31) * 4;
    for (int r = gw; r < MX; r += NGW) {
        const int b = r >> 13, i = r & (SEQ - 1);
        u32x2 av[NH], cv[NH];
#pragma unroll
        for (int h = 0; h < NH; ++h) { const int inst0 = ((b * NH + h) * 2 + 0) * 2 + vh;
            av[h] = *(const u32x2*)(Ob + ((size_t)inst0 * SEQ + i) * DH + d); cv[h] = *(const u32x2*)(Ob + ((size_t)(inst0 + 2) * SEQ + i) * DH + d); }
#pragma unroll
        for (int h = 0; h < NH; ++h) {
            const u32x2 a = av[h], c = cv[h];
            float v[4] = {bflo(a.x) - lam * bflo(c.x), bfhi(a.x) - lam * bfhi(c.x), bflo(a.y) - lam * bflo(c.y), bfhi(a.y) - lam * bfhi(c.y)};
            const float ss = wave_sum_dpp((v[0] * v[0] + v[1] * v[1]) + (v[2] * v[2] + v[3] * v[3]));
            const float rs = 0.8f / sqrtf(ss * (1.0f / 256.0f) + EPS);
            *(u32x2*)(ATTO + (size_t)r * DM + h * 256 + 4 * lane) = (u32x2){pk2(v[0] * rs * sgv.x, v[1] * rs * sgv.y), pk2(v[2] * rs * sgv.z, v[3] * rs * sgv.w)};
        }
    }
    for (int t = gw; t < NMETA * NH; t += NGW) {
        const int qi = t >> 4, h = t & 15, j = lane & 15, part = lane >> 4;
        float am = 0.f;
#pragma unroll
        for (int c = 0; c < 2; ++c) {
            const bf16* qrow = Qb + ((size_t)(2 * h + c) * SKVP + qi) * DH + part * 32; const bf16* krow = Kb + ((size_t)(2 * h + c) * SKVP + j) * DH + part * 32;
            float s = 0.f;
#pragma unroll
            for (int e = 0; e < 4; ++e) { const u32x4 qv = *(const u32x4*)(qrow + 8 * e), kv = *(const u32x4*)(krow + 8 * e);
                s += bflo(qv.x) * bflo(kv.x) + bfhi(qv.x) * bfhi(kv.x) + bflo(qv.y) * bflo(kv.y) + bfhi(qv.y) * bfhi(kv.y) + bflo(qv.z) * bflo(kv.z) + bfhi(qv.z) * bfhi(kv.z) + bflo(qv.w) * bflo(kv.w) + bfhi(qv.w) * bfhi(kv.w); }
            s += __shfl_xor(s, 16); s += __shfl_xor(s, 32);
            s = (j <= qi) ? s * 0.08838834764831845f : -__builtin_inff();
            float mx = s; mx = fmaxf(mx, __shfl_xor(mx, 1)); mx = fmaxf(mx, __shfl_xor(mx, 2)); mx = fmaxf(mx, __shfl_xor(mx, 4)); mx = fmaxf(mx, __shfl_xor(mx, 8));
            const float e_ = expf(s - mx); float sm = e_; sm += __shfl_xor(sm, 1); sm += __shfl_xor(sm, 2); sm += __shfl_xor(sm, 4); sm += __shfl_xor(sm, 8);
            const float p_ = e_ / sm; am = c == 0 ? p_ : am - lam * p_;
        }
        float o[4] = {0.f, 0.f, 0.f, 0.f};
        for (int jj = 0; jj <= qi; ++jj) { const float aj = __shfl(am, jj); const u32x2 vv = *(const u32x2*)(Vb + ((size_t)(2 * h + vh) * SKVP + jj) * DH + d);
            o[0] += aj * bflo(vv.x); o[1] += aj * bfhi(vv.x); o[2] += aj * bflo(vv.y); o[3] += aj * bfhi(vv.y); }
        const float ss = wave_sum((o[0] * o[0] + o[1] * o[1]) + (o[2] * o[2] + o[3] * o[3]));
        const float rs = 0.8f / sqrtf(ss * (1.0f / 256.0f) + EPS);
        *(u32x2*)(ATTO + (size_t)(MX + qi) * DM + h * 256 + 4 * lane) = (u32x2){pk2(o[0] * rs * sgv.x, o[1] * rs * sgv.y), pk2(o[2] * rs * sgv.z, o[3] * rs * sgv.w)};
    }
    for (int m = MX + NMETA + gw; m < MP; m += NGW) zero_row(ATTO + (size_t)m * DM, nullptr, lane);
}

__device__ __forceinline__ f32x2 cpowf2(float dar, float dai, int tau) { const float m = expf((float)tau * dar), a = (float)tau * dai; return (f32x2){m * cosf(a), m * sinf(a)}; }
template <int CTRL, bool BC> __device__ __forceinline__ float dppf(float x) { return __builtin_bit_cast(float, __builtin_amdgcn_update_dpp(0, __builtin_bit_cast(int, x), CTRL, 0xF, 0xF, BC)); }
__device__ __forceinline__ f32x4 cmul_add2(f32x4 w, f32x4 v, f32x4 acc) {
    acc.x += w.x * v.x - w.y * v.y; acc.y += w.x * v.y + w.y * v.x; acc.z += w.z * v.z - w.w * v.w; acc.w += w.z * v.w + w.w * v.z; return acc; }
template <int CTRL, bool BC> __device__ __forceinline__ f32x4 dpp4(f32x4 v) { return (f32x4){dppf<CTRL, BC>(v.x), dppf<CTRL, BC>(v.y), dppf<CTRL, BC>(v.z), dppf<CTRL, BC>(v.w)}; }

__device__ __forceinline__ void s5_load_u(bf16x8 (&uf)[8], const bf16* rowbase  , int fq) {
#pragma unroll
    for (int kt = 0; kt < 8; ++kt) uf[kt] = *(const bf16x8*)(rowbase + (size_t)(2 * kt + (fq >> 1)) * DM + 8 * (fq & 1));
}
__device__ __forceinline__ void s5_bmat(f32x4 (&Lc)[8], const bf16x8 (&uf)[8], LAS unsigned char* bfr  ) {
#pragma unroll
    for (int mt = 0; mt < 8; ++mt) Lc[mt] = (f32x4){0.f, 0.f, 0.f, 0.f};
#pragma unroll
    for (int ks = 0; ks < 8; ++ks) { asm volatile("" ::: "memory");
#pragma unroll
        for (int mt = 0; mt < 8; ++mt) Lc[mt] = __builtin_amdgcn_mfma_f32_16x16x32_bf16(*(const LAS bf16x8*)(bfr + (mt * 8 + ks) * 1024), uf[ks], Lc[mt], 0, 0, 0); }
}
__device__ __forceinline__ void s5_scan(f32x4 (&Lc)[8], const LAS f32x4* wp  ) {
    asm volatile("" ::: "memory");
#pragma unroll
    for (int mt = 0; mt < 8; ++mt) { Lc[mt] = cmul_add2(wp[0 * 32 + mt * 4], dpp4<0x111, true>(Lc[mt]), Lc[mt]); }
    asm volatile("" ::: "memory");
#pragma unroll
    for (int mt = 0; mt < 8; ++mt) { Lc[mt] = cmul_add2(wp[1 * 32 + mt * 4], dpp4<0x112, true>(Lc[mt]), Lc[mt]); }
    asm volatile("" ::: "memory");
#pragma unroll
    for (int mt = 0; mt < 8; ++mt) { Lc[mt] = cmul_add2(wp[2 * 32 + mt * 4], dpp4<0x114, true>(Lc[mt]), Lc[mt]); }
    asm volatile("" ::: "memory");
#pragma unroll
    for (int mt = 0; mt < 8; ++mt) { Lc[mt] = cmul_add2(wp[3 * 32 + mt * 4], dpp4<0x118, true>(Lc[mt]), Lc[mt]); }
}

__device__ __forceinline__ void dbg4(float* dbg, int comp0, int fr, f32x4 v, bool dd) { if (dd) { float* p = dbg; asm volatile("" : "+v"(p)); p += comp0 * 16 + fr; p[0] = v.x; p[16] = v.y; p[32] = v.z; p[48] = v.w; } }
template <int DUMP> __device__ __forceinline__ void s5_tile(unsigned char* ws, const bf16* HN, bf16* Z, int b, int tl, int g, int fr, int fq, f32x4 (&carry)[8],
        LAS unsigned char* bfr, LAS unsigned char* cfr, LAS unsigned char* ktb, const LAS f32x4* wp, const LAS f32x4* cpw, const LAS f32x4* a256) {
                bf16x8 uf[8]; f32x4 Lc[8];
                const size_t row0 = (size_t)b * SEQ + (size_t)(16 * tl + fr) * 16;
                s5_load_u(uf, HN + row0 * DM + g * SGS, fq); s5_bmat(Lc, uf, bfr);
#if defined(CHK) && CHK
                float* dbg = (float*)(ws + WS_END + 8 * MiB); constexpr int dm = DUMP; const bool dd = (g == 37 && b == 0 && tl == 5);
                if constexpr ((dm & 1) != 0) {
_Pragma("unroll") for (int mt = 0; mt < 8; ++mt) dbg4(dbg, 0 * 128 + 16 * mt + 4 * fq, fr, Lc[mt], dd); }
#endif
                s5_scan(Lc, wp);
#if defined(CHK) && CHK
                if constexpr ((dm & 2) != 0) {
_Pragma("unroll") for (int mt = 0; mt < 8; ++mt) { dbg4(dbg, 1 * 128 + 16 * mt + 4 * fq, fr, Lc[mt], dd); dbg4(dbg, 3 * 128 + 16 * mt + 4 * fq, fr, carry[mt], dd); } }
#endif
                bf16x8 sf[4]; asm volatile("" ::: "memory");
#pragma unroll
                for (int ks = 0; ks < 4; ++ks) { f32x4 s0 = cmul_add2(cpw[(2 * ks) * 4], carry[2 * ks], dpp4<0x111, true>(Lc[2 * ks])), s1 = cmul_add2(cpw[(2 * ks + 1) * 4], carry[2 * ks + 1], dpp4<0x111, true>(Lc[2 * ks + 1]));
                    const u32x4 w = (u32x4){pk2(s0.x, s0.y), pk2(s0.z, s0.w), pk2(s1.x, s1.y), pk2(s1.z, s1.w)}; sf[ks] = __builtin_bit_cast(bf16x8, w);
#if defined(CHK) && CHK
                    if constexpr ((dm & 4) != 0) {
#if CHK_ALT == 1
                        const f32x4 d0 = dpp4<0x111, true>(Lc[2 * ks]), d1 = dpp4<0x111, true>(Lc[2 * ks + 1]);
#elif CHK_ALT == 2
                        const f32x4 d0 = s0 - dpp4<0x111, true>(Lc[2 * ks]), d1 = s1 - dpp4<0x111, true>(Lc[2 * ks + 1]);
#elif CHK_ALT == 3
                        const f32x4 d0 = carry[2 * ks], d1 = carry[2 * ks + 1];
#else
                        const f32x4 d0 = s0, d1 = s1;
#endif
                        dbg4(dbg, 2 * 128 + 16 * (2 * ks) + 4 * fq, fr, d0, dd); dbg4(dbg, 2 * 128 + 16 * (2 * ks + 1) + 4 * fq, fr, d1, dd); }
#endif
                }
                asm volatile("" ::: "memory");
#pragma unroll
                for (int mt = 0; mt < 8; ++mt) carry[mt] = cmul_add2(a256[mt * 4], carry[mt], dpp4<0x15F, false>(Lc[mt]));
                bf16* zrow = Z + row0 * DM + g * SGS + 4 * fq;
#pragma unroll
                for (int hf = 0; hf < 2; ++hf) {
                    f32x4 Y[8];
#pragma unroll
                    for (int m8 = 0; m8 < 8; ++m8) Y[m8] = (f32x4){0.f, 0.f, 0.f, 0.f};
#pragma unroll
                    for (int ks = 0; ks < 4; ++ks) { asm volatile("" ::: "memory");
#pragma unroll
                        for (int m8 = 0; m8 < 8; ++m8) Y[m8] = __builtin_amdgcn_mfma_f32_16x16x32_bf16(*(const LAS bf16x8*)(cfr + ((8 * hf + m8) * 4 + ks) * 1024), sf[ks], Y[m8], 0, 0, 0); }
#if defined(CHK) && CHK
                    if constexpr ((dm & 8) != 0) {
_Pragma("unroll") for (int m8 = 0; m8 < 8; ++m8) dbg4(dbg, 4 * 128 + 16 * (8 * hf + m8) + 4 * fq, fr, Y[m8], dd); }
#endif
#pragma unroll
                    for (int kt = 0; kt < 4 * hf + 4; ++kt) { asm volatile("" ::: "memory");
#pragma unroll
                        for (int m8 = 0; m8 < 8; ++m8) { const int mt = 8 * hf + m8; if (mt < 2 * kt) continue;
                            bf16x8 a = *(const LAS bf16x8*)(ktb + (mt - 2 * kt) * 512);
                            if (mt == 2 * kt && fq >= 2) a = (bf16x8){0, 0, 0, 0, 0, 0, 0, 0};
                            Y[m8] = __builtin_amdgcn_mfma_f32_16x16x32_bf16(a, uf[kt], Y[m8], 0, 0, 0); } }
#if defined(CHK) && CHK
                    if constexpr ((dm & 16) != 0) {
_Pragma("unroll") for (int m8 = 0; m8 < 8; ++m8) dbg4(dbg, 6 * 128 + 16 * (8 * hf + m8) + 4 * fq, fr, Y[m8], dd); }
#endif
#pragma unroll
                    for (int m8 = 0; m8 < 8; ++m8) { float o[4];
#pragma unroll
                        for (int i = 0; i < 4; ++i) { const float y = Y[m8][i]; o[i] = y * __builtin_amdgcn_rcpf(1.0f + __builtin_amdgcn_exp2f(-2.3022082f * (y + 0.044715f * y * y * y))); }
                        *(u32x2*)(zrow + (size_t)(8 * hf + m8) * DM) = (u32x2){pk2(o[0], o[1]), pk2(o[2], o[3])}; }
                }
}
template <int DMASK> __device__ __forceinline__ void s5_phase(const Ptrs& P, LAS unsigned char* lds, int vcu, int G, int tid, bool tables_only = false) {
    const int wave = __builtin_amdgcn_readfirstlane(tid >> 6), lane = tid & 63, fr = lane & 15, fq = lane >> 4;
    const bf16* HN = (const bf16*)(P.ws + WS_HN); bf16* Z = (bf16*)(P.ws + WS_ATTO);
    for (int g = vcu; g < SG; g += G) {
        __syncthreads();
        const float dt = expf(P.log_dt[g]);
        LAS f32x2* Apow = (LAS f32x2*)(lds + S5_F);
        LAS f32x2* Bbar = (LAS f32x2*)(lds + S5_CFRAG);
        for (int e = tid; e < 17 * 64; e += 512) { const int tau = e >> 6, p = e & 63; Apow[e] = cpowf2(dt * P.a_re[g * SP + p], dt * P.a_im[g * SP + p], tau); }
        for (int e = tid; e < SP * SGS; e += 512) { const int p = e >> 4;
            const float ar = P.a_re[g * SP + p], ai = P.a_im[g * SP + p]; const f32x2 ab_ = cpowf2(dt * ar, dt * ai, 1);
            const float nr = ab_.x - 1.0f, ni = ab_.y, den = ar * ar + ai * ai, fre = (nr * ar + ni * ai) / den, fim = (ni * ar - nr * ai) / den;
            const float br = P.b_re[(size_t)g * SP * SGS + e], bi = P.b_im[(size_t)g * SP * SGS + e];
            Bbar[e] = (f32x2){fre * br - fim * bi, fre * bi + fim * br}; }
        __syncthreads();
        for (int f = tid; f < 4096; f += 512) {
            const int l2 = f & 63, ks = (f >> 6) & 7, mt = f >> 9, comp = 16 * mt + (l2 & 15), p = comp >> 1, ri = comp & 1; float v[8];
#pragma unroll
            for (int j = 0; j < 8; ++j) { const int k = 32 * ks + 8 * (l2 >> 4) + j, s = k >> 4, hh = k & 15; const f32x2 pw = Apow[(15 - s) * 64 + p], bb = Bbar[p * 16 + hh];
                v[j] = ri ? (pw.x * bb.y + pw.y * bb.x) : (pw.x * bb.x - pw.y * bb.y); }
            *(LAS u32x4*)(lds + S5_BFRAG + f * 16) = (u32x4){pk2(v[0], v[1]), pk2(v[2], v[3]), pk2(v[4], v[5]), pk2(v[6], v[7])}; }
        for (int e = tid; e < 4096; e += 512) {
            const int hp = e & 15, h = (e >> 4) & 15, tau = e >> 8; float acc = 0.f;
            const float* cr = P.c_re + ((size_t)g * SGS + h) * SP; const float* ci = P.c_im + ((size_t)g * SGS + h) * SP;
            for (int p = 0; p < SP; ++p) { const f32x2 pw = Apow[tau * 64 + p], bb = Bbar[p * 16 + hp]; const float wr_ = pw.x * bb.x - pw.y * bb.y, wi_ = pw.x * bb.y + pw.y * bb.x; acc += cr[p] * wr_ - ci[p] * wi_; }
            if (tau == 0 && h == hp) acc += P.dsk[g * SGS + h];
            ((LAS bf16*)(lds + S5_KTAB))[e] = (bf16)(pk2(acc, 0.f) & 0xffffu); }
        for (int e = tid; e < 16 * 64 + 4 * 64 + 64 + 64; e += 512) {
            int tau, off; const int p = e & 63;
            if (e < 1024) { tau = 16 * (e >> 6); off = S5_CPOW + e * 8; } else if (e < 1280) { tau = 16 << ((e - 1024) >> 6); off = S5_WPOW + (e - 1024) * 8; }
            else if (e < 1344) { tau = 256; off = S5_A256 + p * 8; } else { tau = 1024; off = S5_A1024 + p * 8; }
            *(LAS f32x2*)(lds + off) = cpowf2(dt * P.a_re[g * SP + p], dt * P.a_im[g * SP + p], tau); }
        __syncthreads();
        for (int f = tid; f < 4096; f += 512) {
            const int l2 = f & 63, ks = (f >> 6) & 3, mt = f >> 8, h = l2 & 15; float v[8];
            const float* cr = P.c_re + ((size_t)g * SGS + h) * SP; const float* ci = P.c_im + ((size_t)g * SGS + h) * SP;
#pragma unroll
            for (int j = 0; j < 8; ++j) { const int comp = 16 * (2 * ks + (j >> 2)) + 4 * (l2 >> 4) + (j & 3), p = comp >> 1, ri = comp & 1; const f32x2 pw = Apow[(mt + 1) * 64 + p];
                v[j] = ri ? (-cr[p] * pw.y - ci[p] * pw.x) : (cr[p] * pw.x - ci[p] * pw.y); }
            *(LAS u32x4*)(lds + S5_CFRAG + f * 16) = (u32x4){pk2(v[0], v[1]), pk2(v[2], v[3]), pk2(v[4], v[5]), pk2(v[6], v[7])}; }
        __syncthreads();
        if (tables_only) continue;
        LAS unsigned char* bfr = lds + S5_BFRAG + lane * 16; LAS unsigned char* cfr = lds + S5_CFRAG + lane * 16;
        LAS unsigned char* ktb = lds + S5_KTAB + ((fr * 16 + 8 * (fq & 1)) * 2) - (fq >> 1) * 512;
        const LAS f32x4* wp = (const LAS f32x4*)(lds + S5_WPOW) + fq;
        const LAS f32x4* cpw = (const LAS f32x4*)(lds + S5_CPOW) + fr * 32 + fq;
        const LAS f32x4* a256 = (const LAS f32x4*)(lds + S5_A256) + fq; const LAS f32x4* a1024 = (const LAS f32x4*)(lds + S5_A1024) + fq;
        LAS f32x4* Fw = (LAS f32x4*)(lds + S5_F); LAS f32x4* Em = (LAS f32x4*)(lds + S5_EMETA);
        bf16x8 uf[8]; f32x4 Lc[8];
        if (wave == 0) {
            s5_load_u(uf, HN + (size_t)MX * DM + g * SGS, fq); s5_bmat(Lc, uf, bfr);
            if (fr == 0) {
#pragma unroll
                for (int mt = 0; mt < 8; ++mt) Em[mt * 4 + fq] = Lc[mt]; }
        }
#pragma unroll 1
        for (int b = 0; b < NB; ++b) {
            f32x4 seg[8];
#pragma unroll
            for (int mt = 0; mt < 8; ++mt) seg[mt] = (f32x4){0.f, 0.f, 0.f, 0.f};
#pragma unroll 1
            for (int tl = 4 * wave; tl < 4 * wave + 4; ++tl) {
                s5_load_u(uf, HN + ((size_t)b * SEQ + (size_t)(16 * tl + fr) * 16) * DM + g * SGS, fq); s5_bmat(Lc, uf, bfr); s5_scan(Lc, wp);
                asm volatile("" ::: "memory");
#pragma unroll
                for (int mt = 0; mt < 8; ++mt) seg[mt] = cmul_add2(a256[mt * 4], seg[mt], dpp4<0x15F, false>(Lc[mt]));
            }
            if (fr == 0) {
#pragma unroll
                for (int mt = 0; mt < 8; ++mt) Fw[(b * 8 + wave) * 32 + mt * 4 + fq] = seg[mt]; }
            __syncthreads();
            f32x4 carry[8];
#pragma unroll
            for (int mt = 0; mt < 8; ++mt) carry[mt] = Em[mt * 4 + fq];
            for (int w2 = 0; w2 < wave; ++w2) {
#pragma unroll
                for (int mt = 0; mt < 8; ++mt) carry[mt] = cmul_add2(a1024[mt * 4], carry[mt], Fw[(b * 8 + w2) * 32 + mt * 4 + fq]); }
#pragma unroll 1
            for (int tl = 4 * wave; tl < 4 * wave + 4; ++tl) {
                                s5_tile<DMASK>(P.ws, HN, Z, b, tl, g, fr, fq, carry, bfr, cfr, ktb, wp, cpw, a256);
            }
        }
    }
}

#ifndef PH_ALL
#define PH_ALL 1
#endif
#ifndef PH_P0
#define PH_P0 PH_ALL
#endif
#ifndef PH_QKV
#define PH_QKV PH_ALL
#endif
#ifndef PH_ROPE
#define PH_ROPE PH_ALL
#endif
#ifndef PH_ATTN
#define PH_ATTN PH_ALL
#endif
#ifndef PH_COMB
#define PH_COMB PH_ALL
#endif
#ifndef PH_WO
#define PH_WO PH_ALL
#endif
#ifndef PH_NORM
#define PH_NORM PH_ALL
#endif
#ifndef PH_UP
#define PH_UP PH_ALL
#endif
#ifndef PH_DN
#define PH_DN PH_ALL
#endif
#ifndef PH_S5
#define PH_S5 PH_ALL
#endif
#ifndef PH_GLU
#define PH_GLU PH_ALL
#endif
struct Args { const float* in[22]; float* out; unsigned char* ws; int ph_lo, ph_hi; };
__device__ __forceinline__ Ptrs load_ptrs() {
    const __attribute__((address_space(4))) Args* ap = (const __attribute__((address_space(4))) Args*)__builtin_amdgcn_kernarg_segment_ptr();
    asm volatile("" : "+s"(ap));
    Ptrs P;
    P.x = ap->in[0]; P.meta = ap->in[1]; P.g_mix = ap->in[2]; P.g_mlp = ap->in[3]; P.wqkv = ap->in[4]; P.qg = ap->in[5]; P.kg = ap->in[6]; P.lamv = ap->in[7]; P.sg = ap->in[8]; P.wo = ap->in[9];
    P.a_re = ap->in[10]; P.a_im = ap->in[11]; P.log_dt = ap->in[12]; P.b_re = ap->in[13]; P.b_im = ap->in[14]; P.c_re = ap->in[15]; P.c_im = ap->in[16]; P.dsk = ap->in[17]; P.wglu = ap->in[18]; P.bglu = ap->in[19];
    P.wup = ap->in[20]; P.wdn = ap->in[21]; P.out = ap->out; P.ws = ap->ws;
    return P;
}
#if defined(HV_DEBUG)
#define HV_DBG(ok) do { if (!(ok) && blockIdx.x == 0 && threadIdx.x == 0) { const unsigned long long t0_ = __builtin_amdgcn_s_memrealtime(); while (__builtin_amdgcn_s_memrealtime() - t0_ < 20000ull) __builtin_amdgcn_s_sleep(8); } } while (0)
#else
#define HV_DBG(ok) do {} while (0)
#endif
#define PHASE_VARS() const Ptrs P = load_ptrs(); int tid = tid_fresh(); const int lane = tid & 63, wave = __builtin_amdgcn_readfirstlane(tid >> 6); \
    const int G = gridDim.x, bx = blockIdx.x, vcu = (G % 8 == 0) ? (bx % 8) * (G / 8) + bx / 8 : bx; const int gw = vcu * 8 + wave, NGW = G * 8; (void)lane; (void)gw; (void)NGW; (void)vcu; \
    int hvcu = vcu; { const volatile LAS unsigned* M_ = (const volatile LAS unsigned*)(lds + MISC_OFF); bool ok_ = (G == 256); const unsigned* xr_ = (const unsigned*)(P.ws + WS_CTL) + CW_XRANK; \
      for (int j_ = 0; j_ < 8; ++j_) ok_ = ok_ && (__hip_atomic_load(xr_ + 64 * j_, __ATOMIC_RELAXED, __HIP_MEMORY_SCOPE_AGENT) == 32u); if (ok_) hvcu = (int)(M_[16] * 32u + M_[17]); hvcu = __builtin_amdgcn_readfirstlane(hvcu); HV_DBG(ok_); } (void)hvcu; const int hbx = (G == 256) ? (hvcu & 31) * 8 + (hvcu >> 5) : bx; (void)hbx; \
    bf16* H = (bf16*)(P.ws + WS_H); bf16* HN = (bf16*)(P.ws + WS_HN); bf16* ATTO = (bf16*)(P.ws + WS_ATTO); bf16* MID = (bf16*)(P.ws + WS_MID); \
    bf16* Qb = (bf16*)(P.ws + WS_Q); bf16* Kb = (bf16*)(P.ws + WS_K); bf16* Vb = (bf16*)(P.ws + WS_V); bf16* Ob = (bf16*)(P.ws + WS_O); \
    const bf16* Wqkv_t = (const bf16*)(P.ws + WS_WQKV); const bf16* Wo_t = (const bf16*)(P.ws + WS_WO); const bf16* Wglu_t = (const bf16*)(P.ws + WS_WGLU); \
    const bf16* Wup_t = (const bf16*)(P.ws + WS_WUP); const bf16* Wdn_t = (const bf16*)(P.ws + WS_WDN); \
    (void)H; (void)HN; (void)ATTO; (void)MID; (void)Qb; (void)Kb; (void)Vb; (void)Ob; (void)Wqkv_t; (void)Wo_t; (void)Wglu_t; (void)Wup_t; (void)Wdn_t;

__global__ void __launch_bounds__(512, 2) fwd_kernel(Args args) {
    extern __shared__ __attribute__((aligned(16))) unsigned char lds_raw[];
    LAS unsigned char* lds = (LAS unsigned char*)lds_raw;
    (void)args;
    int ph_lo_, ph_hi_; { const __attribute__((address_space(4))) Args* ap = (const __attribute__((address_space(4))) Args*)__builtin_amdgcn_kernarg_segment_ptr(); ph_lo_ = ap->ph_lo; ph_hi_ = ap->ph_hi; }
#define RUN(k) (ph_lo_ <= (k) && (k) < ph_hi_)
#if defined(PROBE_W)
#define STAMP(k) do { if (blockIdx.x == 0 && threadIdx.x == 0) { const Ptrs Ps = load_ptrs(); ((volatile unsigned long long*)(Ps.ws + WS_CTL + 65536))[k] = __builtin_amdgcn_s_memrealtime(); } } while (0)
#else
#define STAMP(k) do {} while (0)
#endif
    STAMP(0);
    XcdBarrier bar;
    { PHASE_VARS();
      volatile LAS unsigned* MISC = (volatile LAS unsigned*)(lds + MISC_OFF);
      if (tid < 32) MISC[tid] = 0u;
      __syncthreads();
      bar = xcd_barrier_post((unsigned*)(P.ws + WS_CTL) + CW_BAR, MISC + 8);
      if (tid == 0) { const unsigned xcc = xb_xcc_id() & 7u; MISC[16] = xcc; MISC[17] = __hip_atomic_fetch_add((unsigned*)(P.ws + WS_CTL) + CW_XRANK + 64 * xcc, 1u, __ATOMIC_RELAXED, __HIP_MEMORY_SCOPE_AGENT); }
      __syncthreads(); }

#if PH_P0
    if (RUN(0)) {
    { PHASE_VARS(); p0_prologue(P, lds, gw, NGW, wave, lane); }
    }
#endif
    if (RUN(0) && RUN(1)) xcd_barrier(bar);
    STAMP(1);
#if PH_QKV
    if (RUN(1)) {
    { PHASE_VARS(); pg8::Gemm g{HN, Wqkv_t, MX, 3 * DM, DM}; pg8::StaticOrder S; S.init(MX, 3 * DM, G, hbx); pg8::EpiQKV E{Qb, QKV_T_BYTES / 2};
      pg8::gemm_phase<pg8::EpiQKV, pg8::StaticOrder, true, GEMM_SP2>(lds, g, S, E);
      skinny16(lds, HN + (size_t)MX * DM, Wqkv_t, DM, 3 * DM, 1, vcu, G, tid, SkQKV{Qb}); }
    }
#endif
    if (RUN(1) && RUN(2)) xcd_barrier(bar);
    STAMP(2);
#if PH_ROPE
    if (RUN(2)) {
    { PHASE_VARS(); qk_rope_phase(Qb, Kb, P.qg, P.kg, gw, NGW, lane); }
    }
#endif
    if (RUN(2) && RUN(3)) xcd_barrier(bar);
    STAMP(3);
#if PH_ATTN
    if (RUN(3)) {
    { PHASE_VARS();
      ab::da_phase((char*)lds_raw, Qb, Kb, Vb, Ob, hvcu, G, SKVP, SEQ, NMETA); }
    }
#endif
    if (RUN(3) && RUN(4)) xcd_barrier(bar);
    STAMP(4);
#if PH_COMB
    if (RUN(4)) {
    { PHASE_VARS();
#if defined(DA_TESTRUN)
      ab::da_phase((char*)lds_raw, Qb, Kb, Vb, Ob, hvcu, G, SKVP, SEQ, NMETA, DA_TESTRUN); __syncthreads();
#endif
      combine_phase(P, gw, NGW, lane); }
    }
#endif
    if (RUN(4) && RUN(5)) xcd_barrier(bar);
    STAMP(5);
#if PH_WO
    if (RUN(5)) {
    { PHASE_VARS(); pg8::Gemm g{ATTO, Wo_t, MX, DM, DM}; pg8::StaticOrder S; S.init(MX, DM, G, hbx); pg8::EpiRes<false, false, true> E{H, H, (float*)(P.ws + WS_PART)};
      pg8::gemm_phase<pg8::EpiRes<false, false, true>, pg8::StaticOrder, true, GEMM_SP2>(lds, g, S, E);
      skinny16(lds, ATTO + (size_t)MX * DM, Wo_t, DM, DM, 1, vcu, G, tid, SkRes{H}); }
    }
#endif
    if (RUN(5) && RUN(6)) xcd_barrier(bar);
    STAMP(6);
#if PH_NORM
    if (RUN(6)) {
    { PHASE_VARS(); rstd_phase((const float*)(P.ws + WS_PART), 64, (float*)(P.ws + WS_RSTD), H, true, gw, NGW, lane); }
    }
#endif
    if (RUN(6) && RUN(7)) xcd_barrier(bar);
    STAMP(7);
#if PH_UP
    if (RUN(7)) {
    { PHASE_VARS(); pg8::Gemm g{H, Wup_t, MX, FF, DM}; pg8::StaticOrder S; S.init(MX, FF, G, hbx); pg8::EpiRelu2 E{MID, FF, (const float*)(P.ws + WS_RSTD)};
      pg8::gemm_phase<pg8::EpiRelu2, pg8::StaticOrder, true, GEMM_SP2>(lds, g, S, E);
      skinny16(lds, H + (size_t)MX * DM, Wup_t, DM, FF, 1, vcu, G, tid, SkRelu2{MID, (const float*)(P.ws + WS_RSTD)}); }
    }
#endif
    if (RUN(7) && RUN(8)) xcd_barrier(bar);
    STAMP(8);
#if PH_DN
    if (RUN(8)) {
    { PHASE_VARS(); pg8::Gemm g{MID, Wdn_t, MX, DM, FF}; pg8::StaticOrder S; S.init(MX, DM, G, hbx); pg8::EpiRes<false, false> E{H, H, nullptr};
      pg8::gemm_phase<pg8::EpiRes<false, false>, pg8::StaticOrder, true, GEMM_SP2>(lds, g, S, E);
      skinny16(lds, MID + (size_t)MX * FF, Wdn_t, FF, DM, 4, vcu, G, tid, SkPart{(float*)(P.ws + WS_MPART)}); }
    }
#endif
    if (RUN(8) && RUN(9)) xcd_barrier(bar);
    STAMP(9);
#if PH_NORM
    if (RUN(9)) {
    { PHASE_VARS();
      if (gw < NMETA) {
          bf16* hr = H + (size_t)(MX + gw) * DM; const float* pp = (const float*)(P.ws + WS_MPART) + (size_t)gw * DM;
#pragma unroll 4
          for (int j = 0; j < 16; ++j) { const int o = 4 * (lane + 64 * j); const u32x2 w = *(const u32x2*)(hr + o); f32x4 v = (f32x4){bflo(w.x), bfhi(w.x), bflo(w.y), bfhi(w.y)};
              v += *(const f32x4*)(pp + o); v += *(const f32x4*)(pp + (size_t)NMETA * DM + o); v += *(const f32x4*)(pp + (size_t)2 * NMETA * DM + o); v += *(const f32x4*)(pp + (size_t)3 * NMETA * DM + o);
              *(u32x2*)(hr + o) = (u32x2){pk2(v.x, v.y), pk2(v.z, v.w)}; }
          asm volatile("s_waitcnt vmcnt(0)" ::: "memory"); }
      norm_phase(H, P.g_mix + DM, HN, MX + NMETA, gw, NGW, lane); }
    }
#endif
    if (RUN(9) && RUN(10)) xcd_barrier(bar);
    STAMP(10);
#if PH_S5
    if (RUN(10)) {
    { PHASE_VARS();
#if defined(S5_TESTRUN)
      s5_phase<0>(P, lds, vcu, G, tid, true); __syncthreads();
#endif
      s5_phase<0>(P, lds, vcu, G, tid); }
    }
#endif
    if (RUN(10) && RUN(11)) xcd_barrier(bar);
    STAMP(11);
#if PH_GLU
    if (RUN(11)) {
    { PHASE_VARS(); pg8::Gemm g{ATTO, Wglu_t, MX, 2 * DM, DM}; pg8::StaticOrder S; S.init(MX, 2 * DM, G, hbx); pg8::EpiGlu E{H, P.bglu, (float*)(P.ws + WS_PART)};
      pg8::gemm_phase<pg8::EpiGlu, pg8::StaticOrder, true, GEMM_SP2>(lds, g, S, E); }
    }
#endif
    if (RUN(11) && RUN(12)) xcd_barrier(bar);
    STAMP(12);
#if PH_NORM
    if (RUN(12)) {
    { PHASE_VARS(); rstd_phase((const float*)(P.ws + WS_PART), 128, (float*)(P.ws + WS_RSTD), H, false, gw, NGW, lane); }
    }
#endif
    if (RUN(12) && RUN(13)) xcd_barrier(bar);
    STAMP(13);
#if PH_UP
    if (RUN(13)) {
    { PHASE_VARS(); pg8::Gemm g{H, Wup_t + (size_t)DM * FF, MX, FF, DM}; pg8::StaticOrder S; S.init(MX, FF, G, hbx); pg8::EpiRelu2 E{MID, FF, (const float*)(P.ws + WS_RSTD)};
      pg8::gemm_phase<pg8::EpiRelu2, pg8::StaticOrder, true, GEMM_SP2>(lds, g, S, E); }
    }
#endif
    if (RUN(13) && RUN(14)) xcd_barrier(bar);
    STAMP(14);
#if PH_DN
    if (RUN(14)) {
    { PHASE_VARS(); pg8::Gemm g{MID, Wdn_t + (size_t)DM * FF, MX, DM, FF}; pg8::StaticOrder S; S.init(MX, DM, G, hbx); pg8::EpiRes<false, true> E{H, P.out, nullptr};
      pg8::gemm_phase<pg8::EpiRes<false, true>, pg8::StaticOrder, true, GEMM_SP2>(lds, g, S, E); }
    }
#endif
#if defined(PROBE_W)
    STAMP(15);
    if (blockIdx.x == 0 && threadIdx.x == 0) { const Ptrs Ps = load_ptrs(); volatile unsigned long long* st = (volatile unsigned long long*)(Ps.ws + WS_CTL + 65536); const int w[15] = PROBE_W; unsigned long long dur = 0;
#pragma unroll
        for (int k = 0; k < 15; ++k) dur += (unsigned long long)w[k] * (st[k + 1] - st[k]);
        const unsigned long long t0 = __builtin_amdgcn_s_memrealtime(); while (__builtin_amdgcn_s_memrealtime() - t0 < dur) __builtin_amdgcn_s_sleep(8); }
#endif
}

#undef STAMP
#undef RUN
#if defined(CHK) && CHK && defined(CHK_DUMP)
__global__ void __launch_bounds__(512, 2) s5_dbg_kernel(Args args) {
    extern __shared__ __attribute__((aligned(16))) unsigned char lds_raw[];
    LAS unsigned char* lds = (LAS unsigned char*)lds_raw; (void)args;
    PHASE_VARS(); s5_phase<CHK_DUMP>(P, lds, vcu, G, tid);
}
#endif
extern "C" void kernel_launch(void* const* d_in, const int* in_sizes, int n_in, void* d_out, int out_size, void* d_ws, size_t ws_size, hipStream_t stream) {
    static int grid = 0;
    if (grid == 0) {
        if (n_in != 22 || in_sizes[0] != MX * DM || out_size != MX * DM || ws_size < WS_END + 16 * MiB) {
            fprintf(stderr, "kernel_launch: built for 22 inputs, x/out of %d floats, >= %zu bytes of workspace; got n_in %d, in0 %d, out %d, ws %zu; nothing launched\n", MX * DM, (size_t)WS_END, n_in, n_in > 0 ? in_sizes[0] : -1, out_size, ws_size); grid = -1; return; }
        int dev = 0, cus = 0, per_cu = 0;
        if (hipGetDevice(&dev) != hipSuccess || hipDeviceGetAttribute(&cus, hipDeviceAttributeMultiprocessorCount, dev) != hipSuccess) { fprintf(stderr, "kernel_launch: device query failed\n"); grid = -1; return; }
        if (hipFuncSetAttribute((const void*)fwd_kernel, hipFuncAttributeMaxDynamicSharedMemorySize, LDS_BYTES) != hipSuccess) { fprintf(stderr, "kernel_launch: hipFuncSetAttribute(%d B LDS) failed\n", LDS_BYTES); grid = -1; return; }
        if (hipOccupancyMaxActiveBlocksPerMultiprocessor(&per_cu, (const void*)fwd_kernel, 512, LDS_BYTES) != hipSuccess || per_cu < 1)
            fprintf(stderr, "kernel_launch: note: occupancy query reports %d workgroups per CU; launching one per CU anyway (%d B LDS)\n", per_cu, LDS_BYTES);
        (void)hipGetLastError();
        grid = cus;
    }
    if (grid < 0) return;
    if (hipMemsetAsync((char*)d_ws + WS_CTL, 0, CTL_ZERO_BYTES, stream) != hipSuccess) { fprintf(stderr, "kernel_launch: memset failed\n"); return; }
    Args a{};
    for (int i = 0; i < 22; ++i) a.in[i] = (const float*)d_in[i];
    a.out = (float*)d_out; a.ws = (unsigned char*)d_ws;
#if defined(CHK) && CHK
    (void)hipMemsetAsync((char*)d_ws + WS_RES, 0, 1024, stream);
    for (int k = 0; k < 15; ++k) {
        if (k == 8 || k == 11) hipLaunchKernelGGL(chk_snap, dim3(64), dim3(256), 0, stream, (const float*)((char*)d_ws + WS_H), (float*)((char*)d_ws + WS_SNAP));
        a.ph_lo = k; a.ph_hi = k + 1;
        hipLaunchKernelGGL(fwd_kernel, dim3(grid), dim3(512), LDS_BYTES, stream, a);
        if (k == 3) hipLaunchKernelGGL(chk_attn, dim3(48), dim3(128), 0, stream, a);
        else if (k == 10) { hipLaunchKernelGGL(chk_s5, dim3(12), dim3(64), 0, stream, a);
#if defined(CHK_DUMP)
            (void)hipFuncSetAttribute((const void*)s5_dbg_kernel, hipFuncAttributeMaxDynamicSharedMemorySize, LDS_BYTES);
            hipLaunchKernelGGL(s5_dbg_kernel, dim3(grid), dim3(512), LDS_BYTES, stream, a);
            hipLaunchKernelGGL(chk_s5_int, dim3(1), dim3(64), 0, stream, a);
#endif
        }
        else hipLaunchKernelGGL(chk_kernel, dim3(64), dim3(64), 0, stream, a, k);
    }
    hipLaunchKernelGGL(chk_report, dim3(1), dim3(1), 0, stream, a);
#else
    a.ph_lo = 0; a.ph_hi = 15;
    hipLaunchKernelGGL(fwd_kernel, dim3(grid), dim3(512), LDS_BYTES, stream, a);
#endif
    const hipError_t le = hipPeekAtLastError();
    if (le != hipSuccess) fprintf(stderr, "kernel_launch: launch failed: %s\n", hipGetErrorName(le));
}
```
